# Optimizing an MI355X kernel written in HIP

```python
import jax, jax.numpy as jnp
from jax import lax
import numpy as np


D_MODEL = 2048
BATCH = 4
SEQ = 4096
DEPTH = 1

N_META = 16
BLOCK = 128
PAD_LEFT = BLOCK - N_META
HEAD_DIM = 64
MIX_WIDTH = D_MODEL
RWKV_WIDTH = MIX_WIDTH // 2
RWKV_HEADS = RWKV_WIDTH // HEAD_DIM
ATTN_WIDTH = MIX_WIDTH - RWKV_WIDTH
ATTN_Q_HEADS = ATTN_WIDTH // HEAD_DIM
ATTN_KV_HEADS = max(1, ATTN_Q_HEADS // 8)
KV_WIDTH = ATTN_KV_HEADS * HEAD_DIM
WINDOW = 128
ATTN_SCALE = HEAD_DIM ** -0.5
MASK_VALUE = -1e30
DECAY_LORA = 64
AAA_LORA = 64
GATE_LORA = 160
RMS_EPS = 1e-6
GN_EPS = 64e-5
ATTN_COLS = ATTN_WIDTH + 2 * KV_WIDTH
RWKV_COLS = 3 * RWKV_WIDTH + DECAY_LORA + AAA_LORA + GATE_LORA
IN_COLS = ATTN_COLS + RWKV_COLS
PEER_HEADS = 8
N_KEYS = 128
N_EXPERTS = N_KEYS * N_KEYS
PEER_TOPK = 16
D_KEY = 256
PEER_BLOCK = 128

kernel_name = 'hybrid_rwkv7_swa_sink_peer'


def rms_norm(x, g):
    xf = x.astype(jnp.float32)
    y = xf * lax.rsqrt(jnp.mean(xf * xf, axis=-1, keepdims=True) + RMS_EPS)
    return (y * g.astype(jnp.float32)).astype(x.dtype)


def split_cols(p, sizes):
    out, o = [], 0
    for s in sizes:
        out.append(p[..., o:o + s])
        o += s
    return out


def token_shift(p, mu):
    p_prev = jnp.pad(p, ((0, 0), (1, 0), (0, 0)))[:, :-1]
    return p + mu.astype(p.dtype) * (p_prev - p)


def rwkv7_time_mix(pr, pk, pv, pw, pa, pg, w0, w_up, a0, a_up, g_up, k_k, k_a, r_k, gn_w, gn_b):
    B, L, C = pr.shape
    H, N = RWKV_HEADS, HEAD_DIM
    f32 = jnp.float32
    dt = pr.dtype
    w_log = -jax.nn.softplus(-(w0 + jnp.tanh(pw) @ w_up).astype(f32)) - 0.5
    decay = jnp.exp(-jnp.exp(w_log))
    a = jax.nn.sigmoid((a0 + pa @ a_up).astype(f32))
    g = (jax.nn.sigmoid(pg) @ g_up).astype(f32)
    kf = pk.astype(f32)
    kk = (kf * k_k.astype(f32)).reshape(B, L, H, N)
    kk = kk / jnp.maximum(jnp.sqrt(jnp.sum(kk * kk, axis=-1, keepdims=True)), 1e-12)
    k = (kf * (1.0 + (a - 1.0) * k_a.astype(f32))).reshape(B, L, H, N)
    r = pr.astype(f32).reshape(B, L, H, N)
    v = pv.astype(f32).reshape(B, L, H, N)
    a = a.reshape(B, L, H, N)
    decay = decay.reshape(B, L, H, N)

    def step(S, inp):
        r_t, w_t, k_t, v_t, kk_t, a_t = inp
        sa = jnp.einsum('bhij,bhj->bhi', S, -kk_t)
        S = (S * w_t[:, :, None, :] + sa[..., :, None] * (kk_t * a_t)[..., None, :]
             + v_t[..., :, None] * k_t[..., None, :])
        y_t = jnp.einsum('bhij,bhj->bhi', S, r_t)
        return S, y_t

    xs = tuple(jnp.moveaxis(t, 1, 0) for t in (r, decay, k, v, kk, a))
    S0 = jnp.zeros((B, H, N, N), f32)
    _, y = lax.scan(step, S0, xs)
    y = jnp.moveaxis(y, 0, 1)
    mu = jnp.mean(y, axis=-1, keepdims=True)
    var = jnp.mean(jnp.square(y - mu), axis=-1, keepdims=True)
    yn = ((y - mu) * lax.rsqrt(var + GN_EPS)).reshape(B, L, C)
    yn = yn * gn_w.astype(f32) + gn_b.astype(f32)
    bonus = jnp.sum(r * k * r_k.astype(f32), axis=-1, keepdims=True) * v
    return ((yn + bonus.reshape(B, L, C)) * g).astype(dt)


def sliding_window_sink_attention(q, k, v, q_gain, k_gain, sinks):
    B, LP, _ = q.shape
    NB = LP // BLOCK
    KVH = ATTN_KV_HEADS
    G = ATTN_Q_HEADS // KVH
    f32 = jnp.float32
    q = rms_norm(q.reshape(B, LP, ATTN_Q_HEADS, HEAD_DIM), q_gain).reshape(B, NB, BLOCK, KVH, G, HEAD_DIM)
    k = rms_norm(k.reshape(B, LP, KVH, HEAD_DIM), k_gain).reshape(B, NB, BLOCK, KVH, HEAD_DIM)
    v = v.reshape(B, NB, BLOCK, KVH, HEAD_DIM)

    def with_prev(t):
        prev = jnp.pad(t, ((0, 0), (1, 0), (0, 0), (0, 0), (0, 0)))[:, :-1]
        return jnp.concatenate([prev, t], axis=2)

    kw, vw = with_prev(k), with_prev(v)
    s = jnp.einsum('bnqkgd,bnskd->bnkgqs', q, kw, preferred_element_type=f32) * ATTN_SCALE
    blk = jnp.arange(NB)[:, None, None]
    qpos = blk * BLOCK + jnp.arange(BLOCK)[None, :, None]
    kpos = (blk - 1) * BLOCK + jnp.arange(2 * BLOCK)[None, None, :]
    dist = qpos - kpos
    mask = (dist >= 0) & (dist < WINDOW) & (kpos >= PAD_LEFT)
    s = jnp.where(mask[None, :, None, None], s, MASK_VALUE)
    sink = jnp.broadcast_to(sinks.astype(f32).reshape(1, 1, KVH, G, 1, 1), s.shape[:-1] + (1,))
    p = jax.nn.softmax(jnp.concatenate([s, sink], axis=-1), axis=-1)[..., :-1]
    o = jnp.einsum('bnkgqs,bnskd->bnqkgd', p.astype(vw.dtype), vw)
    return o.reshape(B, LP, ATTN_WIDTH)


def peer_ffn(x, peer_query, peer_sub_keys, peer_down, peer_up):
    B, LP, D = x.shape
    T = B * LP
    K = PEER_TOPK
    xt = x.reshape(T, D)
    q = (xt @ peer_query).reshape(T, PEER_HEADS, 2, D_KEY // 2)
    scores = jnp.einsum('thcd,hcnd->thcn', q, peer_sub_keys, preferred_element_type=jnp.float32)
    s_half, i_half = lax.top_k(scores, K)
    cand_s = (s_half[:, :, 0, :, None] + s_half[:, :, 1, None, :]).reshape(T, PEER_HEADS, K * K)
    cand_i = (i_half[:, :, 0, :, None] * N_KEYS + i_half[:, :, 1, None, :]).reshape(T, PEER_HEADS, K * K)
    top_s, top_pos = lax.top_k(cand_s, K)
    idx = jnp.take_along_axis(cand_i, top_pos, axis=-1)
    gate = jax.nn.softmax(top_s, axis=-1).astype(x.dtype)
    nblk = T // PEER_BLOCK
    xb = xt.reshape(nblk, PEER_BLOCK, D)
    ib = idx.reshape(nblk, PEER_BLOCK, PEER_HEADS * K)
    gb = gate.reshape(nblk, PEER_BLOCK, PEER_HEADS * K)

    def one_block(args):
        xc, ic, gc = args
        u = jnp.take(peer_down, ic, axis=0)
        hcur = jax.nn.gelu(jnp.einsum('ped,pd->pe', u, xc), approximate=False)
        vv = jnp.take(peer_up, ic, axis=0)
        return jnp.einsum('pe,ped->pd', hcur * gc, vv)

    out = lax.map(one_block, (xb, ib, gb))
    return out.reshape(B, LP, D)


def hybrid_layer(h, valid, norm1_g, w_in, shift_mu, w0, w_up, a0, a_up, g_up, k_k, k_a, r_k,
                 gn_w, gn_b, q_gain, k_gain, sinks, w_out, norm2_g,
                 peer_query, peer_sub_keys, peer_down, peer_up):
    u = rms_norm(h, norm1_g)
    p = u @ w_in
    p_attn, p_rwkv = p[..., :ATTN_COLS], p[..., ATTN_COLS:]
    q, k, v = split_cols(p_attn, (ATTN_WIDTH, KV_WIDTH, KV_WIDTH))
    p_rwkv = token_shift(p_rwkv, shift_mu)
    pr, pk, pv, pw, pa, pg = split_cols(
        p_rwkv, (RWKV_WIDTH, RWKV_WIDTH, RWKV_WIDTH, DECAY_LORA, AAA_LORA, GATE_LORA))
    y_rwkv = rwkv7_time_mix(pr, pk, pv, pw, pa, pg, w0, w_up, a0, a_up, g_up, k_k, k_a, r_k, gn_w, gn_b)
    y_attn = sliding_window_sink_attention(q, k, v, q_gain, k_gain, sinks)
    h = h + jnp.concatenate([y_rwkv, y_attn], axis=-1) @ w_out
    h = h + peer_ffn(rms_norm(h, norm2_g), peer_query, peer_sub_keys, peer_down, peer_up)
    return jnp.where(valid[None, :, None], h, jnp.zeros_like(h))


def setup_inputs(seed: int = 0) -> dict:
    key = jax.random.key(seed)
    ks = jax.random.split(key, 26)
    f32 = jnp.float32

    def nrm(k, shape, scale):
        return jax.random.normal(k, shape, f32) * scale

    return {
        'x': nrm(ks[0], (BATCH, SEQ, D_MODEL), 1.0),
        'meta_tokens': nrm(ks[1], (N_META, D_MODEL), 1.0),
        'norm1_g': 1.0 + nrm(ks[2], (DEPTH, D_MODEL), 0.02),
        'w_in': nrm(ks[3], (DEPTH, D_MODEL, IN_COLS), D_MODEL ** -0.5),
        'shift_mu': jax.random.uniform(ks[4], (DEPTH, RWKV_COLS), f32),
        'w0': jax.random.uniform(ks[5], (DEPTH, RWKV_WIDTH), f32, -6.5, -1.5),
        'w_up': nrm(ks[6], (DEPTH, DECAY_LORA, RWKV_WIDTH), 0.1 * DECAY_LORA ** -0.5),
        'a0': nrm(ks[7], (DEPTH, RWKV_WIDTH), 0.1),
        'a_up': nrm(ks[8], (DEPTH, AAA_LORA, RWKV_WIDTH), 0.5 * AAA_LORA ** -0.5),
        'g_up': nrm(ks[9], (DEPTH, GATE_LORA, RWKV_WIDTH), GATE_LORA ** -0.5),
        'k_k': 0.85 + nrm(ks[10], (DEPTH, RWKV_WIDTH), 0.02),
        'k_a': 1.0 + nrm(ks[11], (DEPTH, RWKV_WIDTH), 0.02),
        'r_k': nrm(ks[12], (DEPTH, RWKV_HEADS, HEAD_DIM), 0.1),
        'gn_w': 1.0 + nrm(ks[13], (DEPTH, RWKV_WIDTH), 0.02),
        'gn_b': nrm(ks[14], (DEPTH, RWKV_WIDTH), 0.02),
        'q_gain': 1.0 + nrm(ks[15], (DEPTH, HEAD_DIM), 0.02),
        'k_gain': 1.0 + nrm(ks[16], (DEPTH, HEAD_DIM), 0.02),
        'sinks': nrm(ks[17], (DEPTH, ATTN_Q_HEADS), 0.5),
        'w_out': nrm(ks[18], (DEPTH, MIX_WIDTH, D_MODEL), MIX_WIDTH ** -0.5),
        'norm2_g': 1.0 + nrm(ks[19], (DEPTH, D_MODEL), 0.02),
        'peer_query': nrm(ks[20], (DEPTH, D_MODEL, PEER_HEADS * D_KEY), D_MODEL ** -0.5),
        'peer_sub_keys': nrm(ks[21], (DEPTH, PEER_HEADS, 2, N_KEYS, D_KEY // 2), (D_KEY // 2) ** -0.5),
        'peer_down': nrm(ks[22], (DEPTH, N_EXPERTS, D_MODEL), D_MODEL ** -0.5),
        'peer_up': nrm(ks[23], (DEPTH, N_EXPERTS, D_MODEL), PEER_HEADS ** -0.5),
    }


def reference(x, meta_tokens, norm1_g, w_in, shift_mu, w0, w_up, a0, a_up, g_up, k_k, k_a, r_k,
              gn_w, gn_b, q_gain, k_gain, sinks, w_out, norm2_g,
              peer_query, peer_sub_keys, peer_down, peer_up):
    B, S, D = x.shape
    meta = jnp.broadcast_to(meta_tokens.astype(x.dtype)[None], (B, N_META, D))
    h = jnp.concatenate([jnp.zeros((B, PAD_LEFT, D), x.dtype), meta, x], axis=1)
    valid = jnp.arange(h.shape[1]) >= PAD_LEFT
    for i in range(DEPTH):
        h = hybrid_layer(h, valid, norm1_g[i], w_in[i], shift_mu[i], w0[i], w_up[i], a0[i], a_up[i],
                         g_up[i], k_k[i], k_a[i], r_k[i], gn_w[i], gn_b[i], q_gain[i], k_gain[i],
                         sinks[i], w_out[i], norm2_g[i], peer_query[i], peer_sub_keys[i],
                         peer_down[i], peer_up[i])
    return h[:, BLOCK:]
```

```cpp
#include <hip/hip_runtime.h>
#include <cstdio>
#include <cstdint>
namespace pg8 {
#define PG8_LAS __attribute__((address_space(3)))
typedef unsigned short bf16_t;
typedef short bf16x8 __attribute__((ext_vector_type(8)));
typedef float f32x4 __attribute__((ext_vector_type(4)));
typedef unsigned u32x4 __attribute__((ext_vector_type(4)));
constexpr int BM = 256, BK = 64, HALF = 128, HTB = HALF * BK * 2  , STAGE_BYTES = 8 * HTB, NXCD = 8, WGM = 8;

__host__ __device__ __forceinline__ int lds_byte(int r, int c) { const int st = (r >> 4) * 2 + (c >> 5), rr = r & 15, cc = c & 31, ob = rr * 64 + cc * 2; return st * 1024 + (ob ^ (((ob >> 9) & 1) << 5)); }
__host__ __device__ __forceinline__ void stage_rc(int b, int& R, int& C) { const int st = b / 1024, sb = b % 1024, swz = sb ^ (((sb >> 9) & 1) << 5); R = (st >> 1) * 16 + swz / 64; C = (st & 1) * 32 + (swz % 64) / 2; }
__host__ __device__ __forceinline__ int perm32(int rho) { const int n = rho >> 4, i = rho & 15; return 8 * (i >> 2) + 4 * n + (i & 3); }

struct Unit { int pm, pn; };
struct Gemm { const bf16_t* A; const bf16_t* Bt; int M, N, K; };

struct StaticOrder {
    int nM, nN, nwg, G, c;
    __host__ __device__ void init(int M, int N, int G_, int c_) { nM = M / BM; nN = N / BM; nwg = nM * nN; G = G_; c = c_; }
    __host__ __device__ bool next(int i, Unit& u) const {
        const long L = (long)i * G + c; if (L >= nwg) return false;
        int wgid = (int)L; { const int q = nwg / NXCD, r = nwg % NXCD, xcd = wgid % NXCD, off = wgid / NXCD; wgid = (xcd < r ? xcd * (q + 1) : r * (q + 1) + (xcd - r) * q) + off; }
        const int nig = WGM * nN, gid = wgid / nig, fm = gid * WGM, gsz = (nM - fm) < WGM ? (nM - fm) : WGM;
        u.pm = fm + ((wgid % nig) % gsz); u.pn = (wgid % nig) / gsz; return true;
    }
    __device__ __forceinline__ void a_ready(const Unit&) const {}
    __device__ __forceinline__ void done(const Unit&) const {}
};

__device__ __forceinline__ unsigned cvt_pk_bf16(float lo, float hi) { unsigned r; asm volatile("v_cvt_pk_bf16_f32 %0, %1, %2" : "=v"(r) : "v"(lo), "v"(hi)); return r; }
typedef float f32x2 __attribute__((ext_vector_type(2)));
__device__ __forceinline__ f32x2 gelu_pk(f32x2 v) {
    const f32x2 av = __builtin_elementwise_abs(v), d = av * 0.2316418882f + 1.0f;
    f32x2 t; t.x = __builtin_amdgcn_rcpf(d.x); t.y = __builtin_amdgcn_rcpf(d.y);
    f32x2 q = t * 0.5307027145f + (-0.7265760135f); q = q * t + 0.7107068705f; q = q * t + (-0.142248368f); q = q * t + 0.127414796f; q = q * t;
    const f32x2 s = (v * v) * (-0.72134752044f);
    f32x2 e; e.x = __builtin_amdgcn_exp2f(s.x); e.y = __builtin_amdgcn_exp2f(s.y);
    const f32x2 m = v * (q * e), r = v - m;
    f32x2 o; o.x = v.x < 0.f ? m.x : r.x; o.y = v.y < 0.f ? m.y : r.y; return o;
}

template <int ACT  > struct EpiBf16 {
    static constexpr bool PERM = true, AFTER_DRAIN = false; static_assert(ACT == 0 || ACT == 1, "EpiBf16: ACT is 0 (none) or 1 (gelu_pk)");
    bf16_t* O; int ldc; const float* bias; int split_cols; size_t split_stride; float scale0;
    __device__ __forceinline__ void operator()(const f32x4 (&acc)[2][2][4][2], const Unit& u, int wr, int wc, int fr, int fq) const {
        const int row0 = u.pm * BM + wr * 64 + fr; int colt = u.pn * BM; bf16_t* base = O;
        float sc = 1.f; if (split_cols) { const int t = colt / split_cols; base += (size_t)t * split_stride; colt -= t * split_cols; if (t == 0) sc = scale0; }
        const int col0 = colt + wc * 32 + 8 * fq, bcol0 = u.pn * BM + wc * 32 + 8 * fq;
        f32x4 bv[2][2];
#pragma unroll
        for (int bj = 0; bj < 2; ++bj)
#pragma unroll
            for (int n = 0; n < 2; ++n) bv[bj][n] = bias ? *(const f32x4*)(bias + bcol0 + bj * HALF + 4 * n) : (f32x4){0.f, 0.f, 0.f, 0.f};
#pragma unroll
        for (int ai = 0; ai < 2; ++ai)
#pragma unroll
            for (int m = 0; m < 4; ++m) { bf16_t* rowp = base + (size_t)(row0 + ai * HALF + m * 16) * ldc + col0;
#pragma unroll
                for (int bj = 0; bj < 2; ++bj) { f32x4 v0 = acc[ai][bj][m][0] + bv[bj][0], v1 = acc[ai][bj][m][1] + bv[bj][1];
                    if (ACT == 1) { f32x2 a = gelu_pk((f32x2){v0[0], v0[1]}), b = gelu_pk((f32x2){v0[2], v0[3]}), c = gelu_pk((f32x2){v1[0], v1[1]}), d = gelu_pk((f32x2){v1[2], v1[3]});
                        v0 = (f32x4){a.x, a.y, b.x, b.y}; v1 = (f32x4){c.x, c.y, d.x, d.y}; }
                    v0 = v0 * sc; v1 = v1 * sc; u32x4 w; w.x = cvt_pk_bf16(v0[0], v0[1]); w.y = cvt_pk_bf16(v0[2], v0[3]); w.z = cvt_pk_bf16(v1[0], v1[1]); w.w = cvt_pk_bf16(v1[2], v1[3]);
                    *(u32x4*)(rowp + bj * HALF) = w; } }
    }
};

typedef unsigned u32x2 __attribute__((ext_vector_type(2)));
struct EpiOut {
    static constexpr bool PERM = false, AFTER_DRAIN = false;
    const float* x; float* out; bf16_t* hb; float* sumsq; int ldc;
    __device__ __forceinline__ void operator()(const f32x4 (&acc)[2][2][4][2], const Unit& u, int wr, int wc, int fr, int fq) const {
        const int row0 = u.pm * BM + wr * 64 + fr, col0 = u.pn * BM + wc * 32 + 4 * fq;
#pragma unroll
        for (int ai = 0; ai < 2; ++ai)
#pragma unroll
            for (int m = 0; m < 4; ++m) {
                const int row = row0 + ai * HALF + m * 16; const size_t off = (size_t)row * ldc + col0; float ss = 0.f;
#pragma unroll
                for (int bj = 0; bj < 2; ++bj)
#pragma unroll
                    for (int n = 0; n < 2; ++n) {
                        const size_t o = off + bj * HALF + n * 16;
                        const f32x4 xv = *(const f32x4*)(x + o); const f32x4 v = xv + acc[ai][bj][m][n];
                        *(f32x4*)(out + o) = v;
                        ss += (v[0] * v[0] + v[1] * v[1]) + (v[2] * v[2] + v[3] * v[3]);
                        u32x2 w; w.x = cvt_pk_bf16(v[0], v[1]); w.y = cvt_pk_bf16(v[2], v[3]); *(u32x2*)(hb + o) = w;
                    }
                ss += __shfl_xor(ss, 16); ss += __shfl_xor(ss, 32);
                if (fq == 0) atomicAdd(sumsq + row, ss);
            }
    }
};
struct EpiScores {
    static constexpr bool PERM = false, AFTER_DRAIN = false;
    const float* sumsq; float* S; int ldc; float eps;
    __device__ __forceinline__ void operator()(const f32x4 (&acc)[2][2][4][2], const Unit& u, int wr, int wc, int fr, int fq) const {
        const int row0 = u.pm * BM + wr * 64 + fr, col0 = u.pn * BM + wc * 32 + 4 * fq;
#pragma unroll
        for (int ai = 0; ai < 2; ++ai)
#pragma unroll
            for (int m = 0; m < 4; ++m) {
                const int row = row0 + ai * HALF + m * 16; const size_t off = (size_t)row * ldc + col0;
                const float rs = 1.0f / sqrtf(sumsq[row] * (1.0f / 2048.0f) + eps);
#pragma unroll
                for (int bj = 0; bj < 2; ++bj)
#pragma unroll
                    for (int n = 0; n < 2; ++n) *(f32x4*)(S + off + bj * HALF + n * 16) = acc[ai][bj][m][n] * rs;
            }
    }
};
template <class Epi, class Sched, bool ALIGN_EPI = false, bool SP2 = false>
__device__ __forceinline__ void gemm_phase(PG8_LAS unsigned char* lds, const Gemm g, const Sched& S, const Epi& E) {
    const int tid = threadIdx.x, wid = __builtin_amdgcn_readfirstlane(tid >> 6), lane = tid & 63, wr = wid >> 2, wc = wid & 3, fr = lane & 15, fq = lane >> 4;
    const int K = g.K, nt = K / BK;
    unsigned voffA[2], voffB[2];
#pragma unroll
    for (int i = 0; i < 2; ++i) { int R, C; stage_rc(tid * 16 + i * 8192, R, C); const int Rb = Epi::PERM ? ((R & ~31) + perm32(R & 31)) : R;
        voffA[i] = (unsigned)(R * K + C) * 2u; voffB[i] = (unsigned)(Rb * K + C) * 2u; }
    const size_t kstep = (size_t)(BK * 2);
    const size_t hstep = (size_t)HALF * K * 2;
    const size_t tstep = 2 * hstep;
    const unsigned ldsw = (unsigned)wid * 1024u;
    const int aoff = lds_byte(wr * 64 + fr, fq * 8), boff = lds_byte(wc * 32 + fr, fq * 8);
#define PG8_SA(b, h) (((b) * 2 + (h)) * HTB)
#define PG8_SB(b, h) ((4 + (b) * 2 + (h)) * HTB)
#define PG8_STAGE(bufoff, gbase, voff) do { _Pragma("unroll") for (int _i = 0; _i < 2; ++_i) \
        __builtin_amdgcn_global_load_lds((const unsigned*)((const char*)(gbase) + (voff)[_i]), (PG8_LAS unsigned*)(lds + (bufoff) + ldsw + _i * 8192), 16, 0, 0); } while (0)
#define PG8_LDA(dst, b, h) do { _Pragma("unroll") for (int m = 0; m < 4; ++m) _Pragma("unroll") for (int k = 0; k < 2; ++k) dst[m][k] = *(const PG8_LAS bf16x8*)(lds + PG8_SA(b, h) + aoff + m * 2048 + k * 1024); } while (0)
#define PG8_LDB(dst, b, h) do { _Pragma("unroll") for (int n = 0; n < 2; ++n) _Pragma("unroll") for (int k = 0; k < 2; ++k) dst[n][k] = *(const PG8_LAS bf16x8*)(lds + PG8_SB(b, h) + boff + n * 2048 + k * 1024); } while (0)
#define PG8_MMA(ai, bj, At, Bt) do { __builtin_amdgcn_s_setprio(1); _Pragma("unroll") for (int m = 0; m < 4; ++m) _Pragma("unroll") for (int n = 0; n < 2; ++n) _Pragma("unroll") for (int k = 0; k < 2; ++k) \
        acc[ai][bj][m][n] = __builtin_amdgcn_mfma_f32_16x16x32_bf16(Bt[n][k], At[m][k], acc[ai][bj][m][n], 0, 0, 0); __builtin_amdgcn_s_setprio(0); } while (0)
#define PG8_WAIT_V(n) asm volatile("s_waitcnt vmcnt(" #n ")" ::: "memory")
#define PG8_WAIT_L(n) asm volatile("s_waitcnt lgkmcnt(" #n ")" ::: "memory")
#define PG8_BAR __builtin_amdgcn_s_barrier()
#define PG8_SCHED __builtin_amdgcn_sched_barrier(0)
    Unit cur, nxt; int ui = 0;
    if (!S.next(0, cur)) return;
    f32x4 acc[2][2][4][2];
#pragma unroll
    for (int a = 0; a < 2; ++a)
#pragma unroll
        for (int b = 0; b < 2; ++b)
#pragma unroll
            for (int m = 0; m < 4; ++m)
#pragma unroll
                for (int n = 0; n < 2; ++n) acc[a][b][m][n] = (f32x4){0.f, 0.f, 0.f, 0.f};
    bf16x8 At[4][2], B0[2][2], B1[2][2];
    const char* cA = (const char*)g.A + (size_t)cur.pm * tstep; const char* cB = (const char*)g.Bt + (size_t)cur.pn * tstep;
    S.a_ready(cur);
    if constexpr (SP2) {
        PG8_STAGE(PG8_SB(0, 0), cB, voffB); PG8_STAGE(PG8_SB(0, 1), cB + hstep, voffB); PG8_STAGE(PG8_SA(0, 0), cA, voffA); PG8_STAGE(PG8_SA(0, 1), cA + hstep, voffA);
        if (wr == 1) PG8_BAR;
        PG8_WAIT_V(2); PG8_BAR;
        PG8_STAGE(PG8_SB(1, 0), cB + kstep, voffB); PG8_STAGE(PG8_SA(1, 0), cA + kstep, voffA); PG8_STAGE(PG8_SB(1, 1), cB + hstep + kstep, voffB);
        PG8_WAIT_V(6); PG8_BAR;
    } else {
        PG8_STAGE(PG8_SB(0, 0), cB, voffB); PG8_STAGE(PG8_SA(0, 0), cA, voffA); PG8_STAGE(PG8_SB(0, 1), cB + hstep, voffB); PG8_STAGE(PG8_SA(0, 1), cA + hstep, voffA);
        if (wr == 1) PG8_BAR;
        PG8_WAIT_V(4); PG8_BAR;
        PG8_STAGE(PG8_SB(1, 0), cB + kstep, voffB); PG8_STAGE(PG8_SA(1, 0), cA + kstep, voffA); PG8_STAGE(PG8_SB(1, 1), cB + hstep + kstep, voffB);
        PG8_WAIT_V(6); PG8_BAR;
    }
    for (;;) {
        const bool has_next = S.next(ui + 1, nxt);
        const char* nA = has_next ? (const char*)g.A + (size_t)nxt.pm * tstep : cA; const char* nB = has_next ? (const char*)g.Bt + (size_t)nxt.pn * tstep : cB;
        for (int t = 0; t < nt; t += 2) {
            const bool last = (t == nt - 2);
            const char* a1 = cA + (size_t)(t + 1) * kstep;
            const char* a2 = last ? nA : cA + (size_t)(t + 2) * kstep; const char* b2 = last ? nB : cB + (size_t)(t + 2) * kstep;
            const char* a3 = a2 + kstep; const char* b3 = b2 + kstep;
            if (last && has_next) S.a_ready(nxt);
            if constexpr (SP2) {
            PG8_LDB(B0, 0, 0); PG8_LDB(B1, 0, 1); PG8_SCHED; PG8_LDA(At, 0, 0); PG8_STAGE(PG8_SA(1, 1), a1 + hstep, voffA);
            PG8_WAIT_V(8); PG8_WAIT_L(0); PG8_BAR; PG8_MMA(0, 0, At, B0); PG8_MMA(0, 1, At, B1); PG8_BAR; PG8_SCHED;
            PG8_LDA(At, 0, 1); PG8_STAGE(PG8_SB(0, 0), b2, voffB); PG8_STAGE(PG8_SB(0, 1), b2 + hstep, voffB); PG8_STAGE(PG8_SA(0, 0), a2, voffA);
            PG8_WAIT_V(8); PG8_WAIT_L(0); PG8_BAR; PG8_MMA(1, 0, At, B0); PG8_MMA(1, 1, At, B1); PG8_BAR; PG8_SCHED;
            PG8_LDB(B0, 1, 0); PG8_LDB(B1, 1, 1); PG8_SCHED; PG8_LDA(At, 1, 0); PG8_STAGE(PG8_SA(0, 1), a2 + hstep, voffA);
            PG8_WAIT_V(8); PG8_WAIT_L(0); PG8_BAR; PG8_MMA(0, 0, At, B0); PG8_MMA(0, 1, At, B1); PG8_BAR; PG8_SCHED;
            PG8_LDA(At, 1, 1); PG8_STAGE(PG8_SB(1, 0), b3, voffB); PG8_STAGE(PG8_SB(1, 1), b3 + hstep, voffB); PG8_STAGE(PG8_SA(1, 0), a3, voffA);
            PG8_WAIT_V(8); PG8_WAIT_L(0); PG8_BAR; PG8_MMA(1, 0, At, B0); PG8_MMA(1, 1, At, B1); PG8_BAR; PG8_SCHED;
            } else {
            PG8_LDB(B0, 0, 0); PG8_SCHED; PG8_LDA(At, 0, 0); PG8_STAGE(PG8_SA(1, 1), a1 + hstep, voffA);
            PG8_WAIT_L(8); PG8_BAR; PG8_WAIT_L(0); PG8_MMA(0, 0, At, B0); PG8_BAR; PG8_SCHED;
            PG8_LDB(B1, 0, 1); PG8_STAGE(PG8_SB(0, 0), b2, voffB);
            PG8_BAR; PG8_WAIT_L(0); PG8_MMA(0, 1, At, B1); PG8_BAR;
            PG8_LDA(At, 0, 1); PG8_STAGE(PG8_SA(0, 0), a2, voffA);
            PG8_BAR; PG8_WAIT_L(0); PG8_MMA(1, 0, At, B0); PG8_BAR; PG8_SCHED;
            PG8_STAGE(PG8_SB(0, 1), b2 + hstep, voffB);
            PG8_WAIT_V(6); PG8_BAR; PG8_MMA(1, 1, At, B1); PG8_BAR;
            PG8_LDB(B0, 1, 0); PG8_SCHED; PG8_LDA(At, 1, 0); PG8_STAGE(PG8_SA(0, 1), a2 + hstep, voffA);
            PG8_WAIT_L(8); PG8_BAR; PG8_WAIT_L(0); PG8_MMA(0, 0, At, B0); PG8_BAR; PG8_SCHED;
            PG8_LDB(B1, 1, 1); PG8_STAGE(PG8_SB(1, 0), b3, voffB);
            PG8_BAR; PG8_WAIT_L(0); PG8_MMA(0, 1, At, B1); PG8_BAR;
            PG8_LDA(At, 1, 1); PG8_STAGE(PG8_SA(1, 0), a3, voffA);
            PG8_BAR; PG8_WAIT_L(0); PG8_MMA(1, 0, At, B0); PG8_BAR; PG8_SCHED;
            PG8_STAGE(PG8_SB(1, 1), b3 + hstep, voffB);
            PG8_WAIT_V(6); PG8_BAR; PG8_MMA(1, 1, At, B1); PG8_BAR;
            }
        }
        if constexpr (ALIGN_EPI) { if (wr == 0) PG8_BAR; }
        if constexpr (!Epi::AFTER_DRAIN) { E(acc, cur, wr, wc, fr, fq); S.done(cur); }
        if (!has_next) break;
#pragma unroll
        for (int a = 0; a < 2; ++a)
#pragma unroll
            for (int b = 0; b < 2; ++b)
#pragma unroll
                for (int m = 0; m < 4; ++m)
#pragma unroll
                    for (int n = 0; n < 2; ++n) acc[a][b][m][n] = (f32x4){0.f, 0.f, 0.f, 0.f};
        cur = nxt; cA = nA; cB = nB; ++ui;
        if constexpr (ALIGN_EPI) { if (wr == 1) PG8_BAR; }
    }
    PG8_WAIT_V(0);
    if constexpr (!ALIGN_EPI) { if (wr == 0) PG8_BAR; }
    PG8_BAR;
    if constexpr (Epi::AFTER_DRAIN) { E.fused(acc, cur, wr, wc, fr, fq, lds, wid, lane); S.done(cur); }
#undef PG8_SA
#undef PG8_SB
#undef PG8_STAGE
#undef PG8_LDA
#undef PG8_LDB
#undef PG8_MMA
#undef PG8_WAIT_V
#undef PG8_WAIT_L
#undef PG8_BAR
#undef PG8_SCHED
}
}
#define GAS __attribute__((address_space(1)))
#define LAS __attribute__((address_space(3)))
typedef unsigned short bf16;
typedef unsigned v4u __attribute__((ext_vector_type(4)));
typedef float f32x4 __attribute__((ext_vector_type(4)));
typedef short bf16x8 __attribute__((ext_vector_type(8)));
typedef GAS unsigned gu32;
typedef GAS unsigned long long gu64;
#define RLX_AGENT __ATOMIC_RELAXED, __HIP_MEMORY_SCOPE_AGENT
#define LDS_WAIT() asm volatile("s_waitcnt lgkmcnt(0)" ::: "memory")
#define VM_WAIT() asm volatile("s_waitcnt vmcnt(0)" ::: "memory")
__device__ __forceinline__ unsigned long long rt() { return __builtin_amdgcn_s_memrealtime(); }
__device__ __forceinline__ unsigned f2bf(float f) { unsigned u = __builtin_bit_cast(unsigned, f); return (u + 0x7fffu + ((u >> 16) & 1u)) >> 16; }
__device__ __forceinline__ unsigned pk2(float lo, float hi) { return f2bf(lo) | (f2bf(hi) << 16); }

#define XB_TMO      128
#define XB_XCNT(j)  (256  + 64 * (j))
#define XB_XSUB(j)  (1280 + 64 * (j))
#define XB_XGEN(j)  (2304 + 64 * (j))
#define XB_TOP      3328
#define XB_TOPGEN   3392
#define XCD_BAR_WORDS 3456
#define XB_SPIN_CAP (1u << 18)

__device__ __forceinline__ unsigned xb_ld(unsigned* p)              { return __hip_atomic_load(p, __ATOMIC_RELAXED, __HIP_MEMORY_SCOPE_AGENT); }
__device__ __forceinline__ unsigned xb_add(unsigned* p, unsigned v) { return __hip_atomic_fetch_add(p, v, __ATOMIC_RELAXED, __HIP_MEMORY_SCOPE_AGENT); }
__device__ __forceinline__ unsigned xb_xcc_id() { return (unsigned)__builtin_amdgcn_s_getreg((3 << 11) | 20) & 0xFu; }
#define XB_SPIN(cond, bar) do { unsigned _sp = 0; while (cond) { __builtin_amdgcn_s_sleep(1); \
    if ((++_sp & 255u) == 0u) { if (xb_ld(&(bar)[XB_TMO])) break; if (_sp > XB_SPIN_CAP) { atomicAdd(&(bar)[XB_TMO], 1u); break; } } } } while (0)

struct XcdBarrier {
    unsigned* bar; unsigned x;
    volatile LAS unsigned* st;
};

__device__ __forceinline__ XcdBarrier xcd_barrier_post(unsigned* bar, volatile LAS unsigned* st) {
    XcdBarrier b; b.bar = bar; b.x = xb_xcc_id(); b.st = st;
    if (threadIdx.x == 0) (void)xb_add(&bar[XB_XCNT(b.x)], 1u);
    return b;
}
__device__ __forceinline__ void xcd_barrier_complete(unsigned* bar, unsigned x, unsigned& nloc, unsigned& nx) {
    const unsigned G = gridDim.x * gridDim.y * gridDim.z;
    unsigned sum, cnt, mine, sp = 0u;
    for (;;) {
        sum = 0u; cnt = 0u; mine = 0u;
#pragma unroll
        for (unsigned j = 0; j < 16; ++j) { const unsigned c = xb_ld(&bar[XB_XCNT(j)]); sum += c; cnt += (c > 0u) ? 1u : 0u; mine = (j == x) ? c : mine; }
        if (sum == G) break;
        __builtin_amdgcn_s_sleep(1);
        if ((++sp & 255u) == 0u) { if (xb_ld(&bar[XB_TMO])) break; if (sp > XB_SPIN_CAP) { atomicAdd(&bar[XB_TMO], 1u); break; } }
    }
    nloc = mine > 0u ? mine : 1u; nx = cnt > 0u ? cnt : 1u;
}

__device__ __forceinline__ void xcd_barrier(const XcdBarrier& b) {
    asm volatile("s_waitcnt vmcnt(0)" ::: "memory");
    __syncthreads();
    if (threadIdx.x == 0) {
        unsigned* bar = b.bar;
        __builtin_amdgcn_s_waitcnt(0);
        unsigned nloc = b.st[0], nx = b.st[1];
        if (nloc == 0u) { xcd_barrier_complete(bar, b.x, nloc, nx); b.st[0] = nloc; b.st[1] = nx; }
        const unsigned old = xb_add(&bar[XB_XSUB(b.x)], 1u);
        const unsigned gen = old / nloc;
        if (old + 1u == (gen + 1u) * nloc) {
            __builtin_amdgcn_fence(__ATOMIC_RELEASE, "agent");
            asm volatile("s_waitcnt vmcnt(0)" ::: "memory");
            const unsigned og = xb_add(&bar[XB_TOP], 1u);
            const unsigned tg = og / nx;
            if (og + 1u == (tg + 1u) * nx) xb_add(&bar[XB_TOPGEN], 1u);
            else XB_SPIN(xb_ld(&bar[XB_TOPGEN]) == tg, bar);
            __builtin_amdgcn_fence(__ATOMIC_ACQUIRE, "agent");
            xb_add(&bar[XB_XGEN(b.x)], 1u);
            asm volatile("s_waitcnt vmcnt(0)" ::: "memory");
        } else {
            XB_SPIN(xb_ld(&bar[XB_XGEN(b.x)]) == gen, bar);
            __builtin_amdgcn_fence(__ATOMIC_ACQUIRE, "agent");
            asm volatile("s_waitcnt vmcnt(0)" ::: "memory");
        }
    }
    __syncthreads();
}

#define DI __device__ __forceinline__
constexpr int NWAVES = 8, NTHR = 512;
constexpr int BATCH = 4, SEQ = 4096, DM = 2048, TR = BATCH * SEQ, NMETA = 16, MIN_ROWS = 16640;
constexpr int INC = 4640, NP = 4864;
constexpr int CQ = 0, CK = 1024, CV = 1152, CR = 1280, CPK = 2304, CPV = 3328, CW = 4352, CA = 4416, CG = 4480;
constexpr int NEXP = 16384, NSEL = 128;
constexpr float RMS_EPS = 1e-6f, GN_EPS = 64e-5f;
constexpr int NPHASE = 7;
#ifndef MK_SPLIT
#define MK_SPLIT 1
#endif

constexpr size_t MiB = 1u << 20;
constexpr size_t WS_CTL = 0, CTL_ZERO_BYTES = 1 * MiB;
constexpr size_t WS_WIN = 1 * MiB, WS_WOUT = 20 * MiB, WS_WQS = 28 * MiB, WS_SUMSQ = 36 * MiB;
constexpr size_t WS_U = 40 * MiB;
constexpr size_t WS_P = 106 * MiB;
constexpr size_t WS_TD = 262 * MiB, WS_TU = 326 * MiB;
constexpr size_t WS_IDX = 390 * MiB, WS_GATE = 398 * MiB, WS_END = 406 * MiB;
constexpr size_t WS_SC = 40 * MiB;
constexpr size_t WS_H1B = 170 * MiB;
static_assert(WS_U + (size_t)MIN_ROWS * DM * 2 <= WS_P && WS_P + (size_t)MIN_ROWS * NP * 2 <= WS_TD && WS_SC + (size_t)TR * DM * 4 <= WS_H1B && WS_H1B + (size_t)TR * DM * 2 <= WS_TD, "ws map");
constexpr int CW_BAR = 4096;
constexpr int RING_BYTES = 131072, LDSCTL_OFF = RING_BYTES, MISC_OFF = LDSCTL_OFF + 320, LDS_BYTES = 147456;

DI float bflo(unsigned w) { return __uint_as_float(w << 16); }
DI float bfhi(unsigned w) { return __uint_as_float(w & 0xffff0000u); }
DI float wave_sum(float v) {
#pragma unroll
    for (int o = 1; o < 64; o <<= 1) v += __shfl_xor(v, o);
    return v;
}
template <int CTRL> DI float dppf(float v) { return __int_as_float(__builtin_amdgcn_update_dpp(0, __float_as_int(v), CTRL, 0xf, 0xf, true)); }
DI float red8(float v) { v += dppf<0xB1>(v); v += dppf<0x4E>(v); v += dppf<0x141>(v); return v; }
DI float red16(float v) { v = red8(v); v += dppf<0x140>(v); return v; }
DI float max16(float v) { v = fmaxf(v, dppf<0xB1>(v)); v = fmaxf(v, dppf<0x4E>(v)); v = fmaxf(v, dppf<0x141>(v)); v = fmaxf(v, dppf<0x140>(v)); return v; }
DI float rdlane(float v, int l) { return __int_as_float(__builtin_amdgcn_readlane(__float_as_int(v), l)); }
DI float wave_max(float v) {
    v = max16(v);
    const float a = rdlane(v, 0), b = rdlane(v, 16), c = rdlane(v, 32), d = rdlane(v, 48);
    return fmaxf(fmaxf(a, b), fmaxf(c, d));
}
DI float sigmoidf_(float x) { return 1.0f / (1.0f + __expf(-x)); }
DI float softplusf_(float x) { return fmaxf(x, 0.f) + log1pf(__expf(-fabsf(x))); }
typedef unsigned u32x2 __attribute__((ext_vector_type(2)));
typedef float f32x16 __attribute__((ext_vector_type(16)));
DI int crow(int reg, int h) { return (reg & 3) + 8 * (reg >> 2) + 4 * h; }
#define MFMA32(a, b, c) __builtin_amdgcn_mfma_f32_32x32x16_bf16((a), (b), (c), 0, 0, 0)

struct Frame {
    LAS unsigned char* lds;
    volatile LAS unsigned* MISC;
    gu32* ctl;
    int tid, lane, wave;
    int vcu, G;
    const float* in[24];
    float* out; unsigned char* ws;
};
#define IN_X 0
#define IN_META 1
#define IN_N1G 2
#define IN_WIN 3
#define IN_MU 4
#define IN_W0 5
#define IN_WUP 6
#define IN_A0 7
#define IN_AUP 8
#define IN_GUP 9
#define IN_KK 10
#define IN_KA 11
#define IN_RK 12
#define IN_GNW 13
#define IN_GNB 14
#define IN_QG 15
#define IN_KG 16
#define IN_SINK 17
#define IN_WOUT 18
#define IN_N2G 19
#define IN_PQ 20
#define IN_PSK 21
#define IN_PD 22
#define IN_PU 23

DI void p0_transpose_item(const float* W, int K, int N, bf16* WT, int row_off, LAS float* scr, int item, int lane) {
    const int nblk = N / 32, kb = item / nblk, nb = item % nblk, k0 = 64 * kb, n0 = 32 * nb;
#pragma unroll 8
    for (int i = 0; i < 32; ++i) { const int kk = 2 * i + (lane >> 5); scr[kk * 33 + (lane & 31)] = W[(size_t)(k0 + kk) * N + n0 + (lane & 31)]; }
    LDS_WAIT(); asm volatile("" ::: "memory");
    const int c = lane & 7;
#pragma unroll
    for (int j = 0; j < 4; ++j) { const int n = (lane >> 3) + 8 * j; const LAS float* s = scr + (8 * c) * 33 + n;
        v4u o; o.x = pk2(s[0 * 33], s[1 * 33]); o.y = pk2(s[2 * 33], s[3 * 33]); o.z = pk2(s[4 * 33], s[5 * 33]); o.w = pk2(s[6 * 33], s[7 * 33]);
        *(GAS v4u*)(WT + (size_t)(row_off + n0 + n) * K + k0 + 8 * c) = o; }
    LDS_WAIT(); asm volatile("" ::: "memory");
}
DI void rms_row_to_bf16(const float* xrow, const float* g, bf16* orow, int lane) {
    const GAS f32x4* xr = (const GAS f32x4*)xrow + lane; const GAS f32x4* gr = (const GAS f32x4*)g + lane;
    f32x4 v[8]; float s = 0.f;
#pragma unroll
    for (int j = 0; j < 8; ++j) { v[j] = xr[64 * j]; s += (v[j].x * v[j].x + v[j].y * v[j].y) + (v[j].z * v[j].z + v[j].w * v[j].w); }
    const float rs = 1.0f / sqrtf(wave_sum(s) * (1.0f / DM) + RMS_EPS);
    GAS unsigned long long* o8 = (GAS unsigned long long*)orow + lane;
#pragma unroll
    for (int j = 0; j < 8; ++j) { const f32x4 gg = gr[64 * j];
        o8[64 * j] = (unsigned long long)pk2(v[j].x * rs * gg.x, v[j].y * rs * gg.y) | ((unsigned long long)pk2(v[j].z * rs * gg.z, v[j].w * rs * gg.w) << 32); }
}
DI void p0_prologue(Frame& F) {
    const int tid = F.tid, lane = F.lane, wave = F.wave;
    const int gw = F.vcu * NWAVES + wave, NGW = F.G * NWAVES;
    const size_t gt = (size_t)blockIdx.x * NTHR + tid, NT = (size_t)F.G * NTHR;
    bf16* Win_t = (bf16*)(F.ws + WS_WIN); bf16* Wout_t = (bf16*)(F.ws + WS_WOUT); bf16* Wqs_t = (bf16*)(F.ws + WS_WQS);
    bf16* U = (bf16*)(F.ws + WS_U); bf16* TD = (bf16*)(F.ws + WS_TD); bf16* TU = (bf16*)(F.ws + WS_TU);
    float* sumsq = (float*)(F.ws + WS_SUMSQ);
    {
        LAS float* scr = (LAS float*)(F.lds + wave * 16384);
        constexpr int I_IN = (DM / 64) * (INC / 32), I_OUT = (DM / 64) * (DM / 32);
        for (int it = gw; it < I_IN + I_OUT; it += NGW) {
            if (it < I_IN) p0_transpose_item(F.in[IN_WIN], DM, INC, Win_t, 0, scr, it, lane);
            else p0_transpose_item(F.in[IN_WOUT], DM, DM, Wout_t, 0, scr, it - I_IN, lane);
        }
        const size_t nz = (size_t)(NP - INC) * DM * 2 / 16;
        GAS v4u* z = (GAS v4u*)(Win_t + (size_t)INC * DM);
        for (size_t i = gt; i < nz; i += NT) z[i] = (v4u){0u, 0u, 0u, 0u};
    }
    for (int m = gw; m < MIN_ROWS; m += NGW) {
        if (m < TR) rms_row_to_bf16(F.in[IN_X] + (size_t)m * DM, F.in[IN_N1G], U + (size_t)m * DM, lane);
        else if (m < TR + NMETA) rms_row_to_bf16(F.in[IN_META] + (size_t)(m - TR) * DM, F.in[IN_N1G], U + (size_t)m * DM, lane);
        else { GAS v4u* o = (GAS v4u*)(U + (size_t)m * DM) + lane;
#pragma unroll
            for (int j = 0; j < 4; ++j) o[64 * j] = (v4u){0u, 0u, 0u, 0u}; }
    }
    {
        const size_t NG = (size_t)NEXP * DM / 8;
        const float* g2 = F.in[IN_N2G];
        for (size_t i = gt; i < 2 * NG; i += NT) {
            const bool up = i >= NG; const size_t j = up ? i - NG : i;
            const GAS f32x4* src = (const GAS f32x4*)((up ? F.in[IN_PU] : F.in[IN_PD]) + j * 8);
            f32x4 a = src[0], b = src[1];
            if (!up) { const int col = (int)((j * 8) & (DM - 1)); const f32x4 ga = *(const GAS f32x4*)(g2 + col), gb = *(const GAS f32x4*)(g2 + col + 4); a = a * ga; b = b * gb; }
            v4u o; o.x = pk2(a.x, a.y); o.y = pk2(a.z, a.w); o.z = pk2(b.x, b.y); o.w = pk2(b.z, b.w);
            *(GAS v4u*)((up ? TU : TD) + j * 8) = o;
        }
    }
    for (size_t i = gt; i < (size_t)TR; i += NT) sumsq[i] = 0.f;
    __syncthreads();
    {
        LAS float* sk = (LAS float*)F.lds;
        LAS float* wq = (LAS float*)(F.lds + 128 * 132 * 4);
        const float* PQ = F.in[IN_PQ]; const float* PSK = F.in[IN_PSK]; const float* g2 = F.in[IN_N2G];
        for (int unit = F.vcu; unit < 512; unit += F.G) {
            const int hc = unit >> 5, k0 = (unit & 31) * 64;
            for (int i = tid; i < 128 * 32; i += NTHR) { const int n = i >> 5, d4 = (i & 31) * 4; *(LAS f32x4*)(sk + n * 132 + d4) = *(const GAS f32x4*)(PSK + (size_t)hc * 16384 + n * 128 + d4); }
            for (int i = tid; i < 64 * 32; i += NTHR) { const int k = i >> 5, d4 = (i & 31) * 4; *(LAS f32x4*)(wq + k * 132 + d4) = *(const GAS f32x4*)(PQ + (size_t)(k0 + k) * DM + hc * 128 + d4); }
            __syncthreads();
            const int n4 = tid >> 4, k4 = tid & 15;
            float acc[4][4];
#pragma unroll
            for (int i = 0; i < 4; ++i)
#pragma unroll
                for (int j = 0; j < 4; ++j) acc[i][j] = 0.f;
            for (int d = 0; d < 128; d += 4) {
                f32x4 a[4], b[4];
#pragma unroll
                for (int i = 0; i < 4; ++i) a[i] = *(LAS f32x4*)(sk + (n4 + 32 * i) * 132 + d);
#pragma unroll
                for (int j = 0; j < 4; ++j) b[j] = *(LAS f32x4*)(wq + (k4 + 16 * j) * 132 + d);
#pragma unroll
                for (int i = 0; i < 4; ++i)
#pragma unroll
                    for (int j = 0; j < 4; ++j) acc[i][j] += (a[i].x * b[j].x + a[i].y * b[j].y) + (a[i].z * b[j].z + a[i].w * b[j].w);
            }
#pragma unroll
            for (int i = 0; i < 4; ++i)
#pragma unroll
                for (int j = 0; j < 4; ++j) { const int n = n4 + 32 * i, k = k0 + k4 + 16 * j; Wqs_t[(size_t)(hc * 128 + n) * DM + k] = (bf16)f2bf(acc[i][j] * g2[k]); }
            __syncthreads();
        }
    }
}

DI int attn_keyrow(int b, int n, int kk) {
    if (kk >= 128) return b * SEQ + 128 * n + (kk - 128);
    if (n > 0) return b * SEQ + 128 * (n - 1) + kk;
    return kk >= 112 ? TR + (kk - 112) : -1;
}
DI void attn_unit(Frame& F, int u) {
    const int tid = F.tid, lane = F.lane, wave = F.wave;
    const int b = u >> 6, kvh = (u >> 5) & 1, n = u & 31;
    const bf16* P = (const bf16*)(F.ws + WS_P); bf16* Y = (bf16*)(F.ws + WS_U);
    LAS bf16* Ks = (LAS bf16*)F.lds;
    LAS bf16* VT = (LAS bf16*)(F.lds + 256 * 144);
    const float* kg = F.in[IN_KG]; const float* qg = F.in[IN_QG];
    for (int c = tid; c < 2048; c += NTHR) {
        const int key = c >> 3, ch = c & 7; const int row = attn_keyrow(b, n, key);
        v4u rk = (v4u){0u, 0u, 0u, 0u}, rv = (v4u){0u, 0u, 0u, 0u};
        if (row >= 0) { rk = *(const GAS v4u*)(P + (size_t)row * NP + CK + kvh * 64 + ch * 8); rv = *(const GAS v4u*)(P + (size_t)row * NP + CV + kvh * 64 + ch * 8); }
        float kv[8] = {bflo(rk.x), bfhi(rk.x), bflo(rk.y), bfhi(rk.y), bflo(rk.z), bfhi(rk.z), bflo(rk.w), bfhi(rk.w)};
        float ss = 0.f;
#pragma unroll
        for (int e = 0; e < 8; ++e) ss += kv[e] * kv[e];
        ss = red8(ss);
        const float rs = 1.0f / sqrtf(ss * (1.0f / 64.0f) + RMS_EPS);
#pragma unroll
        for (int e = 0; e < 8; ++e) kv[e] = kv[e] * rs * kg[ch * 8 + e];
        v4u o; o.x = pk2(kv[0], kv[1]); o.y = pk2(kv[2], kv[3]); o.z = pk2(kv[4], kv[5]); o.w = pk2(kv[6], kv[7]);
        *(LAS v4u*)(Ks + key * 72 + ch * 8) = o;
        LAS bf16* vt = VT + (ch * 8) * 260 + key;
        vt[0 * 260] = (bf16)(rv.x & 0xffffu); vt[1 * 260] = (bf16)(rv.x >> 16); vt[2 * 260] = (bf16)(rv.y & 0xffffu); vt[3 * 260] = (bf16)(rv.y >> 16);
        vt[4 * 260] = (bf16)(rv.z & 0xffffu); vt[5 * 260] = (bf16)(rv.z >> 16); vt[6 * 260] = (bf16)(rv.w & 0xffffu); vt[7 * 260] = (bf16)(rv.w >> 16);
    }
    __syncthreads();
    const int r = lane & 31, hh = lane >> 5, hq = kvh * 8 + wave;
    const float sink = F.in[IN_SINK][hq];
#pragma unroll 1
    for (int qb = 0; qb < 4; ++qb) {
        const int qi = 32 * qb + r;
        const size_t qrow = (size_t)(b * SEQ + 128 * n + qi);
        bf16x8 qf[4];
        {
            v4u raw[4]; float ss = 0.f;
#pragma unroll
            for (int s4 = 0; s4 < 4; ++s4) {
                raw[s4] = *(const GAS v4u*)(P + qrow * NP + CQ + hq * 64 + 16 * s4 + 8 * hh);
                const float q0 = bflo(raw[s4].x), q1 = bfhi(raw[s4].x), q2 = bflo(raw[s4].y), q3 = bfhi(raw[s4].y), q4 = bflo(raw[s4].z), q5 = bfhi(raw[s4].z), q6 = bflo(raw[s4].w), q7 = bfhi(raw[s4].w);
                ss += (q0 * q0 + q1 * q1) + (q2 * q2 + q3 * q3) + (q4 * q4 + q5 * q5) + (q6 * q6 + q7 * q7);
            }
            ss += __shfl_xor(ss, 32);
            const float rs = 0.125f / sqrtf(ss * (1.0f / 64.0f) + RMS_EPS);
#pragma unroll
            for (int s4 = 0; s4 < 4; ++s4) {
                const float* gq = qg + 16 * s4 + 8 * hh;
                v4u w;
                w.x = pk2(bflo(raw[s4].x) * rs * gq[0], bfhi(raw[s4].x) * rs * gq[1]);
                w.y = pk2(bflo(raw[s4].y) * rs * gq[2], bfhi(raw[s4].y) * rs * gq[3]);
                w.z = pk2(bflo(raw[s4].z) * rs * gq[4], bfhi(raw[s4].z) * rs * gq[5]);
                w.w = pk2(bflo(raw[s4].w) * rs * gq[6], bfhi(raw[s4].w) * rs * gq[7]);
                qf[s4] = __builtin_bit_cast(bf16x8, w);
            }
        }
        f32x16 acc[5];
        float mx = sink;
#pragma unroll
        for (int j = 0; j < 5; ++j) {
            const int kt = qb + j;
#pragma unroll
            for (int g = 0; g < 16; ++g) acc[j][g] = 0.f;
#pragma unroll
            for (int s4 = 0; s4 < 4; ++s4) { const bf16x8 a = *(const LAS bf16x8*)(Ks + (32 * kt + r) * 72 + 16 * s4 + 8 * hh); acc[j] = MFMA32(a, qf[s4], acc[j]); }
#pragma unroll
            for (int g = 0; g < 16; ++g) {
                const int kk = 32 * kt + crow(g, hh);
                const bool valid = (kk < 128) ? (kk > qi && (n > 0 || kk >= 112)) : (kk - 128 <= qi);
                const float sv = valid ? acc[j][g] : -INFINITY;
                acc[j][g] = sv; mx = fmaxf(mx, sv);
            }
        }
        mx = fmaxf(mx, __shfl_xor(mx, 32));
        float l = 0.f;
#pragma unroll
        for (int j = 0; j < 5; ++j)
#pragma unroll
            for (int g = 0; g < 16; ++g) { const float p = __expf(acc[j][g] - mx); acc[j][g] = p; l += p; }
        l += __shfl_xor(l, 32);
        l += __expf(sink - mx);
        const float inv = 1.0f / l;
        f32x16 o[2];
#pragma unroll
        for (int g = 0; g < 16; ++g) { o[0][g] = 0.f; o[1][g] = 0.f; }
#pragma unroll
        for (int j = 0; j < 5; ++j) {
            const int kt = qb + j;
#pragma unroll
            for (int s2 = 0; s2 < 2; ++s2) {
                v4u w;
                w.x = pk2(acc[j][8 * s2 + 0], acc[j][8 * s2 + 1]); w.y = pk2(acc[j][8 * s2 + 2], acc[j][8 * s2 + 3]);
                w.z = pk2(acc[j][8 * s2 + 4], acc[j][8 * s2 + 5]); w.w = pk2(acc[j][8 * s2 + 6], acc[j][8 * s2 + 7]);
                const bf16x8 pb = __builtin_bit_cast(bf16x8, w);
#pragma unroll
                for (int dt = 0; dt < 2; ++dt) {
                    const LAS bf16* vp = VT + (32 * dt + r) * 260 + 32 * kt + 16 * s2 + 4 * hh;
                    const u32x2 lo = *(const LAS u32x2*)vp, hi = *(const LAS u32x2*)(vp + 8);
                    v4u av; av.x = lo.x; av.y = lo.y; av.z = hi.x; av.w = hi.y;
                    o[dt] = MFMA32(__builtin_bit_cast(bf16x8, av), pb, o[dt]);
                }
            }
        }
#pragma unroll
        for (int dt = 0; dt < 2; ++dt)
#pragma unroll
            for (int gg = 0; gg < 4; ++gg) {
                u32x2 w; w.x = pk2(o[dt][4 * gg + 0] * inv, o[dt][4 * gg + 1] * inv); w.y = pk2(o[dt][4 * gg + 2] * inv, o[dt][4 * gg + 3] * inv);
                *(GAS u32x2*)(Y + qrow * DM + 1024 + hq * 64 + 32 * dt + 8 * gg + 4 * hh) = w;
            }
    }
    __syncthreads();
}

constexpr int RC = 32;
DI int rwkv_row(int b, int sg) { return sg >= 32 ? b * SEQ + (sg - 32) : (sg >= 16 ? TR + (sg - 16) : -1); }
DI void rwkv_bh(Frame& F, int bh) {
    const int tid = F.tid, lane = F.lane, wave = F.wave;
    const int b = bh >> 4, h = bh & 15;
    const bf16* P = (const bf16*)(F.ws + WS_P); bf16* Y = (bf16*)(F.ws + WS_U);
    LAS float* XR = (LAS float*)(F.lds + 0 * 8192);
    LAS float* KM = (LAS float*)(F.lds + 1 * 8192);
    LAS float* XV = (LAS float*)(F.lds + 2 * 8192);
    LAS float* DEC = (LAS float*)(F.lds + 3 * 8192);
    LAS float* BB = (LAS float*)(F.lds + 4 * 8192);
    LAS float* GG = (LAS float*)(F.lds + 5 * 8192);
    LAS float* KK = (LAS float*)(F.lds + 6 * 8192);
    LAS float* YY = (LAS float*)(F.lds + 7 * 8192);
    LAS bf16* TW = (LAS bf16*)(F.lds + 65536);
    LAS bf16* XA = (LAS bf16*)(F.lds + 65536 + 4608);
    LAS bf16* SG = (LAS bf16*)(F.lds + 65536 + 9216);
    LAS bf16* WUt = (LAS bf16*)(F.lds + 86016);
    LAS bf16* AUt = (LAS bf16*)(F.lds + 86016 + 9216);
    LAS bf16* GUt = (LAS bf16*)(F.lds + 86016 + 18432);
    const float* mu = F.in[IN_MU];
    for (int i = tid; i < 64 * 64; i += NTHR) { const int k = i >> 6, nn = i & 63; WUt[nn * 72 + k] = (bf16)f2bf(F.in[IN_WUP][k * 1024 + h * 64 + nn]); AUt[nn * 72 + k] = (bf16)f2bf(F.in[IN_AUP][k * 1024 + h * 64 + nn]); }
    for (int i = tid; i < 160 * 64; i += NTHR) { const int k = i >> 6, nn = i & 63; GUt[nn * 168 + k] = (bf16)f2bf(F.in[IN_GUP][k * 1024 + h * 64 + nn]); }
    float S[8];
#pragma unroll
    for (int e = 0; e < 8; ++e) S[e] = 0.f;
    const int NCH = (32 + SEQ) / RC;
    for (int c = 0; c < NCH; ++c) {
        __syncthreads();
        for (int pi = tid; pi < RC * 60; pi += NTHR) {
            const int tt = pi / 60, pc = pi % 60;
            int col, mui;
            if (pc < 8) { col = CR + h * 64 + pc * 8; mui = h * 64 + pc * 8; }
            else if (pc < 16) { col = CPK + h * 64 + (pc - 8) * 8; mui = 1024 + h * 64 + (pc - 8) * 8; }
            else if (pc < 24) { col = CPV + h * 64 + (pc - 16) * 8; mui = 2048 + h * 64 + (pc - 16) * 8; }
            else { col = CW + (pc - 24) * 8; mui = 3072 + (pc - 24) * 8; }
            const int sg = RC * c + tt; const int row = rwkv_row(b, sg), rowp = rwkv_row(b, sg - 1);
            v4u rc_ = (v4u){0u, 0u, 0u, 0u}, rp_ = (v4u){0u, 0u, 0u, 0u};
            if (row >= 0) rc_ = *(const GAS v4u*)(P + (size_t)row * NP + col);
            if (rowp >= 0) rp_ = *(const GAS v4u*)(P + (size_t)rowp * NP + col);
            const float cu[8] = {bflo(rc_.x), bfhi(rc_.x), bflo(rc_.y), bfhi(rc_.y), bflo(rc_.z), bfhi(rc_.z), bflo(rc_.w), bfhi(rc_.w)};
            const float pr[8] = {bflo(rp_.x), bfhi(rp_.x), bflo(rp_.y), bfhi(rp_.y), bflo(rp_.z), bfhi(rp_.z), bflo(rp_.w), bfhi(rp_.w)};
            float xs[8];
#pragma unroll
            for (int e = 0; e < 8; ++e) xs[e] = cu[e] + mu[mui + e] * (pr[e] - cu[e]);
            if (pc < 24) {
                LAS float* dst = (pc < 8 ? XR : (pc < 16 ? KM : XV)) + tt * 64 + (pc & 7) * 8;
                *(LAS f32x4*)dst = (f32x4){xs[0], xs[1], xs[2], xs[3]}; *(LAS f32x4*)(dst + 4) = (f32x4){xs[4], xs[5], xs[6], xs[7]};
            } else if (pc < 32) {
                v4u o; o.x = pk2(tanhf(xs[0]), tanhf(xs[1])); o.y = pk2(tanhf(xs[2]), tanhf(xs[3])); o.z = pk2(tanhf(xs[4]), tanhf(xs[5])); o.w = pk2(tanhf(xs[6]), tanhf(xs[7]));
                *(LAS v4u*)(TW + tt * 72 + (pc - 24) * 8) = o;
            } else if (pc < 40) {
                v4u o; o.x = pk2(xs[0], xs[1]); o.y = pk2(xs[2], xs[3]); o.z = pk2(xs[4], xs[5]); o.w = pk2(xs[6], xs[7]);
                *(LAS v4u*)(XA + tt * 72 + (pc - 32) * 8) = o;
            } else {
                v4u o; o.x = pk2(sigmoidf_(xs[0]), sigmoidf_(xs[1])); o.y = pk2(sigmoidf_(xs[2]), sigmoidf_(xs[3])); o.z = pk2(sigmoidf_(xs[4]), sigmoidf_(xs[5])); o.w = pk2(sigmoidf_(xs[6]), sigmoidf_(xs[7]));
                *(LAS v4u*)(SG + tt * 168 + (pc - 40) * 8) = o;
            }
        }
        __syncthreads();
        if (wave < 6) {
            const int mat = wave >> 1, nt = wave & 1, r = lane & 31, hh = lane >> 5;
            const LAS bf16* Ab = mat == 0 ? TW : (mat == 1 ? XA : SG); const LAS bf16* Bb = mat == 0 ? WUt : (mat == 1 ? AUt : GUt);
            const int sa = mat == 2 ? 168 : 72, ks = mat == 2 ? 10 : 4;
            f32x16 acc;
#pragma unroll
            for (int g = 0; g < 16; ++g) acc[g] = 0.f;
            for (int s = 0; s < ks; ++s) {
                const bf16x8 a = *(const LAS bf16x8*)(Ab + r * sa + 16 * s + 8 * hh);
                const bf16x8 bq = *(const LAS bf16x8*)(Bb + (32 * nt + r) * sa + 16 * s + 8 * hh);
                acc = MFMA32(a, bq, acc);
            }
            const int nn = 32 * nt + r;
            if (mat == 0) { const float w0 = F.in[IN_W0][h * 64 + nn];
#pragma unroll
                for (int g = 0; g < 16; ++g) { const float wl = w0 + acc[g]; const float wlog = -softplusf_(-wl) - 0.5f; DEC[crow(g, hh) * 64 + nn] = __expf(-__expf(wlog)); } }
            else if (mat == 1) { const float a0 = F.in[IN_A0][h * 64 + nn];
#pragma unroll
                for (int g = 0; g < 16; ++g) BB[crow(g, hh) * 64 + nn] = sigmoidf_(a0 + acc[g]); }
            else {
#pragma unroll
                for (int g = 0; g < 16; ++g) GG[crow(g, hh) * 64 + nn] = acc[g]; }
        }
        __syncthreads();
        {
            const int tt = tid >> 4, j0 = (tid & 15) * 4;
            const f32x4 xk = *(LAS f32x4*)(KM + tt * 64 + j0), av = *(LAS f32x4*)(BB + tt * 64 + j0);
            const f32x4 kkw = *(const GAS f32x4*)(F.in[IN_KK] + h * 64 + j0), kaw = *(const GAS f32x4*)(F.in[IN_KA] + h * 64 + j0);
            f32x4 kr = xk * kkw;
            float ss = (kr.x * kr.x + kr.y * kr.y) + (kr.z * kr.z + kr.w * kr.w);
            ss = red16(ss);
            const float inv = 1.0f / fmaxf(sqrtf(ss), 1e-12f);
            kr = kr * inv;
            *(LAS f32x4*)(KK + tt * 64 + j0) = kr;
            *(LAS f32x4*)(BB + tt * 64 + j0) = kr * av;
            *(LAS f32x4*)(KM + tt * 64 + j0) = xk * (1.0f + (av - 1.0f) * kaw);
        }
        __syncthreads();
        {
            const int i = tid >> 3, jq = tid & 7;
            for (int tt = 0; tt < RC; ++tt) {
                const int o = tt * 64 + 8 * jq;
                const f32x4 k0 = *(LAS f32x4*)(KK + o), k1 = *(LAS f32x4*)(KK + o + 4);
                const f32x4 w0 = *(LAS f32x4*)(DEC + o), w1 = *(LAS f32x4*)(DEC + o + 4);
                const f32x4 b0 = *(LAS f32x4*)(BB + o), b1 = *(LAS f32x4*)(BB + o + 4);
                const f32x4 m0 = *(LAS f32x4*)(KM + o), m1 = *(LAS f32x4*)(KM + o + 4);
                const f32x4 r0 = *(LAS f32x4*)(XR + o), r1 = *(LAS f32x4*)(XR + o + 4);
                const float v = XV[tt * 64 + i];
                float sa = (S[0] * k0.x + S[1] * k0.y) + (S[2] * k0.z + S[3] * k0.w) + (S[4] * k1.x + S[5] * k1.y) + (S[6] * k1.z + S[7] * k1.w);
                sa = -red8(sa);
                S[0] = S[0] * w0.x + sa * b0.x + v * m0.x; S[1] = S[1] * w0.y + sa * b0.y + v * m0.y; S[2] = S[2] * w0.z + sa * b0.z + v * m0.z; S[3] = S[3] * w0.w + sa * b0.w + v * m0.w;
                S[4] = S[4] * w1.x + sa * b1.x + v * m1.x; S[5] = S[5] * w1.y + sa * b1.y + v * m1.y; S[6] = S[6] * w1.z + sa * b1.z + v * m1.z; S[7] = S[7] * w1.w + sa * b1.w + v * m1.w;
                float y = (S[0] * r0.x + S[1] * r0.y) + (S[2] * r0.z + S[3] * r0.w) + (S[4] * r1.x + S[5] * r1.y) + (S[6] * r1.z + S[7] * r1.w);
                y = red8(y);
                if (jq == 0) YY[tt * 64 + i] = y;
            }
        }
        __syncthreads();
        {
            const int tt = tid >> 4, i0 = (tid & 15) * 4;
            const f32x4 y4 = *(LAS f32x4*)(YY + tt * 64 + i0);
            const float mean = red16((y4.x + y4.y) + (y4.z + y4.w)) * (1.0f / 64.0f);
            const f32x4 d = y4 - mean;
            const float var = red16((d.x * d.x + d.y * d.y) + (d.z * d.z + d.w * d.w)) * (1.0f / 64.0f);
            const float rstd = 1.0f / sqrtf(var + GN_EPS);
            const f32x4 rr = *(LAS f32x4*)(XR + tt * 64 + i0), km = *(LAS f32x4*)(KM + tt * 64 + i0), vv = *(LAS f32x4*)(XV + tt * 64 + i0), gg = *(LAS f32x4*)(GG + tt * 64 + i0);
            const f32x4 rk = *(const GAS f32x4*)(F.in[IN_RK] + h * 64 + i0), gw = *(const GAS f32x4*)(F.in[IN_GNW] + h * 64 + i0), gb = *(const GAS f32x4*)(F.in[IN_GNB] + h * 64 + i0);
            const f32x4 t3 = rr * km * rk;
            const float bonus = red16((t3.x + t3.y) + (t3.z + t3.w));
            const f32x4 ov = ((d * rstd) * gw + gb + vv * bonus) * gg;
            const int sg = RC * c + tt;
            if (sg >= 32) { u32x2 w; w.x = pk2(ov.x, ov.y); w.y = pk2(ov.z, ov.w); *(GAS u32x2*)(Y + (size_t)(b * SEQ + sg - 32) * DM + h * 64 + i0) = w; }
        }
    }
    __syncthreads();
}

DI void topk_phase(Frame& F) {
    const int lane = F.lane, wave = F.wave;
    const int gw = F.vcu * NWAVES + wave, NGW = F.G * NWAVES;
    const float* SC = (const float*)(F.ws + WS_SC); int* IDX = (int*)(F.ws + WS_IDX); float* GATE = (float*)(F.ws + WS_GATE);
    LAS float* tv = (LAS float*)(F.lds + wave * 512);
    LAS int* ti = (LAS int*)(F.lds + wave * 512 + 256);
    for (int unit = gw; unit < TR * 8; unit += NGW) {
        const int t = unit >> 3, hd = unit & 7;
        const float* srow = SC + (size_t)t * DM + hd * 256;
        float va[2][2];
        va[0][0] = srow[lane]; va[0][1] = srow[64 + lane]; va[1][0] = srow[128 + lane]; va[1][1] = srow[192 + lane];
#pragma unroll
        for (int c = 0; c < 2; ++c) {
            float x0 = va[c][0], x1 = va[c][1];
            for (int k = 0; k < 16; ++k) {
                const float m = wave_max(fmaxf(x0, x1));
                const unsigned long long bal = __ballot(x0 == m || x1 == m);
                const int first = __ffsll((long long)bal) - 1;
                if (lane == first) { int sel; if (x0 == m) { x0 = -INFINITY; sel = lane; } else { x1 = -INFINITY; sel = lane + 64; } tv[c * 16 + k] = m; ti[c * 16 + k] = sel; }
            }
        }
        asm volatile("s_waitcnt lgkmcnt(0)" ::: "memory");
        const int ia = lane >> 2, ib0 = (lane & 3) * 4;
        float cs[4]; const float sa = tv[ia];
#pragma unroll
        for (int e = 0; e < 4; ++e) cs[e] = sa + tv[16 + ib0 + e];
        const int idxa = ti[ia] * 128;
        for (int k = 0; k < 16; ++k) {
            const float lm = fmaxf(fmaxf(cs[0], cs[1]), fmaxf(cs[2], cs[3]));
            const float m = wave_max(lm);
            const unsigned long long bal = __ballot(lm == m);
            const int first = __ffsll((long long)bal) - 1;
            if (lane == first) {
                int e;
                if (cs[0] == m) { e = 0; cs[0] = -INFINITY; } else if (cs[1] == m) { e = 1; cs[1] = -INFINITY; } else if (cs[2] == m) { e = 2; cs[2] = -INFINITY; } else { e = 3; cs[3] = -INFINITY; }
                tv[32 + k] = m; ti[32 + k] = idxa + ti[16 + ib0 + e];
            }
        }
        asm volatile("s_waitcnt lgkmcnt(0)" ::: "memory");
        if (lane < 16) {
            const float s = tv[32 + lane], m0 = tv[32];
            const float ex = __expf(s - m0);
            const float sum = red16(ex);
            IDX[(size_t)t * NSEL + hd * 16 + lane] = ti[32 + lane];
            GATE[(size_t)t * NSEL + hd * 16 + lane] = ex / sum;
        }
        asm volatile("s_waitcnt lgkmcnt(0)" ::: "memory");
    }
}

DI void gather_phase(Frame& F) {
    const int lane = F.lane, wave = F.wave;
    const int gw = F.vcu * NWAVES + wave, NGW = F.G * NWAVES;
    const int* IDX = (const int*)(F.ws + WS_IDX); const float* GATE = (const float*)(F.ws + WS_GATE);
    const bf16* TD = (const bf16*)(F.ws + WS_TD); const bf16* TU = (const bf16*)(F.ws + WS_TU); const bf16* H1B = (const bf16*)(F.ws + WS_H1B);
    const float* sumsq = (const float*)(F.ws + WS_SUMSQ);
    for (int t = gw; t < TR; t += NGW) {
        const int id0 = IDX[(size_t)t * NSEL + lane], id1 = IDX[(size_t)t * NSEL + 64 + lane];
        const float g0 = GATE[(size_t)t * NSEL + lane], g1 = GATE[(size_t)t * NSEL + 64 + lane];
        const float rs = 1.0f / sqrtf(sumsq[t] * (1.0f / DM) + RMS_EPS);
        float xv[32];
#pragma unroll
        for (int c = 0; c < 4; ++c) { const v4u raw = *(const GAS v4u*)(H1B + (size_t)t * DM + c * 512 + lane * 8);
            xv[c * 8 + 0] = bflo(raw.x); xv[c * 8 + 1] = bfhi(raw.x); xv[c * 8 + 2] = bflo(raw.y); xv[c * 8 + 3] = bfhi(raw.y); xv[c * 8 + 4] = bflo(raw.z); xv[c * 8 + 5] = bfhi(raw.z); xv[c * 8 + 6] = bflo(raw.w); xv[c * 8 + 7] = bfhi(raw.w); }
        float hv0 = 0.f, hv1 = 0.f;
        for (int k = 0; k < NSEL; k += 4) {
            v4u raw[4][4];
#pragma unroll
            for (int q = 0; q < 4; ++q) {
                const int kq = k + q; const int e = __builtin_amdgcn_readlane(kq < 64 ? id0 : id1, kq & 63);
                const bf16* rowp = TD + (size_t)e * DM + lane * 8;
#pragma unroll
                for (int c = 0; c < 4; ++c) raw[q][c] = *(const GAS v4u*)(rowp + c * 512);
            }
#pragma unroll
            for (int q = 0; q < 4; ++q) {
                float p = 0.f;
#pragma unroll
                for (int c = 0; c < 4; ++c) {
                    p += bflo(raw[q][c].x) * xv[c * 8 + 0] + bfhi(raw[q][c].x) * xv[c * 8 + 1] + bflo(raw[q][c].y) * xv[c * 8 + 2] + bfhi(raw[q][c].y) * xv[c * 8 + 3]
                       + bflo(raw[q][c].z) * xv[c * 8 + 4] + bfhi(raw[q][c].z) * xv[c * 8 + 5] + bflo(raw[q][c].w) * xv[c * 8 + 6] + bfhi(raw[q][c].w) * xv[c * 8 + 7];
                }
                p = wave_sum(p);
                const int kq = k + q;
                if (lane == (kq & 63)) { if (kq < 64) hv0 = p; else hv1 = p; }
            }
        }
        const float z0 = hv0 * rs, z1 = hv1 * rs;
        const float c0 = g0 * 0.5f * z0 * (1.0f + erff(z0 * 0.70710678118654752f)), c1 = g1 * 0.5f * z1 * (1.0f + erff(z1 * 0.70710678118654752f));
        float acc[32];
#pragma unroll
        for (int i = 0; i < 32; ++i) acc[i] = 0.f;
        for (int k = 0; k < NSEL; k += 4) {
            v4u raw[4][4]; float ck[4];
#pragma unroll
            for (int q = 0; q < 4; ++q) {
                const int kq = k + q; const int e = __builtin_amdgcn_readlane(kq < 64 ? id0 : id1, kq & 63);
                ck[q] = rdlane(kq < 64 ? c0 : c1, kq & 63);
                const bf16* rowp = TU + (size_t)e * DM + lane * 8;
#pragma unroll
                for (int c = 0; c < 4; ++c) raw[q][c] = *(const GAS v4u*)(rowp + c * 512);
            }
#pragma unroll
            for (int q = 0; q < 4; ++q)
#pragma unroll
                for (int c = 0; c < 4; ++c) {
                    acc[c * 8 + 0] += ck[q] * bflo(raw[q][c].x); acc[c * 8 + 1] += ck[q] * bfhi(raw[q][c].x); acc[c * 8 + 2] += ck[q] * bflo(raw[q][c].y); acc[c * 8 + 3] += ck[q] * bfhi(raw[q][c].y);
                    acc[c * 8 + 4] += ck[q] * bflo(raw[q][c].z); acc[c * 8 + 5] += ck[q] * bfhi(raw[q][c].z); acc[c * 8 + 6] += ck[q] * bflo(raw[q][c].w); acc[c * 8 + 7] += ck[q] * bfhi(raw[q][c].w);
                }
        }
#pragma unroll
        for (int c = 0; c < 4; ++c) {
            GAS f32x4* op = (GAS f32x4*)(F.out + (size_t)t * DM + c * 512 + lane * 8);
            f32x4 a = op[0], bq = op[1];
            a.x += acc[c * 8 + 0]; a.y += acc[c * 8 + 1]; a.z += acc[c * 8 + 2]; a.w += acc[c * 8 + 3];
            bq.x += acc[c * 8 + 4]; bq.y += acc[c * 8 + 5]; bq.z += acc[c * 8 + 6]; bq.w += acc[c * 8 + 7];
            op[0] = a; op[1] = bq;
        }
    }
}

struct Args { const float* in[24]; float* out; unsigned char* ws; int ph_lo, ph_hi, li, pad; };
__global__ void __launch_bounds__(NTHR, 2) hybrid_fwd(Args args) {
    extern __shared__ __attribute__((aligned(16))) unsigned char lds[];
    Frame F;
    F.lds = (LAS unsigned char*)lds;
    F.MISC = (volatile LAS unsigned*)(F.lds + MISC_OFF);
    F.tid = threadIdx.x; F.lane = F.tid & 63; F.wave = __builtin_amdgcn_readfirstlane(F.tid >> 6);
    F.G = gridDim.x; { const int bx = blockIdx.x; F.vcu = (F.G % 8 == 0) ? (bx % 8) * (F.G / 8) + bx / 8 : bx; }
    F.ws = args.ws; F.out = args.out; F.ctl = (gu32*)(args.ws + WS_CTL);
#pragma unroll
    for (int i = 0; i < 24; ++i) F.in[i] = args.in[i];
    for (int u = F.tid; u < (LDS_BYTES - LDSCTL_OFF) / 4; u += NTHR) ((LAS unsigned*)(F.lds + LDSCTL_OFF))[u] = 0u;
    __syncthreads();
    XcdBarrier bar; bar.bar = (unsigned*)(F.ctl + CW_BAR); bar.x = 0; bar.st = nullptr;
    if (!MK_SPLIT) bar = xcd_barrier_post((unsigned*)(F.ctl + CW_BAR), F.MISC + 8);
    const int lo = args.ph_lo, hi = args.ph_hi;
#ifndef PH_MASK
#define PH_MASK 0x7f
#endif
#define IN(k) (((PH_MASK >> (k)) & 1) && lo <= (k) && (k) < hi)
#define SEAM(k) do { if (IN(k) && IN((k) + 1)) xcd_barrier(bar); } while (0)
    bf16* Win_t = (bf16*)(F.ws + WS_WIN); bf16* Wout_t = (bf16*)(F.ws + WS_WOUT); bf16* Wqs_t = (bf16*)(F.ws + WS_WQS);
    bf16* U = (bf16*)(F.ws + WS_U); bf16* P = (bf16*)(F.ws + WS_P); bf16* H1B = (bf16*)(F.ws + WS_H1B);
    float* sumsq = (float*)(F.ws + WS_SUMSQ); float* SC = (float*)(F.ws + WS_SC);

    if (IN(0)) { p0_prologue(F); } SEAM(0);
    if (IN(1)) {
        pg8::Gemm g{U, Win_t, MIN_ROWS, NP, DM}; pg8::StaticOrder S; S.init(MIN_ROWS, NP, F.G, (int)blockIdx.x);
        pg8::EpiBf16<0> E{P, NP, nullptr, 0, 0, 1.f};
        pg8::gemm_phase<pg8::EpiBf16<0>, pg8::StaticOrder, true, true>(F.lds, g, S, E);
    } SEAM(1);
    if (IN(2)) {
        for (int u = blockIdx.x; u < 256; u += F.G) attn_unit(F, u);
        for (int bh = blockIdx.x; bh < 64; bh += F.G) rwkv_bh(F, bh);
    } SEAM(2);
    if (IN(3)) {
        pg8::Gemm g{U, Wout_t, TR, DM, DM}; pg8::StaticOrder S; S.init(TR, DM, F.G, (int)blockIdx.x);
        pg8::EpiOut E{F.in[IN_X], F.out, H1B, sumsq, DM};
        pg8::gemm_phase<pg8::EpiOut, pg8::StaticOrder, true, true>(F.lds, g, S, E);
    } SEAM(3);
    if (IN(4)) {
        pg8::Gemm g{H1B, Wqs_t, TR, DM, DM}; pg8::StaticOrder S; S.init(TR, DM, F.G, (int)blockIdx.x);
        pg8::EpiScores E{sumsq, SC, DM, RMS_EPS};
        pg8::gemm_phase<pg8::EpiScores, pg8::StaticOrder, true, true>(F.lds, g, S, E);
    } SEAM(4);
    if (IN(5)) { topk_phase(F); } SEAM(5);
    if (IN(6)) { gather_phase(F); }
#undef IN
#undef SEAM
}

extern "C" void kernel_launch(void* const* d_in, const int* in_sizes, int n_in, void* d_out, int out_size, void* d_ws, size_t ws_size, hipStream_t stream) {
    static int grid = 0;
    if (grid == 0) {
        if (n_in != 24 || in_sizes[0] != TR * DM || out_size != TR * DM || ws_size < WS_END) { fprintf(stderr, "kernel_launch: unexpected shapes: n_in %d in0 %d out %d ws %zu\n", n_in, n_in > 0 ? in_sizes[0] : -1, out_size, ws_size); grid = -1; return; }
        int dev = 0, cus = 0, per_cu = 0;
        if (hipGetDevice(&dev) != hipSuccess || hipDeviceGetAttribute(&cus, hipDeviceAttributeMultiprocessorCount, dev) != hipSuccess) { grid = -1; return; }
        if (hipFuncSetAttribute((const void*)hybrid_fwd, hipFuncAttributeMaxDynamicSharedMemorySize, LDS_BYTES) != hipSuccess) { fprintf(stderr, "kernel_launch: hipFuncSetAttribute failed\n"); grid = -1; return; }
        if (hipOccupancyMaxActiveBlocksPerMultiprocessor(&per_cu, (const void*)hybrid_fwd, NTHR, LDS_BYTES) != hipSuccess || per_cu < 1) fprintf(stderr, "kernel_launch: occupancy query says %d\n", per_cu);
        (void)hipGetLastError();
        grid = cus;
    }
    if (grid < 0) return;
    if (hipMemsetAsync((char*)d_ws + WS_CTL, 0, CTL_ZERO_BYTES, stream) != hipSuccess) return;
    Args a{};
    for (int i = 0; i < 24; ++i) a.in[i] = (const float*)d_in[i];
    a.out = (float*)d_out; a.ws = (unsigned char*)d_ws;
#if MK_SPLIT
    for (int li = 0; li < NPHASE; ++li) { a.ph_lo = li; a.ph_hi = li + 1; a.li = li; hipLaunchKernelGGL(hybrid_fwd, dim3(grid), dim3(NTHR), LDS_BYTES, stream, a); }
#else
    a.ph_lo = 0; a.ph_hi = NPHASE; a.li = 0;
    hipLaunchKernelGGL(hybrid_fwd, dim3(grid), dim3(NTHR), LDS_BYTES, stream, a);
#endif
}
```

```cpp
#include <hip/hip_runtime.h>
#include <cstdio>
#include <cstdint>
namespace pg8 {
#define PG8_LAS __attribute__((address_space(3)))
typedef unsigned short bf16_t;
typedef short bf16x8 __attribute__((ext_vector_type(8)));
typedef float f32x4 __attribute__((ext_vector_type(4)));
typedef unsigned u32x4 __attribute__((ext_vector_type(4)));
constexpr int BM = 256, BK = 64, HALF = 128, HTB = HALF * BK * 2  , STAGE_BYTES = 8 * HTB, NXCD = 8, WGM = 8;

__host__ __device__ __forceinline__ int lds_byte(int r, int c) { const int st = (r >> 4) * 2 + (c >> 5), rr = r & 15, cc = c & 31, ob = rr * 64 + cc * 2; return st * 1024 + (ob ^ (((ob >> 9) & 1) << 5)); }
__host__ __device__ __forceinline__ void stage_rc(int b, int& R, int& C) { const int st = b / 1024, sb = b % 1024, swz = sb ^ (((sb >> 9) & 1) << 5); R = (st >> 1) * 16 + swz / 64; C = (st & 1) * 32 + (swz % 64) / 2; }
__host__ __device__ __forceinline__ int perm32(int rho) { const int n = rho >> 4, i = rho & 15; return 8 * (i >> 2) + 4 * n + (i & 3); }

struct Unit { int pm, pn; };
struct Gemm { const bf16_t* A; const bf16_t* Bt; int M, N, K; };

struct StaticOrder {
    int nM, nN, nwg, G, c;
    __host__ __device__ void init(int M, int N, int G_, int c_) { nM = M / BM; nN = N / BM; nwg = nM * nN; G = G_; c = c_; }
    __host__ __device__ bool next(int i, Unit& u) const {
        const long L = (long)i * G + c; if (L >= nwg) return false;
        int wgid = (int)L; { const int q = nwg / NXCD, r = nwg % NXCD, xcd = wgid % NXCD, off = wgid / NXCD; wgid = (xcd < r ? xcd * (q + 1) : r * (q + 1) + (xcd - r) * q) + off; }
        const int nig = WGM * nN, gid = wgid / nig, fm = gid * WGM, gsz = (nM - fm) < WGM ? (nM - fm) : WGM;
        u.pm = fm + ((wgid % nig) % gsz); u.pn = (wgid % nig) / gsz; return true;
    }
    __device__ __forceinline__ void a_ready(const Unit&) const {}
    __device__ __forceinline__ void done(const Unit&) const {}
};

__device__ __forceinline__ unsigned cvt_pk_bf16(float lo, float hi) { unsigned r; asm volatile("v_cvt_pk_bf16_f32 %0, %1, %2" : "=v"(r) : "v"(lo), "v"(hi)); return r; }
typedef float f32x2 __attribute__((ext_vector_type(2)));
__device__ __forceinline__ f32x2 gelu_pk(f32x2 v) {
    const f32x2 av = __builtin_elementwise_abs(v), d = av * 0.2316418882f + 1.0f;
    f32x2 t; t.x = __builtin_amdgcn_rcpf(d.x); t.y = __builtin_amdgcn_rcpf(d.y);
    f32x2 q = t * 0.5307027145f + (-0.7265760135f); q = q * t + 0.7107068705f; q = q * t + (-0.142248368f); q = q * t + 0.127414796f; q = q * t;
    const f32x2 s = (v * v) * (-0.72134752044f);
    f32x2 e; e.x = __builtin_amdgcn_exp2f(s.x); e.y = __builtin_amdgcn_exp2f(s.y);
    const f32x2 m = v * (q * e), r = v - m;
    f32x2 o; o.x = v.x < 0.f ? m.x : r.x; o.y = v.y < 0.f ? m.y : r.y; return o;
}

template <int ACT  > struct EpiBf16 {
    static constexpr bool PERM = true, AFTER_DRAIN = false; static_assert(ACT == 0 || ACT == 1, "EpiBf16: ACT is 0 (none) or 1 (gelu_pk)");
    bf16_t* O; int ldc; const float* bias; int split_cols; size_t split_stride; float scale0;
    __device__ __forceinline__ void operator()(const f32x4 (&acc)[2][2][4][2], const Unit& u, int wr, int wc, int fr, int fq) const {
        const int row0 = u.pm * BM + wr * 64 + fr; int colt = u.pn * BM; bf16_t* base = O;
        float sc = 1.f; if (split_cols) { const int t = colt / split_cols; base += (size_t)t * split_stride; colt -= t * split_cols; if (t == 0) sc = scale0; }
        const int col0 = colt + wc * 32 + 8 * fq, bcol0 = u.pn * BM + wc * 32 + 8 * fq;
        f32x4 bv[2][2];
#pragma unroll
        for (int bj = 0; bj < 2; ++bj)
#pragma unroll
            for (int n = 0; n < 2; ++n) bv[bj][n] = bias ? *(const f32x4*)(bias + bcol0 + bj * HALF + 4 * n) : (f32x4){0.f, 0.f, 0.f, 0.f};
#pragma unroll
        for (int ai = 0; ai < 2; ++ai)
#pragma unroll
            for (int m = 0; m < 4; ++m) { bf16_t* rowp = base + (size_t)(row0 + ai * HALF + m * 16) * ldc + col0;
#pragma unroll
                for (int bj = 0; bj < 2; ++bj) { f32x4 v0 = acc[ai][bj][m][0] + bv[bj][0], v1 = acc[ai][bj][m][1] + bv[bj][1];
                    if (ACT == 1) { f32x2 a = gelu_pk((f32x2){v0[0], v0[1]}), b = gelu_pk((f32x2){v0[2], v0[3]}), c = gelu_pk((f32x2){v1[0], v1[1]}), d = gelu_pk((f32x2){v1[2], v1[3]});
                        v0 = (f32x4){a.x, a.y, b.x, b.y}; v1 = (f32x4){c.x, c.y, d.x, d.y}; }
                    v0 = v0 * sc; v1 = v1 * sc; u32x4 w; w.x = cvt_pk_bf16(v0[0], v0[1]); w.y = cvt_pk_bf16(v0[2], v0[3]); w.z = cvt_pk_bf16(v1[0], v1[1]); w.w = cvt_pk_bf16(v1[2], v1[3]);
                    *(u32x4*)(rowp + bj * HALF) = w; } }
    }
};

typedef unsigned u32x2 __attribute__((ext_vector_type(2)));
#define H1_BF16_ONLY 1
struct EpiOut {
    static constexpr bool PERM = false, AFTER_DRAIN = false;
    const float* x; float* out; bf16_t* hb; float* sumsq; int ldc;
    __device__ __forceinline__ void operator()(const f32x4 (&acc)[2][2][4][2], const Unit& u, int wr, int wc, int fr, int fq) const {
        const int row0 = u.pm * BM + wr * 64 + fr, col0 = u.pn * BM + wc * 32 + 4 * fq;
#pragma unroll
        for (int ai = 0; ai < 2; ++ai)
#pragma unroll
            for (int m = 0; m < 4; ++m) {
                const int row = row0 + ai * HALF + m * 16; const size_t off = (size_t)row * ldc + col0; float ss = 0.f;
#pragma unroll
                for (int bj = 0; bj < 2; ++bj)
#pragma unroll
                    for (int n = 0; n < 2; ++n) {
                        const size_t o = off + bj * HALF + n * 16;
                        const f32x4 xv = *(const f32x4*)(x + o); const f32x4 v = xv + acc[ai][bj][m][n];
#if !defined(H1_BF16_ONLY)
                        *(f32x4*)(out + o) = v;
#endif
                        ss += (v[0] * v[0] + v[1] * v[1]) + (v[2] * v[2] + v[3] * v[3]);
                        u32x2 w; w.x = cvt_pk_bf16(v[0], v[1]); w.y = cvt_pk_bf16(v[2], v[3]); *(u32x2*)(hb + o) = w;
                    }
                ss += __shfl_xor(ss, 16); ss += __shfl_xor(ss, 32);
                if (fq == 0) atomicAdd(sumsq + row, ss);
            }
    }
};
struct EpiScores {
    static constexpr bool PERM = false, AFTER_DRAIN = false;
    const float* sumsq; float* S; int ldc; float eps;
    __device__ __forceinline__ void operator()(const f32x4 (&acc)[2][2][4][2], const Unit& u, int wr, int wc, int fr, int fq) const {
        const int row0 = u.pm * BM + wr * 64 + fr, col0 = u.pn * BM + wc * 32 + 4 * fq;
#pragma unroll
        for (int ai = 0; ai < 2; ++ai)
#pragma unroll
            for (int m = 0; m < 4; ++m) {
                const int row = row0 + ai * HALF + m * 16; const size_t off = (size_t)row * ldc + col0;
                const float rs = 1.0f / sqrtf(sumsq[row] * (1.0f / 2048.0f) + eps);
#pragma unroll
                for (int bj = 0; bj < 2; ++bj)
#pragma unroll
                    for (int n = 0; n < 2; ++n) *(f32x4*)(S + off + bj * HALF + n * 16) = acc[ai][bj][m][n] * rs;
            }
    }
};
template <class Epi, class Sched, bool ALIGN_EPI = false, bool SP2 = false>
__device__ __forceinline__ void gemm_phase(PG8_LAS unsigned char* lds, const Gemm g, const Sched& S, const Epi& E) {
    const int tid = threadIdx.x, wid = __builtin_amdgcn_readfirstlane(tid >> 6), lane = tid & 63, wr = wid >> 2, wc = wid & 3, fr = lane & 15, fq = lane >> 4;
    const int K = g.K, nt = K / BK;
    unsigned voffA[2], voffB[2];
#pragma unroll
    for (int i = 0; i < 2; ++i) { int R, C; stage_rc(tid * 16 + i * 8192, R, C); const int Rb = Epi::PERM ? ((R & ~31) + perm32(R & 31)) : R;
        voffA[i] = (unsigned)(R * K + C) * 2u; voffB[i] = (unsigned)(Rb * K + C) * 2u; }
    const size_t kstep = (size_t)(BK * 2);
    const size_t hstep = (size_t)HALF * K * 2;
    const size_t tstep = 2 * hstep;
    const unsigned ldsw = (unsigned)wid * 1024u;
    const int aoff = lds_byte(wr * 64 + fr, fq * 8), boff = lds_byte(wc * 32 + fr, fq * 8);
#define PG8_SA(b, h) (((b) * 2 + (h)) * HTB)
#define PG8_SB(b, h) ((4 + (b) * 2 + (h)) * HTB)
#define PG8_STAGE(bufoff, gbase, voff) do { _Pragma("unroll") for (int _i = 0; _i < 2; ++_i) \
        __builtin_amdgcn_global_load_lds((const unsigned*)((const char*)(gbase) + (voff)[_i]), (PG8_LAS unsigned*)(lds + (bufoff) + ldsw + _i * 8192), 16, 0, 0); } while (0)
#define PG8_LDA(dst, b, h) do { _Pragma("unroll") for (int m = 0; m < 4; ++m) _Pragma("unroll") for (int k = 0; k < 2; ++k) dst[m][k] = *(const PG8_LAS bf16x8*)(lds + PG8_SA(b, h) + aoff + m * 2048 + k * 1024); } while (0)
#define PG8_LDB(dst, b, h) do { _Pragma("unroll") for (int n = 0; n < 2; ++n) _Pragma("unroll") for (int k = 0; k < 2; ++k) dst[n][k] = *(const PG8_LAS bf16x8*)(lds + PG8_SB(b, h) + boff + n * 2048 + k * 1024); } while (0)
#define PG8_MMA(ai, bj, At, Bt) do { __builtin_amdgcn_s_setprio(1); _Pragma("unroll") for (int m = 0; m < 4; ++m) _Pragma("unroll") for (int n = 0; n < 2; ++n) _Pragma("unroll") for (int k = 0; k < 2; ++k) \
        acc[ai][bj][m][n] = __builtin_amdgcn_mfma_f32_16x16x32_bf16(Bt[n][k], At[m][k], acc[ai][bj][m][n], 0, 0, 0); __builtin_amdgcn_s_setprio(0); } while (0)
#define PG8_WAIT_V(n) asm volatile("s_waitcnt vmcnt(" #n ")" ::: "memory")
#define PG8_WAIT_L(n) asm volatile("s_waitcnt lgkmcnt(" #n ")" ::: "memory")
#define PG8_BAR __builtin_amdgcn_s_barrier()
#define PG8_SCHED __builtin_amdgcn_sched_barrier(0)
    Unit cur, nxt; int ui = 0;
    if (!S.next(0, cur)) return;
    f32x4 acc[2][2][4][2];
#pragma unroll
    for (int a = 0; a < 2; ++a)
#pragma unroll
        for (int b = 0; b < 2; ++b)
#pragma unroll
            for (int m = 0; m < 4; ++m)
#pragma unroll
                for (int n = 0; n < 2; ++n) acc[a][b][m][n] = (f32x4){0.f, 0.f, 0.f, 0.f};
    bf16x8 At[4][2], B0[2][2], B1[2][2];
    const char* cA = (const char*)g.A + (size_t)cur.pm * tstep; const char* cB = (const char*)g.Bt + (size_t)cur.pn * tstep;
    S.a_ready(cur);
    if constexpr (SP2) {
        PG8_STAGE(PG8_SB(0, 0), cB, voffB); PG8_STAGE(PG8_SB(0, 1), cB + hstep, voffB); PG8_STAGE(PG8_SA(0, 0), cA, voffA); PG8_STAGE(PG8_SA(0, 1), cA + hstep, voffA);
        if (wr == 1) PG8_BAR;
        PG8_WAIT_V(2); PG8_BAR;
        PG8_STAGE(PG8_SB(1, 0), cB + kstep, voffB); PG8_STAGE(PG8_SA(1, 0), cA + kstep, voffA); PG8_STAGE(PG8_SB(1, 1), cB + hstep + kstep, voffB);
        PG8_WAIT_V(6); PG8_BAR;
    } else {
        PG8_STAGE(PG8_SB(0, 0), cB, voffB); PG8_STAGE(PG8_SA(0, 0), cA, voffA); PG8_STAGE(PG8_SB(0, 1), cB + hstep, voffB); PG8_STAGE(PG8_SA(0, 1), cA + hstep, voffA);
        if (wr == 1) PG8_BAR;
        PG8_WAIT_V(4); PG8_BAR;
        PG8_STAGE(PG8_SB(1, 0), cB + kstep, voffB); PG8_STAGE(PG8_SA(1, 0), cA + kstep, voffA); PG8_STAGE(PG8_SB(1, 1), cB + hstep + kstep, voffB);
        PG8_WAIT_V(6); PG8_BAR;
    }
    for (;;) {
        const bool has_next = S.next(ui + 1, nxt);
        const char* nA = has_next ? (const char*)g.A + (size_t)nxt.pm * tstep : cA; const char* nB = has_next ? (const char*)g.Bt + (size_t)nxt.pn * tstep : cB;
        for (int t = 0; t < nt; t += 2) {
            const bool last = (t == nt - 2);
            const char* a1 = cA + (size_t)(t + 1) * kstep;
            const char* a2 = last ? nA : cA + (size_t)(t + 2) * kstep; const char* b2 = last ? nB : cB + (size_t)(t + 2) * kstep;
            const char* a3 = a2 + kstep; const char* b3 = b2 + kstep;
            if (last && has_next) S.a_ready(nxt);
            if constexpr (SP2) {
            PG8_LDB(B0, 0, 0); PG8_LDB(B1, 0, 1); PG8_SCHED; PG8_LDA(At, 0, 0); PG8_STAGE(PG8_SA(1, 1), a1 + hstep, voffA);
            PG8_WAIT_V(8); PG8_WAIT_L(0); PG8_BAR; PG8_MMA(0, 0, At, B0); PG8_MMA(0, 1, At, B1); PG8_BAR; PG8_SCHED;
            PG8_LDA(At, 0, 1); PG8_STAGE(PG8_SB(0, 0), b2, voffB); PG8_STAGE(PG8_SB(0, 1), b2 + hstep, voffB); PG8_STAGE(PG8_SA(0, 0), a2, voffA);
            PG8_WAIT_V(8); PG8_WAIT_L(0); PG8_BAR; PG8_MMA(1, 0, At, B0); PG8_MMA(1, 1, At, B1); PG8_BAR; PG8_SCHED;
            PG8_LDB(B0, 1, 0); PG8_LDB(B1, 1, 1); PG8_SCHED; PG8_LDA(At, 1, 0); PG8_STAGE(PG8_SA(0, 1), a2 + hstep, voffA);
            PG8_WAIT_V(8); PG8_WAIT_L(0); PG8_BAR; PG8_MMA(0, 0, At, B0); PG8_MMA(0, 1, At, B1); PG8_BAR; PG8_SCHED;
            PG8_LDA(At, 1, 1); PG8_STAGE(PG8_SB(1, 0), b3, voffB); PG8_STAGE(PG8_SB(1, 1), b3 + hstep, voffB); PG8_STAGE(PG8_SA(1, 0), a3, voffA);
            PG8_WAIT_V(8); PG8_WAIT_L(0); PG8_BAR; PG8_MMA(1, 0, At, B0); PG8_MMA(1, 1, At, B1); PG8_BAR; PG8_SCHED;
            } else {
            PG8_LDB(B0, 0, 0); PG8_SCHED; PG8_LDA(At, 0, 0); PG8_STAGE(PG8_SA(1, 1), a1 + hstep, voffA);
            PG8_WAIT_L(8); PG8_BAR; PG8_WAIT_L(0); PG8_MMA(0, 0, At, B0); PG8_BAR; PG8_SCHED;
            PG8_LDB(B1, 0, 1); PG8_STAGE(PG8_SB(0, 0), b2, voffB);
            PG8_BAR; PG8_WAIT_L(0); PG8_MMA(0, 1, At, B1); PG8_BAR;
            PG8_LDA(At, 0, 1); PG8_STAGE(PG8_SA(0, 0), a2, voffA);
            PG8_BAR; PG8_WAIT_L(0); PG8_MMA(1, 0, At, B0); PG8_BAR; PG8_SCHED;
            PG8_STAGE(PG8_SB(0, 1), b2 + hstep, voffB);
            PG8_WAIT_V(6); PG8_BAR; PG8_MMA(1, 1, At, B1); PG8_BAR;
            PG8_LDB(B0, 1, 0); PG8_SCHED; PG8_LDA(At, 1, 0); PG8_STAGE(PG8_SA(0, 1), a2 + hstep, voffA);
            PG8_WAIT_L(8); PG8_BAR; PG8_WAIT_L(0); PG8_MMA(0, 0, At, B0); PG8_BAR; PG8_SCHED;
            PG8_LDB(B1, 1, 1); PG8_STAGE(PG8_SB(1, 0), b3, voffB);
            PG8_BAR; PG8_WAIT_L(0); PG8_MMA(0, 1, At, B1); PG8_BAR;
            PG8_LDA(At, 1, 1); PG8_STAGE(PG8_SA(1, 0), a3, voffA);
            PG8_BAR; PG8_WAIT_L(0); PG8_MMA(1, 0, At, B0); PG8_BAR; PG8_SCHED;
            PG8_STAGE(PG8_SB(1, 1), b3 + hstep, voffB);
            PG8_WAIT_V(6); PG8_BAR; PG8_MMA(1, 1, At, B1); PG8_BAR;
            }
        }
        if constexpr (ALIGN_EPI) { if (wr == 0) PG8_BAR; }
        if constexpr (!Epi::AFTER_DRAIN) { E(acc, cur, wr, wc, fr, fq); S.done(cur); }
        if (!has_next) break;
#pragma unroll
        for (int a = 0; a < 2; ++a)
#pragma unroll
            for (int b = 0; b < 2; ++b)
#pragma unroll
                for (int m = 0; m < 4; ++m)
#pragma unroll
                    for (int n = 0; n < 2; ++n) acc[a][b][m][n] = (f32x4){0.f, 0.f, 0.f, 0.f};
        cur = nxt; cA = nA; cB = nB; ++ui;
        if constexpr (ALIGN_EPI) { if (wr == 1) PG8_BAR; }
    }
    PG8_WAIT_V(0);
    if constexpr (!ALIGN_EPI) { if (wr == 0) PG8_BAR; }
    PG8_BAR;
    if constexpr (Epi::AFTER_DRAIN) { E.fused(acc, cur, wr, wc, fr, fq, lds, wid, lane); S.done(cur); }
#undef PG8_SA
#undef PG8_SB
#undef PG8_STAGE
#undef PG8_LDA
#undef PG8_LDB
#undef PG8_MMA
#undef PG8_WAIT_V
#undef PG8_WAIT_L
#undef PG8_BAR
#undef PG8_SCHED
}
}
#define GAS __attribute__((address_space(1)))
#define LAS __attribute__((address_space(3)))
typedef unsigned short bf16;
typedef unsigned v4u __attribute__((ext_vector_type(4)));
typedef float f32x4 __attribute__((ext_vector_type(4)));
typedef short bf16x8 __attribute__((ext_vector_type(8)));
typedef GAS unsigned gu32;
typedef GAS unsigned long long gu64;
#define RLX_AGENT __ATOMIC_RELAXED, __HIP_MEMORY_SCOPE_AGENT
#define LDS_WAIT() asm volatile("s_waitcnt lgkmcnt(0)" ::: "memory")
#define VM_WAIT() asm volatile("s_waitcnt vmcnt(0)" ::: "memory")
__device__ __forceinline__ unsigned long long rt() { return __builtin_amdgcn_s_memrealtime(); }
__device__ __forceinline__ unsigned f2bf(float f) { unsigned u = __builtin_bit_cast(unsigned, f); return (u + 0x7fffu + ((u >> 16) & 1u)) >> 16; }
__device__ __forceinline__ unsigned pk2(float lo, float hi) { return f2bf(lo) | (f2bf(hi) << 16); }

#define XB_TMO      128
#define XB_XCNT(j)  (256  + 64 * (j))
#define XB_XSUB(j)  (1280 + 64 * (j))
#define XB_XGEN(j)  (2304 + 64 * (j))
#define XB_TOP      3328
#define XB_TOPGEN   3392
#define XCD_BAR_WORDS 3456
#define XB_SPIN_CAP (1u << 18)

__device__ __forceinline__ unsigned xb_ld(unsigned* p)              { return __hip_atomic_load(p, __ATOMIC_RELAXED, __HIP_MEMORY_SCOPE_AGENT); }
__device__ __forceinline__ unsigned xb_add(unsigned* p, unsigned v) { return __hip_atomic_fetch_add(p, v, __ATOMIC_RELAXED, __HIP_MEMORY_SCOPE_AGENT); }
__device__ __forceinline__ unsigned xb_xcc_id() { return (unsigned)__builtin_amdgcn_s_getreg((3 << 11) | 20) & 0xFu; }
#define XB_SPIN(cond, bar) do { unsigned _sp = 0; while (cond) { __builtin_amdgcn_s_sleep(1); \
    if ((++_sp & 255u) == 0u) { if (xb_ld(&(bar)[XB_TMO])) break; if (_sp > XB_SPIN_CAP) { atomicAdd(&(bar)[XB_TMO], 1u); break; } } } } while (0)

struct XcdBarrier {
    unsigned* bar; unsigned x;
    volatile LAS unsigned* st;
};

__device__ __forceinline__ XcdBarrier xcd_barrier_post(unsigned* bar, volatile LAS unsigned* st) {
    XcdBarrier b; b.bar = bar; b.x = xb_xcc_id(); b.st = st;
    if (threadIdx.x == 0) (void)xb_add(&bar[XB_XCNT(b.x)], 1u);
    return b;
}
__device__ __forceinline__ void xcd_barrier_complete(unsigned* bar, unsigned x, unsigned& nloc, unsigned& nx) {
    const unsigned G = gridDim.x * gridDim.y * gridDim.z;
    unsigned sum, cnt, mine, sp = 0u;
    for (;;) {
        sum = 0u; cnt = 0u; mine = 0u;
#pragma unroll
        for (unsigned j = 0; j < 16; ++j) { const unsigned c = xb_ld(&bar[XB_XCNT(j)]); sum += c; cnt += (c > 0u) ? 1u : 0u; mine = (j == x) ? c : mine; }
        if (sum == G) break;
        __builtin_amdgcn_s_sleep(1);
        if ((++sp & 255u) == 0u) { if (xb_ld(&bar[XB_TMO])) break; if (sp > XB_SPIN_CAP) { atomicAdd(&bar[XB_TMO], 1u); break; } }
    }
    nloc = mine > 0u ? mine : 1u; nx = cnt > 0u ? cnt : 1u;
}

__device__ __forceinline__ void xcd_barrier(const XcdBarrier& b) {
    asm volatile("s_waitcnt vmcnt(0)" ::: "memory");
    __syncthreads();
    if (threadIdx.x == 0) {
        unsigned* bar = b.bar;
        __builtin_amdgcn_s_waitcnt(0);
        unsigned nloc = b.st[0], nx = b.st[1];
        if (nloc == 0u) { xcd_barrier_complete(bar, b.x, nloc, nx); b.st[0] = nloc; b.st[1] = nx; }
        const unsigned old = xb_add(&bar[XB_XSUB(b.x)], 1u);
        const unsigned gen = old / nloc;
        if (old + 1u == (gen + 1u) * nloc) {
            __builtin_amdgcn_fence(__ATOMIC_RELEASE, "agent");
            asm volatile("s_waitcnt vmcnt(0)" ::: "memory");
            const unsigned og = xb_add(&bar[XB_TOP], 1u);
            const unsigned tg = og / nx;
            if (og + 1u == (tg + 1u) * nx) xb_add(&bar[XB_TOPGEN], 1u);
            else XB_SPIN(xb_ld(&bar[XB_TOPGEN]) == tg, bar);
            __builtin_amdgcn_fence(__ATOMIC_ACQUIRE, "agent");
            xb_add(&bar[XB_XGEN(b.x)], 1u);
            asm volatile("s_waitcnt vmcnt(0)" ::: "memory");
        } else {
            XB_SPIN(xb_ld(&bar[XB_XGEN(b.x)]) == gen, bar);
            __builtin_amdgcn_fence(__ATOMIC_ACQUIRE, "agent");
            asm volatile("s_waitcnt vmcnt(0)" ::: "memory");
        }
    }
    __syncthreads();
}

#define DI __device__ __forceinline__
constexpr int NWAVES = 8, NTHR = 512;
constexpr int BATCH = 4, SEQ = 4096, DM = 2048, TR = BATCH * SEQ, NMETA = 16, MIN_ROWS = 16640;
constexpr int INC = 4640, NP = 4864;
constexpr int CQ = 0, CK = 1024, CV = 1152, CR = 1280, CPK = 2304, CPV = 3328, CW = 4352, CA = 4416, CG = 4480;
constexpr int NEXP = 16384, NSEL = 128;
constexpr float RMS_EPS = 1e-6f, GN_EPS = 64e-5f;
constexpr int NPHASE = 9;
#ifndef MK_SPLIT
#define MK_SPLIT 0
#endif

constexpr size_t MiB = 1u << 20;
constexpr size_t WS_CTL = 0, CTL_ZERO_BYTES = 1 * MiB;
constexpr size_t WS_WIN = 1 * MiB, WS_WOUT = 20 * MiB, WS_WQS = 28 * MiB, WS_SUMSQ = 36 * MiB;
constexpr size_t WS_U = 40 * MiB;
constexpr size_t WS_P = 106 * MiB;
constexpr size_t WS_TD = 262 * MiB, WS_TU = 294 * MiB;
constexpr size_t WS_SCL = 37 * MiB;
constexpr size_t WS_LW = 38 * MiB;
constexpr size_t WS_IDX = 390 * MiB, WS_GATE = 398 * MiB;
#ifndef TBL_FP6
#define TBL_FP6 1
#endif
#ifndef TBL_FP4
#define TBL_FP4 1
#endif
constexpr int ROWB = TBL_FP4 ? 1152 : 1536;
#ifndef GATHER_SLICED
#define GATHER_SLICED 0
#endif
constexpr size_t WS_PART = 40 * MiB;
constexpr size_t WS_RW = 330 * MiB;
constexpr size_t WS_RWS = 460 * MiB;
constexpr size_t WS_END = 470 * MiB;
constexpr size_t WS_SC = 40 * MiB;
constexpr size_t WS_H1B = 170 * MiB;
static_assert(WS_U + (size_t)MIN_ROWS * DM * 2 <= WS_P && WS_P + (size_t)MIN_ROWS * NP * 2 <= WS_TD && WS_SC + (size_t)TR * DM * 4 <= WS_H1B && WS_H1B + (size_t)TR * DM * 2 <= WS_TD, "ws map");
constexpr int CW_BAR = 4096;
constexpr int RING_BYTES = 131072, LDSCTL_OFF = 159744, MISC_OFF = LDSCTL_OFF + 320, LDS_BYTES = 160256;

DI float bflo(unsigned w) { return __uint_as_float(w << 16); }
DI float bfhi(unsigned w) { return __uint_as_float(w & 0xffff0000u); }
DI float wave_sum(float v) {
#pragma unroll
    for (int o = 1; o < 64; o <<= 1) v += __shfl_xor(v, o);
    return v;
}
template <int CTRL> DI float dppf(float v) { return __int_as_float(__builtin_amdgcn_update_dpp(0, __float_as_int(v), CTRL, 0xf, 0xf, true)); }
DI float red8(float v) { v += dppf<0xB1>(v); v += dppf<0x4E>(v); v += dppf<0x141>(v); return v; }
DI float red16(float v) { v = red8(v); v += dppf<0x140>(v); return v; }
DI float max16(float v) { v = fmaxf(v, dppf<0xB1>(v)); v = fmaxf(v, dppf<0x4E>(v)); v = fmaxf(v, dppf<0x141>(v)); v = fmaxf(v, dppf<0x140>(v)); return v; }
DI float rdlane(float v, int l) { return __int_as_float(__builtin_amdgcn_readlane(__float_as_int(v), l)); }
DI float wave_max(float v) {
    v = max16(v);
    const float a = rdlane(v, 0), b = rdlane(v, 16), c = rdlane(v, 32), d = rdlane(v, 48);
    return fmaxf(fmaxf(a, b), fmaxf(c, d));
}
DI float frcp(float x) { return __builtin_amdgcn_rcpf(x); }
DI float frsq(float x) { return __builtin_amdgcn_rsqf(x); }
DI float sigmoidf_(float x) { return frcp(1.0f + __expf(-x)); }
DI float tanhf_(float x) { return 1.0f - 2.0f * frcp(1.0f + __expf(2.0f * x)); }
DI float softplusf_(float x) { return fmaxf(x, 0.f) + __logf(1.0f + __expf(-fabsf(x))); }
DI void rw_piece(int pi, int& tt, int& pc) {
    if (pi < 768) { tt = pi / 24; pc = pi - tt * 24; }
    else if (pi < 1024) { const int q = pi - 768; tt = q >> 3; pc = 24 + (q & 7); }
    else if (pi < 1280) { const int q = pi - 1024; tt = q >> 3; pc = 32 + (q & 7); }
    else { const int q = pi - 1280; tt = q / 20; pc = 40 + (q - tt * 20); }
}
typedef unsigned u32x2 __attribute__((ext_vector_type(2)));
typedef float f32x16 __attribute__((ext_vector_type(16)));
DI int crow(int reg, int h) { return (reg & 3) + 8 * (reg >> 2) + 4 * h; }
#define MFMA32(a, b, c) __builtin_amdgcn_mfma_f32_32x32x16_bf16((a), (b), (c), 0, 0, 0)
#define MFMA16(a, b, c) __builtin_amdgcn_mfma_f32_16x16x32_bf16((a), (b), (c), 0, 0, 0)
#define LBAR() do { asm volatile("s_waitcnt lgkmcnt(0)" ::: "memory"); __builtin_amdgcn_s_barrier(); asm volatile("" ::: "memory"); } while (0)

struct Frame {
    LAS unsigned char* lds;
    volatile LAS unsigned* MISC;
    gu32* ctl;
    int tid, lane, wave;
    int vcu, G;
    const float* in[24];
    float* out; unsigned char* ws;
};
#define IN_X 0
#define IN_META 1
#define IN_N1G 2
#define IN_WIN 3
#define IN_MU 4
#define IN_W0 5
#define IN_WUP 6
#define IN_A0 7
#define IN_AUP 8
#define IN_GUP 9
#define IN_KK 10
#define IN_KA 11
#define IN_RK 12
#define IN_GNW 13
#define IN_GNB 14
#define IN_QG 15
#define IN_KG 16
#define IN_SINK 17
#define IN_WOUT 18
#define IN_N2G 19
#define IN_PQ 20
#define IN_PSK 21
#define IN_PD 22
#define IN_PU 23

DI void p0_transpose_item(const float* W, int K, int N, bf16* WT, int row_off, LAS float* scr, int item, int lane) {
    const int nblk = N / 32, kb = item / nblk, nb = item % nblk, k0 = 64 * kb, n0 = 32 * nb;
#pragma unroll 8
    for (int i = 0; i < 32; ++i) { const int kk = 2 * i + (lane >> 5); scr[kk * 33 + (lane & 31)] = W[(size_t)(k0 + kk) * N + n0 + (lane & 31)]; }
    LDS_WAIT(); asm volatile("" ::: "memory");
    const int c = lane & 7;
#pragma unroll
    for (int j = 0; j < 4; ++j) { const int n = (lane >> 3) + 8 * j; const LAS float* s = scr + (8 * c) * 33 + n;
        v4u o; o.x = pk2(s[0 * 33], s[1 * 33]); o.y = pk2(s[2 * 33], s[3 * 33]); o.z = pk2(s[4 * 33], s[5 * 33]); o.w = pk2(s[6 * 33], s[7 * 33]);
        *(GAS v4u*)(WT + (size_t)(row_off + n0 + n) * K + k0 + 8 * c) = o; }
    LDS_WAIT(); asm volatile("" ::: "memory");
}
DI void rms_row_to_bf16(const float* xrow, const float* g, bf16* orow, int lane) {
    const GAS f32x4* xr = (const GAS f32x4*)xrow + lane; const GAS f32x4* gr = (const GAS f32x4*)g + lane;
    f32x4 v[8]; float s = 0.f;
#pragma unroll
    for (int j = 0; j < 8; ++j) { v[j] = xr[64 * j]; s += (v[j].x * v[j].x + v[j].y * v[j].y) + (v[j].z * v[j].z + v[j].w * v[j].w); }
    const float rs = 1.0f / sqrtf(wave_sum(s) * (1.0f / DM) + RMS_EPS);
    GAS unsigned long long* o8 = (GAS unsigned long long*)orow + lane;
#pragma unroll
    for (int j = 0; j < 8; ++j) { const f32x4 gg = gr[64 * j];
        o8[64 * j] = (unsigned long long)pk2(v[j].x * rs * gg.x, v[j].y * rs * gg.y) | ((unsigned long long)pk2(v[j].z * rs * gg.z, v[j].w * rs * gg.w) << 32); }
}
#ifndef P0_REP
#define P0_REP 0
#endif
DI void p0_prologue(Frame& F) {
    const int tid = F.tid, lane = F.lane, wave = F.wave;
    const int gw = F.vcu * NWAVES + wave, NGW = F.G * NWAVES;
    const size_t gt = (size_t)blockIdx.x * NTHR + tid, NT = (size_t)F.G * NTHR;
    bf16* Win_t = (bf16*)(F.ws + WS_WIN); bf16* Wout_t = (bf16*)(F.ws + WS_WOUT); bf16* Wqs_t = (bf16*)(F.ws + WS_WQS);
    bf16* U = (bf16*)(F.ws + WS_U);
    float* sumsq = (float*)(F.ws + WS_SUMSQ);
    for (int rp_ = 0; rp_ < ((P0_REP & 1) ? 2 : 1); ++rp_)
    {
        LAS float* scr = (LAS float*)(F.lds + wave * 16384);
        constexpr int I_IN = (DM / 64) * (INC / 32), I_OUT = (DM / 64) * (DM / 32);
        for (int it = gw; it < I_IN + I_OUT; it += NGW) {
            if (it < I_IN) p0_transpose_item(F.in[IN_WIN], DM, INC, Win_t, 0, scr, it, lane);
            else p0_transpose_item(F.in[IN_WOUT], DM, DM, Wout_t, 0, scr, it - I_IN, lane);
        }
        const size_t nz = (size_t)(NP - INC) * DM * 2 / 16;
        GAS v4u* z = (GAS v4u*)(Win_t + (size_t)INC * DM);
        for (size_t i = gt; i < nz; i += NT) z[i] = (v4u){0u, 0u, 0u, 0u};
    }
    for (int rp_ = 0; rp_ < ((P0_REP & 2) ? 2 : 1); ++rp_)
    {
        f32x4 nv[8];
        auto row_src = [&](int m_) -> const float* { return m_ < TR ? F.in[IN_X] + (size_t)m_ * DM : F.in[IN_META] + (size_t)((m_ < TR + NMETA ? m_ : TR) - TR) * DM; };
        if (gw < MIN_ROWS) { const GAS f32x4* xr = (const GAS f32x4*)row_src(gw) + lane;
#pragma unroll
            for (int j = 0; j < 8; ++j) nv[j] = xr[64 * j]; }
#pragma unroll 1
        for (int m = gw; m < MIN_ROWS; m += NGW) {
            f32x4 v[8];
#pragma unroll
            for (int j = 0; j < 8; ++j) v[j] = nv[j];
            { const int nm = m + NGW < MIN_ROWS ? m + NGW : m; const GAS f32x4* xr = (const GAS f32x4*)row_src(nm) + lane;
#pragma unroll
              for (int j = 0; j < 8; ++j) nv[j] = xr[64 * j]; }
            if (m < TR + NMETA) {
                float ss = 0.f;
#pragma unroll
                for (int j = 0; j < 8; ++j) ss += (v[j].x * v[j].x + v[j].y * v[j].y) + (v[j].z * v[j].z + v[j].w * v[j].w);
                const float rs = 1.0f / sqrtf(wave_sum(ss) * (1.0f / DM) + RMS_EPS);
                const GAS f32x4* gr = (const GAS f32x4*)F.in[IN_N1G] + lane;
                GAS unsigned long long* o8 = (GAS unsigned long long*)(U + (size_t)m * DM) + lane;
#pragma unroll
                for (int j = 0; j < 8; ++j) { const f32x4 gg = gr[64 * j];
                    o8[64 * j] = (unsigned long long)pk2(v[j].x * rs * gg.x, v[j].y * rs * gg.y) | ((unsigned long long)pk2(v[j].z * rs * gg.z, v[j].w * rs * gg.w) << 32); }
            } else { GAS v4u* o = (GAS v4u*)(U + (size_t)m * DM) + lane;
#pragma unroll
                for (int j = 0; j < 4; ++j) o[64 * j] = (v4u){0u, 0u, 0u, 0u}; }
        }
    }
#if TBL_FP6 && !GATHER_SLICED
    for (int rp_ = 0; rp_ < ((P0_REP & 4) ? 2 : 1); ++rp_)
    {
        unsigned char* T8D = F.ws + WS_TD; unsigned char* T8U = F.ws + WS_TU; float* SCL = (float*)(F.ws + WS_SCL);
        const float* g2 = F.in[IN_N2G];
        typedef float f32x16v __attribute__((ext_vector_type(16)));
        f32x4 nv[8];
        if (gw < 2 * NEXP) { const float* src = (gw >= NEXP ? F.in[IN_PU] + (size_t)(gw - NEXP) * DM : F.in[IN_PD] + (size_t)gw * DM) + lane * 4;
#pragma unroll
            for (int j = 0; j < 8; ++j) nv[j] = *(const GAS f32x4*)(src + 256 * j); }
#pragma unroll 1
        for (int row = gw; row < 2 * NEXP; row += NGW) {
            const bool up = row >= NEXP; const int e = up ? row - NEXP : row;
            f32x4 v[8]; float m = 0.f;
#pragma unroll
            for (int j = 0; j < 8; ++j) v[j] = nv[j];
            { const int nr = row + NGW < 2 * NEXP ? row + NGW : row; const float* src = (nr >= NEXP ? F.in[IN_PU] + (size_t)(nr - NEXP) * DM : F.in[IN_PD] + (size_t)nr * DM) + lane * 4;
#pragma unroll
              for (int j = 0; j < 8; ++j) nv[j] = *(const GAS f32x4*)(src + 256 * j); }
#pragma unroll
            for (int j = 0; j < 8; ++j) {
                f32x4 a = v[j];
                if (!up) a = a * *(const GAS f32x4*)(g2 + 256 * j + lane * 4);
                v[j] = a; m = fmaxf(m, fmaxf(fmaxf(fabsf(a.x), fabsf(a.y)), fmaxf(fabsf(a.z), fabsf(a.w))));
            }
#if TBL_FP4
            {
                float bsf = m > 0.f ? m * (1.0f / 6.0f) : 1.0f;
                const unsigned bsb = (__float_as_uint(bsf) + 0xffffu) >> 16; bsf = __uint_as_float(bsb << 16);
                const float inv = 1.0f / bsf;
                v4u d;
#pragma unroll
                for (int w = 0; w < 4; ++w) { unsigned o = 0u;
                    o = __builtin_amdgcn_cvt_scalef32_pk_fp4_f32(o, v[2 * w].x * inv, v[2 * w].y * inv, 1.0f, 0);
                    o = __builtin_amdgcn_cvt_scalef32_pk_fp4_f32(o, v[2 * w].z * inv, v[2 * w].w * inv, 1.0f, 1);
                    o = __builtin_amdgcn_cvt_scalef32_pk_fp4_f32(o, v[2 * w + 1].x * inv, v[2 * w + 1].y * inv, 1.0f, 2);
                    o = __builtin_amdgcn_cvt_scalef32_pk_fp4_f32(o, v[2 * w + 1].z * inv, v[2 * w + 1].w * inv, 1.0f, 3);
                    d[w] = o; }
                unsigned char* dst = (up ? T8U : T8D) + (size_t)e * ROWB;
                *(GAS v4u*)(dst + 16 * lane) = d; *(GAS unsigned short*)(dst + 1024 + 2 * lane) = (unsigned short)bsb;
                continue;
            }
#endif
            m = wave_max(m);
            const float sc = m > 0.f ? 7.0f / m : 1.0f;
            f32x16v x0, x1;
#pragma unroll
            for (int j = 0; j < 8; ++j) { x0[2 * j] = v[j].x * sc; x1[2 * j] = v[j].y * sc; x0[2 * j + 1] = v[j].z * sc; x1[2 * j + 1] = v[j].w * sc; }
            const auto pk = __builtin_amdgcn_cvt_scalef32_2xpk16_fp6_f32(x0, x1, 1.0f);
            unsigned char* dst = (up ? T8U : T8D) + (size_t)e * 1536 + lane * 24;
            *(GAS u32x2*)(dst) = (u32x2){pk[0], pk[1]}; *(GAS u32x2*)(dst + 8) = (u32x2){pk[2], pk[3]}; *(GAS u32x2*)(dst + 16) = (u32x2){pk[4], pk[5]};
            if (lane == 0) SCL[row] = m > 0.f ? m * (1.0f / 7.0f) : 1.0f;
        }
    }
#else
    {
        unsigned char* T8D = F.ws + WS_TD; unsigned char* T8U = F.ws + WS_TU; float* SCL = (float*)(F.ws + WS_SCL);
        const float* g2 = F.in[IN_N2G];
        for (int row = gw; row < 2 * NEXP; row += NGW) {
            const bool up = row >= NEXP; const int e = up ? row - NEXP : row;
            const float* src = (up ? F.in[IN_PU] : F.in[IN_PD]) + (size_t)e * DM;
            f32x4 v[2][4]; float m = 0.f;
#pragma unroll
            for (int c = 0; c < 2; ++c)
#pragma unroll
                for (int j = 0; j < 4; ++j) {
                    const int col = c * 1024 + lane * 16 + j * 4;
                    f32x4 a = *(const GAS f32x4*)(src + col);
                    if (!up) a = a * *(const GAS f32x4*)(g2 + col);
                    v[c][j] = a; m = fmaxf(m, fmaxf(fmaxf(fabsf(a.x), fabsf(a.y)), fmaxf(fabsf(a.z), fabsf(a.w))));
                }
            m = wave_max(m);
            const float sc = m > 0.f ? 440.0f / m : 1.0f;
#pragma unroll
            for (int c = 0; c < 2; ++c) {
                v4u o; unsigned w;
                w = (unsigned)__builtin_amdgcn_cvt_pk_fp8_f32(v[c][0].x * sc, v[c][0].y * sc, 0, false); w = (unsigned)__builtin_amdgcn_cvt_pk_fp8_f32(v[c][0].z * sc, v[c][0].w * sc, (int)w, true); o.x = w;
                w = (unsigned)__builtin_amdgcn_cvt_pk_fp8_f32(v[c][1].x * sc, v[c][1].y * sc, 0, false); w = (unsigned)__builtin_amdgcn_cvt_pk_fp8_f32(v[c][1].z * sc, v[c][1].w * sc, (int)w, true); o.y = w;
                w = (unsigned)__builtin_amdgcn_cvt_pk_fp8_f32(v[c][2].x * sc, v[c][2].y * sc, 0, false); w = (unsigned)__builtin_amdgcn_cvt_pk_fp8_f32(v[c][2].z * sc, v[c][2].w * sc, (int)w, true); o.z = w;
                w = (unsigned)__builtin_amdgcn_cvt_pk_fp8_f32(v[c][3].x * sc, v[c][3].y * sc, 0, false); w = (unsigned)__builtin_amdgcn_cvt_pk_fp8_f32(v[c][3].z * sc, v[c][3].w * sc, (int)w, true); o.w = w;
#if GATHER_SLICED
                *(GAS v4u*)((up ? T8U : T8D) + (size_t)(4 * c + (lane >> 4)) * ((size_t)NEXP * 256) + (size_t)e * 256 + (lane & 15) * 16) = o;
#else
                *(GAS v4u*)((up ? T8U : T8D) + (size_t)e * DM + c * 1024 + lane * 16) = o;
#endif
            }
            if (lane == 0) SCL[row] = m > 0.f ? m * (1.0f / 440.0f) : 1.0f;
        }
    }
#endif
    {
        bf16* LWU = (bf16*)(F.ws + WS_LW); bf16* LWA = LWU + 1024 * 64; bf16* LWG = LWA + 1024 * 64;
        for (size_t i = gt; i < (size_t)1024 * 64; i += NT) { const int n = (int)(i >> 6), k = (int)(i & 63); LWU[i] = (bf16)f2bf(F.in[IN_WUP][k * 1024 + n]); LWA[i] = (bf16)f2bf(F.in[IN_AUP][k * 1024 + n]); }
        for (size_t i = gt; i < (size_t)1024 * 160; i += NT) { const int n = (int)(i / 160), k = (int)(i % 160); LWG[i] = (bf16)f2bf(F.in[IN_GUP][k * 1024 + n]); }
    }
    for (size_t i = gt; i < (size_t)TR; i += NT) sumsq[i] = 0.f;
    __syncthreads();
    for (int rp_ = 0; rp_ < ((P0_REP & 8) ? 2 : 1); ++rp_)
    {
        LAS float* sk = (LAS float*)F.lds;
        LAS float* wq = (LAS float*)(F.lds + 128 * 132 * 4);
        const float* PQ = F.in[IN_PQ]; const float* PSK = F.in[IN_PSK]; const float* g2 = F.in[IN_N2G];
        for (int unit = F.vcu; unit < 512; unit += F.G) {
            const int hc = unit >> 5, k0 = (unit & 31) * 64;
            for (int i = tid; i < 128 * 32; i += NTHR) { const int n = i >> 5, d4 = (i & 31) * 4; *(LAS f32x4*)(sk + n * 132 + d4) = *(const GAS f32x4*)(PSK + (size_t)hc * 16384 + n * 128 + d4); }
            for (int i = tid; i < 64 * 32; i += NTHR) { const int k = i >> 5, d4 = (i & 31) * 4; *(LAS f32x4*)(wq + k * 132 + d4) = *(const GAS f32x4*)(PQ + (size_t)(k0 + k) * DM + hc * 128 + d4); }
            __syncthreads();
            const int n4 = tid >> 4, k4 = tid & 15;
            float acc[4][4];
#pragma unroll
            for (int i = 0; i < 4; ++i)
#pragma unroll
                for (int j = 0; j < 4; ++j) acc[i][j] = 0.f;
            for (int d = 0; d < 128; d += 4) {
                f32x4 a[4], b[4];
#pragma unroll
                for (int i = 0; i < 4; ++i) a[i] = *(LAS f32x4*)(sk + (n4 + 32 * i) * 132 + d);
#pragma unroll
                for (int j = 0; j < 4; ++j) b[j] = *(LAS f32x4*)(wq + (k4 + 16 * j) * 132 + d);
#pragma unroll
                for (int i = 0; i < 4; ++i)
#pragma unroll
                    for (int j = 0; j < 4; ++j) acc[i][j] += (a[i].x * b[j].x + a[i].y * b[j].y) + (a[i].z * b[j].z + a[i].w * b[j].w);
            }
#pragma unroll
            for (int i = 0; i < 4; ++i)
#pragma unroll
                for (int j = 0; j < 4; ++j) { const int n = n4 + 32 * i, k = k0 + k4 + 16 * j; Wqs_t[(size_t)(hc * 128 + n) * DM + k] = (bf16)f2bf(acc[i][j] * g2[k]); }
            __syncthreads();
        }
    }
}

DI int attn_keyrow(int b, int n, int kk) {
    if (kk >= 128) return b * SEQ + 128 * n + (kk - 128);
    if (n > 0) return b * SEQ + 128 * (n - 1) + kk;
    return kk >= 112 ? TR + (kk - 112) : -1;
}
DI void attn_unit(Frame& F, int u) {
    const int tid = F.tid, lane = F.lane, wave = F.wave;
    const int b = u >> 6, kvh = (u >> 5) & 1, n = u & 31;
    const bf16* P = (const bf16*)(F.ws + WS_P); bf16* Y = (bf16*)(F.ws + WS_U);
    LAS bf16* Ks = (LAS bf16*)F.lds;
    LAS bf16* VT = (LAS bf16*)(F.lds + 256 * 144);
    const float* kg = F.in[IN_KG]; const float* qg = F.in[IN_QG];
    for (int c = tid; c < 2048; c += NTHR) {
        const int key = c >> 3, ch = c & 7; const int row = attn_keyrow(b, n, key);
        v4u rk = (v4u){0u, 0u, 0u, 0u}, rv = (v4u){0u, 0u, 0u, 0u};
        if (row >= 0) { rk = *(const GAS v4u*)(P + (size_t)row * NP + CK + kvh * 64 + ch * 8); rv = *(const GAS v4u*)(P + (size_t)row * NP + CV + kvh * 64 + ch * 8); }
        float kv[8] = {bflo(rk.x), bfhi(rk.x), bflo(rk.y), bfhi(rk.y), bflo(rk.z), bfhi(rk.z), bflo(rk.w), bfhi(rk.w)};
        float ss = 0.f;
#pragma unroll
        for (int e = 0; e < 8; ++e) ss += kv[e] * kv[e];
        ss = red8(ss);
        const float rs = 1.0f / sqrtf(ss * (1.0f / 64.0f) + RMS_EPS);
#pragma unroll
        for (int e = 0; e < 8; ++e) kv[e] = kv[e] * rs * kg[ch * 8 + e];
        v4u o; o.x = pk2(kv[0], kv[1]); o.y = pk2(kv[2], kv[3]); o.z = pk2(kv[4], kv[5]); o.w = pk2(kv[6], kv[7]);
        *(LAS v4u*)(Ks + key * 72 + ch * 8) = o;
        LAS bf16* vt = VT + (ch * 8) * 260 + key;
        vt[0 * 260] = (bf16)(rv.x & 0xffffu); vt[1 * 260] = (bf16)(rv.x >> 16); vt[2 * 260] = (bf16)(rv.y & 0xffffu); vt[3 * 260] = (bf16)(rv.y >> 16);
        vt[4 * 260] = (bf16)(rv.z & 0xffffu); vt[5 * 260] = (bf16)(rv.z >> 16); vt[6 * 260] = (bf16)(rv.w & 0xffffu); vt[7 * 260] = (bf16)(rv.w >> 16);
    }
    __syncthreads();
    const int r = lane & 31, hh = lane >> 5, hq = kvh * 8 + wave;
    const float sink = F.in[IN_SINK][hq];
#pragma unroll 1
    for (int qb = 0; qb < 4; ++qb) {
        const int qi = 32 * qb + r;
        const size_t qrow = (size_t)(b * SEQ + 128 * n + qi);
        bf16x8 qf[4];
        {
            v4u raw[4]; float ss = 0.f;
#pragma unroll
            for (int s4 = 0; s4 < 4; ++s4) {
                raw[s4] = *(const GAS v4u*)(P + qrow * NP + CQ + hq * 64 + 16 * s4 + 8 * hh);
                const float q0 = bflo(raw[s4].x), q1 = bfhi(raw[s4].x), q2 = bflo(raw[s4].y), q3 = bfhi(raw[s4].y), q4 = bflo(raw[s4].z), q5 = bfhi(raw[s4].z), q6 = bflo(raw[s4].w), q7 = bfhi(raw[s4].w);
                ss += (q0 * q0 + q1 * q1) + (q2 * q2 + q3 * q3) + (q4 * q4 + q5 * q5) + (q6 * q6 + q7 * q7);
            }
            ss += __shfl_xor(ss, 32);
            const float rs = 0.125f / sqrtf(ss * (1.0f / 64.0f) + RMS_EPS);
#pragma unroll
            for (int s4 = 0; s4 < 4; ++s4) {
                const float* gq = qg + 16 * s4 + 8 * hh;
                v4u w;
                w.x = pk2(bflo(raw[s4].x) * rs * gq[0], bfhi(raw[s4].x) * rs * gq[1]);
                w.y = pk2(bflo(raw[s4].y) * rs * gq[2], bfhi(raw[s4].y) * rs * gq[3]);
                w.z = pk2(bflo(raw[s4].z) * rs * gq[4], bfhi(raw[s4].z) * rs * gq[5]);
                w.w = pk2(bflo(raw[s4].w) * rs * gq[6], bfhi(raw[s4].w) * rs * gq[7]);
                qf[s4] = __builtin_bit_cast(bf16x8, w);
            }
        }
        f32x16 acc[5];
        float mx = sink;
#pragma unroll
        for (int j = 0; j < 5; ++j) {
            const int kt = qb + j;
#pragma unroll
            for (int g = 0; g < 16; ++g) acc[j][g] = 0.f;
#pragma unroll
            for (int s4 = 0; s4 < 4; ++s4) { const bf16x8 a = *(const LAS bf16x8*)(Ks + (32 * kt + r) * 72 + 16 * s4 + 8 * hh); acc[j] = MFMA32(a, qf[s4], acc[j]); }
#pragma unroll
            for (int g = 0; g < 16; ++g) {
                const int kk = 32 * kt + crow(g, hh);
                const bool valid = (kk < 128) ? (kk > qi && (n > 0 || kk >= 112)) : (kk - 128 <= qi);
                const float sv = valid ? acc[j][g] : -INFINITY;
                acc[j][g] = sv; mx = fmaxf(mx, sv);
            }
        }
        mx = fmaxf(mx, __shfl_xor(mx, 32));
        float l = 0.f;
#pragma unroll
        for (int j = 0; j < 5; ++j)
#pragma unroll
            for (int g = 0; g < 16; ++g) { const float p = __expf(acc[j][g] - mx); acc[j][g] = p; l += p; }
        l += __shfl_xor(l, 32);
        l += __expf(sink - mx);
        const float inv = 1.0f / l;
        f32x16 o[2];
#pragma unroll
        for (int g = 0; g < 16; ++g) { o[0][g] = 0.f; o[1][g] = 0.f; }
#pragma unroll
        for (int j = 0; j < 5; ++j) {
            const int kt = qb + j;
#pragma unroll
            for (int s2 = 0; s2 < 2; ++s2) {
                v4u w;
                w.x = pk2(acc[j][8 * s2 + 0], acc[j][8 * s2 + 1]); w.y = pk2(acc[j][8 * s2 + 2], acc[j][8 * s2 + 3]);
                w.z = pk2(acc[j][8 * s2 + 4], acc[j][8 * s2 + 5]); w.w = pk2(acc[j][8 * s2 + 6], acc[j][8 * s2 + 7]);
                const bf16x8 pb = __builtin_bit_cast(bf16x8, w);
#pragma unroll
                for (int dt = 0; dt < 2; ++dt) {
                    const LAS bf16* vp = VT + (32 * dt + r) * 260 + 32 * kt + 16 * s2 + 4 * hh;
                    const u32x2 lo = *(const LAS u32x2*)vp, hi = *(const LAS u32x2*)(vp + 8);
                    v4u av; av.x = lo.x; av.y = lo.y; av.z = hi.x; av.w = hi.y;
                    o[dt] = MFMA32(__builtin_bit_cast(bf16x8, av), pb, o[dt]);
                }
            }
        }
#pragma unroll
        for (int dt = 0; dt < 2; ++dt)
#pragma unroll
            for (int gg = 0; gg < 4; ++gg) {
                u32x2 w; w.x = pk2(o[dt][4 * gg + 0] * inv, o[dt][4 * gg + 1] * inv); w.y = pk2(o[dt][4 * gg + 2] * inv, o[dt][4 * gg + 3] * inv);
                *(GAS u32x2*)(Y + qrow * DM + 1024 + hq * 64 + 32 * dt + 8 * gg + 4 * hh) = w;
            }
    }
    __syncthreads();
}

constexpr int RC = 32;
DI int rwkv_row(int b, int sg) { return sg >= 32 ? b * SEQ + (sg - 32) : (sg >= 16 ? TR + (sg - 16) : -1); }
constexpr int RW_NCH = (32 + SEQ) / 32, RW_SEG0 = 33, RW_SEGN = 32;
DI void rwkv_pass1(Frame& F, int unit) {
    const int tid = F.tid, lane = F.lane, wave = F.wave;
    const int bh = unit & 63, seg = unit >> 6;
    const int b = bh >> 4, h = bh & 15;
    const int c_lo = seg == 0 ? 0 : RW_SEG0 + RW_SEGN * (seg - 1), c_hi = RW_SEG0 + RW_SEGN * seg;
    unsigned char* const blob0 = F.ws + WS_RW + (size_t)bh * RW_NCH * 16384;
    float* const HS = (float*)(F.ws + WS_RWS) + (size_t)(bh * 4 + seg) * 8192;
    const bf16* P = (const bf16*)(F.ws + WS_P); bf16* Y = (bf16*)(F.ws + WS_U);
    const bf16* LWU = (const bf16*)(F.ws + WS_LW); const bf16* LWA = LWU + 1024 * 64; const bf16* LWG = LWA + 1024 * 64;
    LAS float* XR = (LAS float*)(F.lds + 0);
    LAS float* XK = (LAS float*)(F.lds + 8192);
    LAS float* XV = (LAS float*)(F.lds + 16384);
    LAS float* LD = (LAS float*)(F.lds + 24576);
    LAS float* AA = (LAS float*)(F.lds + 32768);
    LAS float* GG = (LAS float*)(F.lds + 40960);
    LAS bf16* TW = (LAS bf16*)(F.lds + 57344);
    LAS bf16* XA = (LAS bf16*)(F.lds + 57344 + 4608);
    LAS bf16* SG = (LAS bf16*)(F.lds + 57344 + 9216);
    LAS bf16* At = (LAS bf16*)(F.lds + 57344);
    LAS bf16* Rt = At + 32 * 72; LAS bf16* Bt = Rt + 32 * 72; LAS bf16* Kt = Bt + 32 * 72;
    LAS bf16* BTt = (LAS bf16*)(F.lds + 77312);
    LAS bf16* KTt = BTt + 64 * 40; LAS bf16* VT = KTt + 64 * 40;
    LAS bf16* LAK = (LAS bf16*)(F.lds + 92672);
    LAS bf16* MRB = LAK + 32 * 40; LAS bf16* MRK = MRB + 32 * 40; LAS bf16* LAB = MRK + 32 * 40;
    LAS float* LAB32 = (LAS float*)(F.lds + 102912);
    LAS bf16* TJ = (LAS bf16*)(F.lds + 107520);
    LAS float* GAM = (LAS float*)(F.lds + 110080);
    LAS bf16* SwAll = (LAS bf16*)(F.lds + 118528);
    LAS bf16* USCAll = (LAS bf16*)(F.lds + 0);
    LAS bf16* UTAll = (LAS bf16*)(F.lds + 10240);
    LAS float* MUL = (LAS float*)(F.lds + 49152);
    LAS float* HC = (LAS float*)(F.lds + 49152 + 1920);
    LAS bf16* GUt = (LAS bf16*)(F.lds + 137984);
    __syncthreads();
    for (int i = tid; i < (110336 - 107520) / 4; i += NTHR) ((LAS unsigned*)(F.lds + 107520))[i] = 0u;
    if (tid < 480) { const int pc = tid >> 3, e = tid & 7; const int mui = pc < 8 ? h * 64 + pc * 8 : (pc < 16 ? 1024 + h * 64 + (pc - 8) * 8 : (pc < 24 ? 2048 + h * 64 + (pc - 16) * 8 : 3072 + (pc - 24) * 8)); MUL[tid] = F.in[IN_MU][mui + e]; }
    if (tid < 448) { const int q = tid >> 6, j = tid & 63; const float* src = q == 0 ? F.in[IN_W0] : (q == 1 ? F.in[IN_A0] : (q == 2 ? F.in[IN_KK] : (q == 3 ? F.in[IN_KA] : (q == 4 ? F.in[IN_RK] : (q == 5 ? F.in[IN_GNW] : F.in[IN_GNB]))))); HC[tid] = src[h * 64 + j]; }
    const int cw = wave & 3; const bool idw = wave >= 4;
    LAS bf16* Sw = SwAll + wave * 16 * 72; LAS bf16* USC = USCAll + wave * 16 * 40; LAS bf16* UT = UTAll + wave * 16 * 40;
    f32x4 accZ[4];
    {
        const int r16i = lane & 15, kqi = lane >> 4;
#pragma unroll
        for (int q = 0; q < 4; ++q) {
#pragma unroll
            for (int e = 0; e < 4; ++e) accZ[q][e] = (idw && (16 * q + 4 * kqi + e == 16 * cw + r16i)) ? 1.f : 0.f;
            *(LAS u32x2*)(Sw + r16i * 72 + 16 * q + 4 * kqi) = (u32x2){pk2(accZ[q][0], accZ[q][1]), pk2(accZ[q][2], accZ[q][3])};
        }
    }
    const int lmat = wave >> 1, lnt = wave & 1;
    bf16x8 bw[4];
    {
        const int r = lane & 31, hh = lane >> 5;
        const bf16* Bg = (lmat == 1 ? LWA : LWU) + (size_t)(h * 64 + 32 * lnt + r) * 64 + 8 * hh;
#pragma unroll
        for (int sx = 0; sx < 4; ++sx) bw[sx] = __builtin_bit_cast(bf16x8, *(const GAS v4u*)(Bg + 16 * sx));
    }
    for (int i = tid; i < 64 * 20; i += NTHR) { const int nn = i / 20, k8 = (i % 20) * 8; *(LAS v4u*)(GUt + nn * 168 + k8) = *(const GAS v4u*)(LWG + (size_t)(h * 64 + nn) * 160 + k8); }
    v4u pfc[4], pfp[4];
#define RW_PREFETCH(cc) do { _Pragma("unroll") for (int it = 0; it < 4; ++it) { const int pi = tid + NTHR * it; pfc[it] = (v4u){0u, 0u, 0u, 0u}; pfp[it] = (v4u){0u, 0u, 0u, 0u}; \
        if (pi < RC * 60) { int tt, pc; rw_piece(pi, tt, pc); const int col = pc < 8 ? CR + h * 64 + pc * 8 : (pc < 16 ? CPK + h * 64 + (pc - 8) * 8 : (pc < 24 ? CPV + h * 64 + (pc - 16) * 8 : CW + (pc - 24) * 8)); \
            const int sg = RC * (cc) + tt; const int row = rwkv_row(b, sg), rowp = rwkv_row(b, sg - 1); \
            if (row >= 0) pfc[it] = *(const GAS v4u*)(P + (size_t)row * NP + col); if (rowp >= 0) pfp[it] = *(const GAS v4u*)(P + (size_t)rowp * NP + col); } } } while (0)
    RW_PREFETCH(c_lo);
    __syncthreads();
    for (int c = c_lo; c < c_hi; ++c) {
        int tidv = tid; asm volatile("" : "+v"(tidv));
        const int lanev = tidv & 63; const int r16 = lanev & 15, kq = lanev >> 4;
#pragma unroll
        for (int it = 0; it < 4; ++it) {
            const int pi = tidv + NTHR * it;
            if (pi < RC * 60) {
                int tt, pc; rw_piece(pi, tt, pc);
                const v4u rc_ = pfc[it], rp_ = pfp[it];
                const float cu[8] = {bflo(rc_.x), bfhi(rc_.x), bflo(rc_.y), bfhi(rc_.y), bflo(rc_.z), bfhi(rc_.z), bflo(rc_.w), bfhi(rc_.w)};
                const float pr[8] = {bflo(rp_.x), bfhi(rp_.x), bflo(rp_.y), bfhi(rp_.y), bflo(rp_.z), bfhi(rp_.z), bflo(rp_.w), bfhi(rp_.w)};
                const f32x4 m0 = *(LAS f32x4*)(MUL + pc * 8), m1 = *(LAS f32x4*)(MUL + pc * 8 + 4);
                const float mv[8] = {m0.x, m0.y, m0.z, m0.w, m1.x, m1.y, m1.z, m1.w};
                float xs[8];
#pragma unroll
                for (int e = 0; e < 8; ++e) xs[e] = cu[e] + mv[e] * (pr[e] - cu[e]);
                if (pc < 24) {
                    LAS float* dst = (pc < 8 ? XR : (pc < 16 ? XK : XV)) + tt * 64 + (pc & 7) * 8;
                    *(LAS f32x4*)dst = (f32x4){xs[0], xs[1], xs[2], xs[3]}; *(LAS f32x4*)(dst + 4) = (f32x4){xs[4], xs[5], xs[6], xs[7]};
                } else if (pc < 32) {
                    v4u o; o.x = pk2(tanhf_(xs[0]), tanhf_(xs[1])); o.y = pk2(tanhf_(xs[2]), tanhf_(xs[3])); o.z = pk2(tanhf_(xs[4]), tanhf_(xs[5])); o.w = pk2(tanhf_(xs[6]), tanhf_(xs[7]));
                    *(LAS v4u*)(TW + tt * 72 + (pc - 24) * 8) = o;
                } else if (pc < 40) {
                    v4u o; o.x = pk2(xs[0], xs[1]); o.y = pk2(xs[2], xs[3]); o.z = pk2(xs[4], xs[5]); o.w = pk2(xs[6], xs[7]);
                    *(LAS v4u*)(XA + tt * 72 + (pc - 32) * 8) = o;
                } else {
                    v4u o; o.x = pk2(sigmoidf_(xs[0]), sigmoidf_(xs[1])); o.y = pk2(sigmoidf_(xs[2]), sigmoidf_(xs[3])); o.z = pk2(sigmoidf_(xs[4]), sigmoidf_(xs[5])); o.w = pk2(sigmoidf_(xs[6]), sigmoidf_(xs[7]));
                    *(LAS v4u*)(SG + tt * 168 + (pc - 40) * 8) = o;
                }
            }
        }
        if (c + 1 < c_hi) RW_PREFETCH(c + 1);
        LBAR();
        if (wave < 6) {
            const int r = lanev & 31, hh = lanev >> 5;
            const LAS bf16* Ab = lmat == 0 ? TW : (lmat == 1 ? XA : SG);
            const int sa = lmat == 2 ? 168 : 72;
            f32x16 acc;
#pragma unroll
            for (int g = 0; g < 16; ++g) acc[g] = 0.f;
            if (lmat == 2) {
#pragma unroll
                for (int sx = 0; sx < 10; ++sx) acc = MFMA32(*(const LAS bf16x8*)(Ab + r * sa + 16 * sx + 8 * hh), *(const LAS bf16x8*)(GUt + (32 * lnt + r) * 168 + 16 * sx + 8 * hh), acc);
            } else {
#pragma unroll
                for (int sx = 0; sx < 4; ++sx) acc = MFMA32(*(const LAS bf16x8*)(Ab + r * sa + 16 * sx + 8 * hh), bw[sx], acc);
            }
            const int nn = 32 * lnt + r;
            if (lmat == 0) {
                const float w0 = HC[nn];
                float ldv[16], rsum[4], osum[4];
#pragma unroll
                for (int g = 0; g < 16; ++g) { const float wl = w0 + acc[g]; const float wlog = -softplusf_(-wl) - 0.5f; ldv[g] = -__expf(wlog); }
#pragma unroll
                for (int gg = 0; gg < 4; ++gg) { rsum[gg] = (ldv[4 * gg] + ldv[4 * gg + 1]) + (ldv[4 * gg + 2] + ldv[4 * gg + 3]); osum[gg] = __shfl_xor(rsum[gg], 32); }
                float off = 0.f;
#pragma unroll
                for (int gg = 0; gg < 4; ++gg) {
                    float cs = off + (hh ? osum[gg] : 0.f);
#pragma unroll
                    for (int e = 0; e < 4; ++e) { cs += ldv[4 * gg + e]; LD[(8 * gg + 4 * hh + e) * 64 + nn] = cs; }
                    off += rsum[gg] + osum[gg];
                }
            } else if (lmat == 1) { const float a0 = HC[64 + nn];
#pragma unroll
                for (int g = 0; g < 16; ++g) AA[crow(g, hh) * 64 + nn] = sigmoidf_(a0 + acc[g]); }
            else {
#pragma unroll
                for (int g = 0; g < 16; ++g) GG[crow(g, hh) * 64 + nn] = acc[g]; }
        }
        LBAR();
        {
            const int tt = tidv >> 4, j0 = (tidv & 15) * 4;
            const f32x4 xk = *(LAS f32x4*)(XK + tt * 64 + j0), av = *(LAS f32x4*)(AA + tt * 64 + j0);
            const f32x4 kkw = *(LAS f32x4*)(HC + 128 + j0), kaw = *(LAS f32x4*)(HC + 192 + j0);
            f32x4 kr = xk * kkw;
            float ss = (kr.x * kr.x + kr.y * kr.y) + (kr.z * kr.z + kr.w * kr.w);
            ss = red16(ss);
            const float inv = frsq(fmaxf(ss, 1e-24f));
            const f32x4 kkv = kr * inv, bb = kkv * av, km = xk * (1.0f + (av - 1.0f) * kaw);
            *(LAS f32x4*)(XK + tt * 64 + j0) = km;
            const f32x4 cum = *(LAS f32x4*)(LD + tt * 64 + j0);
            f32x4 cx = (f32x4){0.f, 0.f, 0.f, 0.f}; if (tt > 0) cx = *(LAS f32x4*)(LD + (tt - 1) * 64 + j0);
            const f32x4 rr = *(LAS f32x4*)(XR + tt * 64 + j0), vv = *(LAS f32x4*)(XV + tt * 64 + j0);
            float ep[4], en[4], ex[4];
#pragma unroll
            for (int e = 0; e < 4; ++e) { ep[e] = __expf(cum[e]); en[e] = __expf(-cum[e]); ex[e] = __expf(cx[e]); }
            unsigned short a_[4], b_[4], k_[4], r_[4], v_[4];
#pragma unroll
            for (int e = 0; e < 4; ++e) { a_[e] = (unsigned short)f2bf(-kkv[e] * ex[e]); b_[e] = (unsigned short)f2bf(bb[e] * en[e]); k_[e] = (unsigned short)f2bf(km[e] * en[e]); r_[e] = (unsigned short)f2bf(rr[e] * ep[e]); v_[e] = (unsigned short)f2bf(vv[e]); }
            *(LAS u32x2*)(At + tt * 72 + j0) = (u32x2){(unsigned)a_[0] | ((unsigned)a_[1] << 16), (unsigned)a_[2] | ((unsigned)a_[3] << 16)};
            *(LAS u32x2*)(Bt + tt * 72 + j0) = (u32x2){(unsigned)b_[0] | ((unsigned)b_[1] << 16), (unsigned)b_[2] | ((unsigned)b_[3] << 16)};
            *(LAS u32x2*)(Kt + tt * 72 + j0) = (u32x2){(unsigned)k_[0] | ((unsigned)k_[1] << 16), (unsigned)k_[2] | ((unsigned)k_[3] << 16)};
            *(LAS u32x2*)(Rt + tt * 72 + j0) = (u32x2){(unsigned)r_[0] | ((unsigned)r_[1] << 16), (unsigned)r_[2] | ((unsigned)r_[3] << 16)};
#pragma unroll
            for (int e = 0; e < 4; ++e) { BTt[(j0 + e) * 40 + tt] = b_[e]; KTt[(j0 + e) * 40 + tt] = k_[e]; VT[(j0 + e) * 40 + tt] = v_[e]; }
            if (tt == RC - 1) *(LAS f32x4*)(GAM + j0) = (f32x4){ep[0], ep[1], ep[2], ep[3]};
            const f32x4 gg = *(LAS f32x4*)(GG + tt * 64 + j0);
            const f32x4 rk = *(LAS f32x4*)(HC + 256 + j0), gw = *(LAS f32x4*)(HC + 320 + j0), gb = *(LAS f32x4*)(HC + 384 + j0);
            const f32x4 t3 = rr * km * rk;
            const float bonus = red16((t3.x + t3.y) + (t3.z + t3.w));
            {
                unsigned char* blob = blob0 + (size_t)c * 16384;
                const f32x4 g1 = gw * gg, e1 = (gb + vv * bonus) * gg;
                *(GAS u32x2*)(blob + 8192 + (tt * 64 + j0) * 2) = (u32x2){pk2(g1.x, g1.y), pk2(g1.z, g1.w)};
                *(GAS u32x2*)(blob + 12288 + (tt * 64 + j0) * 2) = (u32x2){pk2(e1.x, e1.y), pk2(e1.z, e1.w)};
            }
        }
        LBAR();
        if (wave < 4) {
            const int r = lanev & 31, hh = lanev >> 5;
            const LAS bf16* Aimg = (wave == 0 || wave == 2) ? Kt : Bt;
            const LAS bf16* Bimg = (wave == 0 || wave == 3) ? At : Rt;
            LAS bf16* Oimg = wave == 0 ? LAK : (wave == 1 ? MRB : (wave == 2 ? MRK : LAB));
            const bool incl = (wave == 1 || wave == 2);
            f32x16 acc;
#pragma unroll
            for (int g = 0; g < 16; ++g) acc[g] = 0.f;
#pragma unroll
            for (int s = 0; s < 4; ++s) {
                const bf16x8 a = *(const LAS bf16x8*)(Aimg + r * 72 + 16 * s + 8 * hh);
                const bf16x8 bq = *(const LAS bf16x8*)(Bimg + r * 72 + 16 * s + 8 * hh);
                acc = MFMA32(a, bq, acc);
            }
            const int t = r;
#pragma unroll
            for (int gg = 0; gg < 4; ++gg) {
                float x[4];
#pragma unroll
                for (int e = 0; e < 4; ++e) { const int tau = 8 * gg + 4 * hh + e; const bool keep = incl ? (tau <= t) : (tau < t); x[e] = keep ? acc[4 * gg + e] : 0.f; }
                *(LAS u32x2*)(Oimg + t * 40 + 8 * gg + 4 * hh) = (u32x2){pk2(x[0], x[1]), pk2(x[2], x[3])};
                if (wave == 3) *(LAS f32x4*)(LAB32 + t * 36 + 8 * gg + 4 * hh) = (f32x4){x[0], x[1], x[2], x[3]};
            }
        }
        LBAR();
        f32x4 accN[2], accY[2];
        if (wave == 4) {
            const int blk = (lanev >> 4) & 1, cc = lanev & 15;
            const LAS float* Lb = LAB32 + (16 * blk) * 36 + 16 * blk;
            float Tc[16];
            f32x4 ln[4];
#pragma unroll
            for (int q = 0; q < 4; ++q) ln[q] = *(const LAS f32x4*)(Lb + 1 * 36 + 4 * q);
            Tc[0] = (cc == 0) ? 1.f : 0.f;
#pragma unroll
            for (int t = 1; t < 16; ++t) {
                f32x4 lc[4];
#pragma unroll
                for (int q = 0; q < 4; ++q) lc[q] = ln[q];
                if (t + 1 < 16) {
#pragma unroll
                    for (int q = 0; q < 4; ++q) if (4 * q < t + 1) ln[q] = *(const LAS f32x4*)(Lb + (t + 1) * 36 + 4 * q);
                }
                float s0 = (t == cc) ? 1.f : 0.f, s1 = 0.f, s2 = 0.f, s3 = 0.f;
#pragma unroll
                for (int tau = 0; tau < t; ++tau) { const float pr_ = lc[tau >> 2][tau & 3] * Tc[tau]; if ((tau & 3) == 0) s0 += pr_; else if ((tau & 3) == 1) s1 += pr_; else if ((tau & 3) == 2) s2 += pr_; else s3 += pr_; }
                Tc[t] = (s0 + s1) + (s2 + s3);
            }
            if (lanev < 32) {
#pragma unroll
                for (int t = 0; t < 16; ++t) TJ[blk * 640 + t * 40 + cc] = (unsigned short)f2bf(Tc[t]);
            }
        }
        const bf16x8 bzero = (bf16x8){0, 0, 0, 0, 0, 0, 0, 0};
        {
#pragma unroll
            for (int m = 0; m < 2; ++m) {
                f32x4 an = (f32x4){0.f, 0.f, 0.f, 0.f}, ay = (f32x4){0.f, 0.f, 0.f, 0.f};
#pragma unroll
                for (int ks = 0; ks < 2; ++ks) {
                    const bf16x8 sb_ = *(const LAS bf16x8*)(Sw + r16 * 72 + 32 * ks + 8 * kq);
                    an = MFMA16(*(const LAS bf16x8*)(At + (16 * m + r16) * 72 + 32 * ks + 8 * kq), sb_, an);
                    ay = MFMA16(*(const LAS bf16x8*)(Rt + (16 * m + r16) * 72 + 32 * ks + 8 * kq), sb_, ay);
                }
                const bf16x8 vb = idw ? bzero : *(const LAS bf16x8*)(VT + (16 * cw + r16) * 40 + 8 * kq);
                an = MFMA16(*(const LAS bf16x8*)(LAK + (16 * m + r16) * 40 + 8 * kq), vb, an);
                ay = MFMA16(*(const LAS bf16x8*)(MRK + (16 * m + r16) * 40 + 8 * kq), vb, ay);
                accN[m] = an; accY[m] = ay;
            }
        }
        LBAR();
        {
            const f32x4 z4 = (f32x4){0.f, 0.f, 0.f, 0.f};
            *(LAS u32x2*)(USC + r16 * 40 + 16 + 4 * kq) = (u32x2){0u, 0u};
            *(LAS u32x2*)(USC + r16 * 40 + 4 * kq) = (u32x2){pk2(accN[0][0], accN[0][1]), pk2(accN[0][2], accN[0][3])};
            LDS_WAIT();
            f32x4 u0 = MFMA16(*(const LAS bf16x8*)(TJ + r16 * 40 + 8 * kq), *(const LAS bf16x8*)(USC + r16 * 40 + 8 * kq), z4);
            {
                const u32x2 uw = (u32x2){pk2(u0[0], u0[1]), pk2(u0[2], u0[3])};
                LDS_WAIT();
                *(LAS u32x2*)(USC + r16 * 40 + 4 * kq) = uw; *(LAS u32x2*)(UT + r16 * 40 + 4 * kq) = uw;
            }
            LDS_WAIT();
            f32x4 n1 = MFMA16(*(const LAS bf16x8*)(LAB + (16 + r16) * 40 + 8 * kq), *(const LAS bf16x8*)(USC + r16 * 40 + 8 * kq), accN[1]);
            LDS_WAIT();
            *(LAS u32x2*)(USC + r16 * 40 + 4 * kq) = (u32x2){pk2(n1[0], n1[1]), pk2(n1[2], n1[3])};
            LDS_WAIT();
            f32x4 u1 = MFMA16(*(const LAS bf16x8*)(TJ + 640 + r16 * 40 + 8 * kq), *(const LAS bf16x8*)(USC + r16 * 40 + 8 * kq), z4);
            *(LAS u32x2*)(UT + r16 * 40 + 16 + 4 * kq) = (u32x2){pk2(u1[0], u1[1]), pk2(u1[2], u1[3])};
            LDS_WAIT();
            const bf16x8 ub = *(const LAS bf16x8*)(UT + r16 * 40 + 8 * kq);
            const bf16x8 vb = idw ? bzero : *(const LAS bf16x8*)(VT + (16 * cw + r16) * 40 + 8 * kq);
            unsigned char* blob = blob0 + (size_t)c * 16384;
#pragma unroll
            for (int m = 0; m < 2; ++m) {
                const f32x4 yv = MFMA16(*(const LAS bf16x8*)(MRB + (16 * m + r16) * 40 + 8 * kq), ub, accY[m]);
                if (!idw) *(GAS u32x2*)(blob + ((cw * 2 + m) * 64 + lanev) * 8) = (u32x2){pk2(yv[0], yv[1]), pk2(yv[2], yv[3])};
                else {
#pragma unroll
                    for (int e = 0; e < 4; ++e) *(GAS unsigned short*)(blob + 4096 + ((16 * m + 4 * kq + e) * 64 + 16 * cw + r16) * 2) = (unsigned short)f2bf(yv[e]);
                }
            }
#pragma unroll
            for (int jt = 0; jt < 4; ++jt) {
                f32x4 zz = MFMA16(*(const LAS bf16x8*)(BTt + (16 * jt + r16) * 40 + 8 * kq), ub, accZ[jt]);
                zz = MFMA16(*(const LAS bf16x8*)(KTt + (16 * jt + r16) * 40 + 8 * kq), vb, zz);
                const f32x4 gm = *(const LAS f32x4*)(GAM + 16 * jt + 4 * kq);
                zz = zz * gm; accZ[jt] = zz;
                *(LAS u32x2*)(Sw + r16 * 72 + 16 * jt + 4 * kq) = (u32x2){pk2(zz[0], zz[1]), pk2(zz[2], zz[3])};
            }
        }
        LBAR();
    }
    {
        const int r16 = lane & 15, kq = lane >> 4;
#pragma unroll
        for (int jt = 0; jt < 4; ++jt) {
            if (!idw) *(GAS f32x4*)(HS + (16 * cw + r16) * 64 + 16 * jt + 4 * kq) = accZ[jt];
            else {
#pragma unroll
                for (int e = 0; e < 4; ++e) HS[4096 + (16 * jt + 4 * kq + e) * 64 + 16 * cw + r16] = accZ[jt][e];
            }
        }
    }
    __syncthreads();
}


DI void rwkv_pass2(Frame& F, int unit) {
    const int tid = F.tid, lane = F.lane, wave = F.wave;
    const int bh = unit & 63, seg = unit >> 6;
    const int b = bh >> 4, h = bh & 15;
    const int c_lo = seg == 0 ? 0 : RW_SEG0 + RW_SEGN * (seg - 1), c_hi = RW_SEG0 + RW_SEGN * seg;
    const unsigned char* const blob0 = F.ws + WS_RW + (size_t)bh * RW_NCH * 16384;
    const float* const HS0 = (const float*)(F.ws + WS_RWS) + (size_t)(bh * 4) * 8192;
    bf16* Y = (bf16*)(F.ws + WS_U);
    LAS float* ZA = (LAS float*)(F.lds + 0);
    LAS float* ZB = (LAS float*)(F.lds + 17408);
    LAS float* GL = (LAS float*)(F.lds + 34816);
    LAS bf16* SIN = (LAS bf16*)(F.lds + 52224);
    LAS float* YY = (LAS float*)(F.lds + 61440);
    __syncthreads();
    if (seg > 0) {
        for (int i = tid; i < 64 * 16; i += NTHR) { const int r = i >> 4, c4 = (i & 15) * 4; *(LAS f32x4*)(ZA + r * 68 + c4) = *(const GAS f32x4*)(HS0 + r * 64 + c4); }
        LAS float* zc = ZA; LAS float* zn = ZB;
        for (int sx = 1; sx < seg; ++sx) {
            for (int i = tid; i < 64 * 16; i += NTHR) { const int r = i >> 4, c4 = (i & 15) * 4; *(LAS f32x4*)(GL + r * 68 + c4) = *(const GAS f32x4*)(HS0 + (size_t)sx * 8192 + 4096 + r * 64 + c4); }
            __syncthreads();
            const int i = tid >> 3, j0 = (tid & 7) * 8;
            float acc[8];
#pragma unroll
            for (int e = 0; e < 8; ++e) acc[e] = HS0[(size_t)sx * 8192 + i * 64 + j0 + e];
            for (int m = 0; m < 64; m += 4) {
                const f32x4 z = *(LAS f32x4*)(zc + i * 68 + m);
#pragma unroll
                for (int e = 0; e < 8; ++e) { const f32x4 gv = *(LAS f32x4*)(GL + (j0 + e) * 68 + m); acc[e] += (z.x * gv.x + z.y * gv.y) + (z.z * gv.z + z.w * gv.w); }
            }
#pragma unroll
            for (int e = 0; e < 8; ++e) zn[i * 68 + j0 + e] = acc[e];
            __syncthreads();
            LAS float* t_ = zc; zc = zn; zn = t_;
        }
        __syncthreads();
        for (int i = tid; i < 64 * 16; i += NTHR) { const int r = i >> 4, c4 = (i & 15) * 4; const f32x4 z = *(LAS f32x4*)(zc + r * 68 + c4); *(LAS u32x2*)(SIN + r * 72 + c4) = (u32x2){pk2(z.x, z.y), pk2(z.z, z.w)}; }
        __syncthreads();
    }
    const int r16 = lane & 15, kq = lane >> 4, ct = wave & 3, m2 = wave >> 2;
    const int tt = tid >> 4, i0 = (tid & 15) * 4;
    u32x2 pyl, pg1, pe1; v4u pyh[2];
#define RW2_LOAD(cc) do { const unsigned char* bl_ = blob0 + (size_t)(cc) * 16384; pyl = *(const GAS u32x2*)(bl_ + ((ct * 2 + m2) * 64 + lane) * 8); \
        pyh[0] = *(const GAS v4u*)(bl_ + 4096 + ((16 * m2 + r16) * 64 + 8 * kq) * 2); pyh[1] = *(const GAS v4u*)(bl_ + 4096 + ((16 * m2 + r16) * 64 + 32 + 8 * kq) * 2); \
        pg1 = *(const GAS u32x2*)(bl_ + 8192 + (tt * 64 + i0) * 2); pe1 = *(const GAS u32x2*)(bl_ + 12288 + (tt * 64 + i0) * 2); } while (0)
    RW2_LOAD(c_lo);
    for (int c = c_lo; c < c_hi; ++c) {
        f32x4 acc = (f32x4){bflo(pyl.x), bfhi(pyl.x), bflo(pyl.y), bfhi(pyl.y)};
        const v4u yh0 = pyh[0], yh1 = pyh[1]; const u32x2 g1w = pg1, e1w = pe1;
        if (c + 1 < c_hi) RW2_LOAD(c + 1);
        if (seg > 0) {
            acc = MFMA16(__builtin_bit_cast(bf16x8, yh0), *(const LAS bf16x8*)(SIN + (16 * ct + r16) * 72 + 8 * kq), acc);
            acc = MFMA16(__builtin_bit_cast(bf16x8, yh1), *(const LAS bf16x8*)(SIN + (16 * ct + r16) * 72 + 32 + 8 * kq), acc);
        }
        LAS float* yb = YY + (c & 1) * 2048;
#pragma unroll
        for (int e = 0; e < 4; ++e) yb[(16 * m2 + 4 * kq + e) * 64 + 16 * ct + r16] = acc[e];
        LBAR();
        {
            const f32x4 y4 = *(LAS f32x4*)(yb + tt * 64 + i0);
            const float mean = red16((y4.x + y4.y) + (y4.z + y4.w)) * (1.0f / 64.0f);
            const f32x4 d = y4 - mean;
            const float var = red16((d.x * d.x + d.y * d.y) + (d.z * d.z + d.w * d.w)) * (1.0f / 64.0f);
            const float rstd = frsq(var + GN_EPS);
            const f32x4 g1 = (f32x4){bflo(g1w.x), bfhi(g1w.x), bflo(g1w.y), bfhi(g1w.y)}, e1 = (f32x4){bflo(e1w.x), bfhi(e1w.x), bflo(e1w.y), bfhi(e1w.y)};
            const f32x4 ov = (d * rstd) * g1 + e1;
            const int sg = RC * c + tt;
            if (sg >= 32) { u32x2 w; w.x = pk2(ov.x, ov.y); w.y = pk2(ov.z, ov.w); *(GAS u32x2*)(Y + (size_t)(b * SEQ + sg - 32) * DM + h * 64 + i0) = w; }
        }
    }
    __syncthreads();
}

DI int f2key(float f) { const int b = __float_as_int(f); return b ^ ((b >> 31) & 0x7fffffff); }
DI float key2f(int k) { return __int_as_float(k ^ ((k >> 31) & 0x7fffffff)); }
template <int CTRL> DI int dppi(int v) { return __builtin_amdgcn_update_dpp(0, v, CTRL, 0xf, 0xf, true); }
DI int imax2(int a, int b) { return a > b ? a : b; }
DI int imin2(int a, int b) { return a < b ? a : b; }
DI int imax16(int v) { v = imax2(v, dppi<0xB1>(v)); v = imax2(v, dppi<0x4E>(v)); v = imax2(v, dppi<0x141>(v)); v = imax2(v, dppi<0x140>(v)); return v; }
constexpr int KMIN = -2147483647 - 1;
#define CEX(a, b) do { const int lo_ = imin2(a, b), hi_ = imax2(a, b); a = hi_; b = lo_; } while (0)
DI int top16_of8(int (&x)[8], int l16) {
    CEX(x[0], x[1]); CEX(x[2], x[3]); CEX(x[4], x[5]); CEX(x[6], x[7]);
    CEX(x[0], x[2]); CEX(x[1], x[3]); CEX(x[4], x[6]); CEX(x[5], x[7]);
    CEX(x[1], x[2]); CEX(x[5], x[6]); CEX(x[0], x[4]); CEX(x[3], x[7]);
    CEX(x[1], x[5]); CEX(x[2], x[6]);
    CEX(x[1], x[4]); CEX(x[3], x[6]);
    CEX(x[2], x[4]); CEX(x[3], x[5]);
    CEX(x[3], x[4]);
    int res = KMIN;
#pragma unroll
    for (int k = 0; k < 16; ++k) {
        const int m = imax16(x[0]);
        const bool hit = x[0] == m;
#pragma unroll
        for (int q = 0; q < 7; ++q) x[q] = hit ? x[q + 1] : x[q];
        x[7] = hit ? KMIN : x[7];
        res = (l16 == k) ? m : res;
    }
    return res;
}
DI int top16_of4(int (&x)[4], int l16) {
    CEX(x[0], x[1]); CEX(x[2], x[3]); CEX(x[0], x[2]); CEX(x[1], x[3]); CEX(x[1], x[2]);
    int res = KMIN;
#pragma unroll
    for (int k = 0; k < 16; ++k) {
        const int m = imax16(x[0]);
        const bool hit = x[0] == m;
        x[0] = hit ? x[1] : x[0]; x[1] = hit ? x[2] : x[1]; x[2] = hit ? x[3] : x[2]; x[3] = hit ? KMIN : x[3];
        res = (l16 == k) ? m : res;
    }
    return res;
}
DI void topk_setup(LAS unsigned char* TAB, int lane) {
    {
        unsigned char v = 0xFF; int q = lane, i = 0;
#pragma unroll
        for (int ii = 0; ii < 16; ++ii) { const int cnt = 16 / (ii + 1); if (i == ii) { if (q < cnt) { v = (unsigned char)((ii << 4) | q); i = 99; } else { q -= cnt; i = ii + 1; } } }
        TAB[lane] = v;
    }
    asm volatile("s_waitcnt lgkmcnt(0)" ::: "memory");
}
DI void topk_pass(const float* SC, int t, int pass, int lane, LAS int* KA, LAS int* KB, int& eidx, float& gate) {
    const int g = lane >> 4, l16 = lane & 15;
    const LAS unsigned char* TAB = (const LAS unsigned char*)(KA + 128);
    const int hd = 4 * pass + g;
    const float* srow = SC + (size_t)t * DM + hd * 256 + 8 * l16;
    const f32x4 a0 = *(const GAS f32x4*)(srow), a1 = *(const GAS f32x4*)(srow + 4), b0 = *(const GAS f32x4*)(srow + 128), b1 = *(const GAS f32x4*)(srow + 132);
    int xa[8], xb[8];
#pragma unroll
    for (int q = 0; q < 4; ++q) { xa[q] = (f2key(a0[q]) & ~0x7F) | (8 * l16 + q); xa[4 + q] = (f2key(a1[q]) & ~0x7F) | (8 * l16 + 4 + q);
                                  xb[q] = (f2key(b0[q]) & ~0x7F) | (8 * l16 + q); xb[4 + q] = (f2key(b1[q]) & ~0x7F) | (8 * l16 + 4 + q); }
    const int ra = top16_of8(xa, l16), rb = top16_of8(xb, l16);
    KA[g * 16 + l16] = ra; KB[g * 16 + l16] = rb;
    asm volatile("s_waitcnt lgkmcnt(0)" ::: "memory");
    int cs[4];
#pragma unroll
    for (int e = 0; e < 4; ++e) {
        const int ij = TAB[4 * l16 + e]; const int ka = KA[g * 16 + ((ij >> 4) & 15)], kb = KB[g * 16 + (ij & 15)];
        const float sv = key2f(ka & ~0x7F) + key2f(kb & ~0x7F);
        cs[e] = (ij == 0xFF) ? KMIN : ((f2key(sv) & ~0xFF) | ij);
    }
    const int rc = top16_of4(cs, l16);
    const int ij = rc & 0xFF;
    const int ia = KA[g * 16 + (ij >> 4)] & 0x7F, ib = KB[g * 16 + (ij & 15)] & 0x7F;
    const float sv = key2f(rc & ~0xFF);
    const float smax = key2f(imax16(rc) & ~0xFF);
    const float ex = __expf(sv - smax);
    const float sum = red16(ex);
    eidx = ia * 128 + ib; gate = ex * frcp(sum);
    asm volatile("s_waitcnt lgkmcnt(0)" ::: "memory");
}
#ifndef FUSE_TOPK
#define FUSE_TOPK 1
#endif
DI void topk_phase(Frame& F) {
    const int lane = F.lane, wave = F.wave;
    const int gw = F.vcu * NWAVES + wave, NGW = F.G * NWAVES;
    const float* SC = (const float*)(F.ws + WS_SC); int* IDX = (int*)(F.ws + WS_IDX); float* GATE = (float*)(F.ws + WS_GATE);
    LAS int* KA = (LAS int*)(F.lds + wave * 1024); LAS int* KB = KA + 64;
    topk_setup((LAS unsigned char*)(F.lds + wave * 1024 + 512), lane);
    for (int t = gw; t < TR; t += NGW) {
#pragma unroll 1
        for (int pass = 0; pass < 2; ++pass) {
            int e; float gt; topk_pass(SC, t, pass, lane, KA, KB, e, gt);
            IDX[(size_t)t * NSEL + 64 * pass + lane] = e; GATE[(size_t)t * NSEL + 64 * pass + lane] = gt;
        }
    }
}

typedef float f32x2v __attribute__((ext_vector_type(2)));
#ifndef GATHER_NT
#define GATHER_NT 0
#endif
#if GATHER_NT
#define G_LD(p) __builtin_nontemporal_load(p)
#else
#define G_LD(p) (*(p))
#endif
#if TBL_FP4
typedef unsigned v4u8 __attribute__((ext_vector_type(4), aligned(8)));
typedef unsigned u32x6v __attribute__((ext_vector_type(6)));
struct Row6 { v4u a; unsigned s; };
#define G_ISSUE(buf, gb) do { const int tb_ = (gb) < 32 ? 0 : (int)(WS_TU - WS_TD); const int kb_ = ((gb) & 31) * 4; \
    _Pragma("unroll") for (int q = 0; q < 4; ++q) { const int k_ = kb_ + q; const int e_ = __builtin_amdgcn_readlane(k_ < 64 ? id0 : id1, k_ & 63); \
        const int so_ = tb_ + e_ * ROWB; buf[q].a = __builtin_amdgcn_raw_buffer_load_b128(trs, (int)lo16, so_, 0); buf[q].s = __builtin_amdgcn_raw_buffer_load_b16(trs, (int)lo2, so_, 0); } } while (0)
#define G_DEC4(r, y_) do { _Pragma("unroll") for (int w_ = 0; w_ < 4; ++w_) { \
    { const auto f_ = __builtin_amdgcn_cvt_scalef32_pk_f32_fp4((r).a[w_], 1.0f, 0); y_[8 * w_ + 0] = f_[0]; y_[8 * w_ + 1] = f_[1]; } \
    { const auto f_ = __builtin_amdgcn_cvt_scalef32_pk_f32_fp4((r).a[w_], 1.0f, 1); y_[8 * w_ + 2] = f_[0]; y_[8 * w_ + 3] = f_[1]; } \
    { const auto f_ = __builtin_amdgcn_cvt_scalef32_pk_f32_fp4((r).a[w_], 1.0f, 2); y_[8 * w_ + 4] = f_[0]; y_[8 * w_ + 5] = f_[1]; } \
    { const auto f_ = __builtin_amdgcn_cvt_scalef32_pk_f32_fp4((r).a[w_], 1.0f, 3); y_[8 * w_ + 6] = f_[0]; y_[8 * w_ + 7] = f_[1]; } } } while (0)
typedef __bf16 bf16x2p __attribute__((ext_vector_type(2)));
#define G_D2(w_, bs_, acc_) acc_ = __builtin_amdgcn_fdot2_f32_bf16(__builtin_amdgcn_cvt_scalef32_pk_bf16_fp4(rr_.a[w_], 1.0f, bs_), __builtin_bit_cast(bf16x2p, xr[4 * (w_) + (bs_)]), acc_, false)
#define G_PART(buf, j0) do { _Pragma("unroll") for (int q = 0; q < 4; ++q) { const Row6 rr_ = buf[q]; float s_ = 0.f; \
        _Pragma("unroll") for (int w = 0; w < 4; ++w) { G_D2(w, 0, s_); G_D2(w, 1, s_); G_D2(w, 2, s_); G_D2(w, 3, s_); } \
        pp[(j0) + q] = s_ * __uint_as_float(rr_.s << 16); } } while (0)
#define G_RED16(G) do { \
    _Pragma("unroll") for (int i = 0; i < 8; ++i) { const auto r_ = __builtin_amdgcn_permlane32_swap(__float_as_uint(pp[i]), __float_as_uint(pp[i + 8]), false, false); pp[i] = __uint_as_float(r_[0]) + __uint_as_float(r_[1]); } \
    _Pragma("unroll") for (int i = 0; i < 4; ++i) { const auto r_ = __builtin_amdgcn_permlane16_swap(__float_as_uint(pp[i]), __float_as_uint(pp[i + 4]), false, false); pp[i] = __uint_as_float(r_[0]) + __uint_as_float(r_[1]); } \
    { const bool b3_ = (lane & 8) != 0; _Pragma("unroll") for (int i = 0; i < 2; ++i) { const float keep_ = b3_ ? pp[i + 2] : pp[i], send_ = b3_ ? pp[i] : pp[i + 2]; pp[i] = keep_ + dppf<0x128>(send_); } } \
    { const bool b2_ = (lane & 4) != 0; const float keep_ = b2_ ? pp[1] : pp[0], send_ = b2_ ? pp[0] : pp[1]; pp[0] = keep_ + dppf<0x141>(send_); } \
    float tot_ = pp[0]; tot_ += dppf<0xB1>(tot_); tot_ += dppf<0x4E>(tot_); \
    if ((lane & 3) == ((G) & 3)) { if ((G) < 4) hv0 = tot_; else hv1 = tot_; } } while (0)
#define G_DOWN(buf, b) do { float p_[4]; \
    _Pragma("unroll") for (int q = 0; q < 4; ++q) { const Row6 rr_ = buf[q]; float s0_ = 0.f, s1_ = 0.f, s2_ = 0.f, s3_ = 0.f; \
        _Pragma("unroll") for (int w = 0; w < 4; ++w) { G_D2(w, 0, s0_); G_D2(w, 1, s1_); G_D2(w, 2, s2_); G_D2(w, 3, s3_); } \
        p_[q] = ((s0_ + s1_) + (s2_ + s3_)) * __uint_as_float(rr_.s << 16); } \
    { const bool h5_ = (lane & 32) != 0; _Pragma("unroll") for (int i = 0; i < 2; ++i) { const float keep_ = h5_ ? p_[i + 2] : p_[i], send_ = h5_ ? p_[i] : p_[i + 2]; p_[i] = keep_ + __shfl_xor(send_, 32); } } \
    { const bool h4_ = (lane & 16) != 0; const float keep_ = h4_ ? p_[1] : p_[0], send_ = h4_ ? p_[0] : p_[1]; p_[0] = keep_ + __shfl_xor(send_, 16); } \
    const float tot_ = red16(p_[0]); \
    if ((lane & 15) == ((b) & 15)) { if ((b) < 16) hv0 = tot_; else hv1 = tot_; } } while (0)
#define G_UP(buf, b) do { _Pragma("unroll") for (int q = 0; q < 4; ++q) { Row6 rr_ = buf[q]; asm volatile("" : "+v"(rr_.a) : "v"(acc[0]), "v"(acc[31]));        \
        const float ck_ = rdlane((b) < 16 ? c0 : c1, 16 * ((b) & 3) + 4 * q + (((b) >> 2) & 3)) * __uint_as_float(rr_.s << 16); float y_[32]; G_DEC4(rr_, y_); \
        _Pragma("unroll") for (int i = 0; i < 32; ++i) acc[i] += ck_ * y_[i]; } } while (0)
DI void fp8x4_f32(unsigned w, float& a, float& b, float& c, float& d) { const auto lo = __builtin_amdgcn_cvt_pk_f32_fp8((int)w, false); const auto hi = __builtin_amdgcn_cvt_pk_f32_fp8((int)w, true); a = lo[0]; b = lo[1]; c = hi[0]; d = hi[1]; }
#elif TBL_FP6
typedef unsigned v4u8 __attribute__((ext_vector_type(4), aligned(8)));
typedef unsigned u32x6v __attribute__((ext_vector_type(6)));
struct Row6 { v4u a; u32x2 b; };
#define G_ISSUE(buf, gb) do { const unsigned char* tb_ = (gb) < 32 ? T8D : T8U; const int kb_ = ((gb) & 31) * 4; \
    _Pragma("unroll") for (int q = 0; q < 4; ++q) { const int k_ = kb_ + q; const int e_ = __builtin_amdgcn_readlane(k_ < 64 ? id0 : id1, k_ & 63); \
        const unsigned char* p_ = tb_ + (size_t)e_ * 1536 + lane * 24; buf[q].a = *(const GAS v4u8*)p_; buf[q].b = *(const GAS u32x2*)(p_ + 16); } } while (0)
#define G_DEC(r) __builtin_amdgcn_cvt_scalef32_pk32_f32_fp6((u32x6v){(r).a.x, (r).a.y, (r).a.z, (r).a.w, (r).b.x, (r).b.y}, 1.0f)
#define G_DOWN(buf, b) do { float p_[4]; \
    _Pragma("unroll") for (int q = 0; q < 4; ++q) { const auto y_ = G_DEC(buf[q]); float s0_ = 0.f, s1_ = 0.f, s2_ = 0.f, s3_ = 0.f; \
        _Pragma("unroll") for (int i = 0; i < 32; i += 4) { s0_ += y_[i] * xv[i]; s1_ += y_[i + 1] * xv[i + 1]; s2_ += y_[i + 2] * xv[i + 2]; s3_ += y_[i + 3] * xv[i + 3]; } p_[q] = (s0_ + s1_) + (s2_ + s3_); } \
    { const bool h5_ = (lane & 32) != 0; _Pragma("unroll") for (int i = 0; i < 2; ++i) { const float keep_ = h5_ ? p_[i + 2] : p_[i], send_ = h5_ ? p_[i] : p_[i + 2]; p_[i] = keep_ + __shfl_xor(send_, 32); } } \
    { const bool h4_ = (lane & 16) != 0; const float keep_ = h4_ ? p_[1] : p_[0], send_ = h4_ ? p_[0] : p_[1]; p_[0] = keep_ + __shfl_xor(send_, 16); } \
    const float tot_ = red16(p_[0]); \
    if ((lane & 15) == ((b) & 15)) { if ((b) < 16) hv0 = tot_; else hv1 = tot_; } } while (0)
#define G_UP(buf, b) do { _Pragma("unroll") for (int q = 0; q < 4; ++q) { const float ck_ = rdlane((b) < 16 ? c0 : c1, 16 * q + ((b) & 15)); const auto y_ = G_DEC(buf[q]); \
        _Pragma("unroll") for (int i = 0; i < 32; ++i) acc[i] += ck_ * y_[i]; } } while (0)
DI void fp8x4_f32(unsigned w, float& a, float& b, float& c, float& d) { const auto lo = __builtin_amdgcn_cvt_pk_f32_fp8((int)w, false); const auto hi = __builtin_amdgcn_cvt_pk_f32_fp8((int)w, true); a = lo[0]; b = lo[1]; c = hi[0]; d = hi[1]; }
#else
#define G_ISSUE(buf, gb) do { const unsigned char* tb_ = (gb) < 32 ? T8D : T8U; const int kb_ = ((gb) & 31) * 4; \
    _Pragma("unroll") for (int q = 0; q < 4; ++q) { const int k_ = kb_ + q; const int e_ = __builtin_amdgcn_readlane(k_ < 64 ? id0 : id1, k_ & 63); \
        const unsigned char* p_ = tb_ + (size_t)e_ * DM + lane * 16; buf[q][0] = G_LD((const GAS v4u*)p_); buf[q][1] = G_LD((const GAS v4u*)(p_ + 1024)); } } while (0)
DI void fp8x4_f32(unsigned w, float& a, float& b, float& c, float& d) { const auto lo = __builtin_amdgcn_cvt_pk_f32_fp8((int)w, false); const auto hi = __builtin_amdgcn_cvt_pk_f32_fp8((int)w, true); a = lo[0]; b = lo[1]; c = hi[0]; d = hi[1]; }
DI float fp8_dot4(unsigned w, float x0, float x1, float x2, float x3) { float a, b, c, d; fp8x4_f32(w, a, b, c, d); return (a * x0 + b * x1) + (c * x2 + d * x3); }
#define G_DOT4(w, xo) fp8_dot4((w), xv[(xo) + 0], xv[(xo) + 1], xv[(xo) + 2], xv[(xo) + 3])
#define G_DOWN(buf, b) do { float p_[4]; \
    _Pragma("unroll") for (int q = 0; q < 4; ++q) { float s0_ = 0.f, s1_ = 0.f; \
        s0_ += G_DOT4(buf[q][0].x, 0); s1_ += G_DOT4(buf[q][0].y, 4); s0_ += G_DOT4(buf[q][0].z, 8); s1_ += G_DOT4(buf[q][0].w, 12); \
        s0_ += G_DOT4(buf[q][1].x, 16); s1_ += G_DOT4(buf[q][1].y, 20); s0_ += G_DOT4(buf[q][1].z, 24); s1_ += G_DOT4(buf[q][1].w, 28); p_[q] = s0_ + s1_; } \
    { const bool h5_ = (lane & 32) != 0; _Pragma("unroll") for (int i = 0; i < 2; ++i) { const float keep_ = h5_ ? p_[i + 2] : p_[i], send_ = h5_ ? p_[i] : p_[i + 2]; p_[i] = keep_ + __shfl_xor(send_, 32); } } \
    { const bool h4_ = (lane & 16) != 0; const float keep_ = h4_ ? p_[1] : p_[0], send_ = h4_ ? p_[0] : p_[1]; p_[0] = keep_ + __shfl_xor(send_, 16); } \
    const float tot_ = red16(p_[0]); \
    if ((lane & 15) == ((b) & 15)) { if ((b) < 16) hv0 = tot_; else hv1 = tot_; } } while (0)
#define G_FMA4(w, ao, ck) do { float a_, b_, c_, d_; fp8x4_f32((w), a_, b_, c_, d_); \
    acc[(ao) + 0] += (ck) * a_; acc[(ao) + 1] += (ck) * b_; acc[(ao) + 2] += (ck) * c_; acc[(ao) + 3] += (ck) * d_; } while (0)
#define G_UP(buf, b) do { _Pragma("unroll") for (int q = 0; q < 4; ++q) { const float ck_ = rdlane((b) < 16 ? c0 : c1, 16 * q + ((b) & 15)); \
        G_FMA4(buf[q][0].x, 0, ck_); G_FMA4(buf[q][0].y, 4, ck_); G_FMA4(buf[q][0].z, 8, ck_); G_FMA4(buf[q][0].w, 12, ck_); \
        G_FMA4(buf[q][1].x, 16, ck_); G_FMA4(buf[q][1].y, 20, ck_); G_FMA4(buf[q][1].z, 24, ck_); G_FMA4(buf[q][1].w, 28, ck_); } } while (0)
#endif
DI void bitonic128(int& a, int& b, int lane) {
#pragma unroll
    for (int k = 2; k <= 128; k <<= 1) {
#pragma unroll
        for (int j = k >> 1; j >= 1; j >>= 1) {
            if (j == 64) { const int lo = imin2(a, b), hi = imax2(a, b); a = lo; b = hi; }
            else {
                const int oa = __shfl_xor(a, j), ob = __shfl_xor(b, j);
                const bool lower = (lane & j) == 0;
                const bool up_a = k == 128 ? true : (k == 64 ? true : ((lane & k) == 0));
                const bool up_b = k == 128 ? true : (k == 64 ? false : ((lane & k) == 0));
                a = (lower == up_a) ? imin2(a, oa) : imax2(a, oa);
                b = (lower == up_b) ? imin2(b, ob) : imax2(b, ob);
            }
        }
    }
}
#ifndef GATHER_SORT
#define GATHER_SORT 1
#endif
#ifndef GATHER_TRIPLE
#define GATHER_TRIPLE 0
#endif
#ifndef GATHER_SYNC
#define GATHER_SYNC 0
#endif
DI void gather_phase(Frame& F, const XcdBarrier& bar) {
    const int lane = F.lane, wave = F.wave;
    const int gw = F.vcu * NWAVES + wave, NGW = F.G * NWAVES;
    const int* IDX = (const int*)(F.ws + WS_IDX); const float* GATE = (const float*)(F.ws + WS_GATE);
    const unsigned char* T8D = F.ws + WS_TD; const unsigned char* T8U = F.ws + WS_TU; const float* SCL = (const float*)(F.ws + WS_SCL);
    const bf16* H1B = (const bf16*)(F.ws + WS_H1B);
    const float* sumsq = (const float*)(F.ws + WS_SUMSQ);
#if TBL_FP4
    const __amdgpu_buffer_rsrc_t trs = __builtin_amdgcn_make_buffer_rsrc((void*)T8D, 0, 0x7fffffff, 0x00020000);
#endif
#if FUSE_TOPK
    const float* SC = (const float*)(F.ws + WS_SC);
    LAS int* KA = (LAS int*)(F.lds + wave * 1024); LAS int* KB = KA + 64;
    topk_setup((LAS unsigned char*)(F.lds + wave * 1024 + 512), lane);
#endif
    for (int t = gw; t < TR; t += NGW) {
#if FUSE_TOPK
        int id0, id1; float gr0, gr1;
        topk_pass(SC, t, 0, lane, KA, KB, id0, gr0); topk_pass(SC, t, 1, lane, KA, KB, id1, gr1);
#else
        int id0 = IDX[(size_t)t * NSEL + lane], id1 = IDX[(size_t)t * NSEL + 64 + lane];
#endif
#if TBL_FP4
        const int kA = 16 * (lane & 3) + (lane >> 2);
#else
        const int kA = 4 * (lane & 15) + (lane >> 4);
#endif
#if GATHER_SORT
        int key0 = (id0 << 7) | lane, key1 = (id1 << 7) | (lane + 64);
        bitonic128(key0, key1, lane);
        id0 = key0 >> 7; id1 = key1 >> 7;
        const int keyA = __shfl(key0, kA), keyB = __shfl(key1, kA);
        const int ea = keyA >> 7, eb = keyB >> 7;
#if FUSE_TOPK
        const int oA = keyA & 127, oB = keyB & 127;
        const float gA0 = __shfl(gr0, oA & 63), gA1 = __shfl(gr1, oA & 63), gB0 = __shfl(gr0, oB & 63), gB1 = __shfl(gr1, oB & 63);
        const float g0 = oA < 64 ? gA0 : gA1, g1 = oB < 64 ? gB0 : gB1;
#else
        const float g0 = GATE[(size_t)t * NSEL + (keyA & 127)], g1 = GATE[(size_t)t * NSEL + (keyB & 127)];
#endif
#else
        const int ea = IDX[(size_t)t * NSEL + kA], eb = IDX[(size_t)t * NSEL + 64 + kA];
        const float g0 = GATE[(size_t)t * NSEL + kA], g1 = GATE[(size_t)t * NSEL + 64 + kA];
#endif
        const float sd0 = SCL[ea], sd1 = SCL[eb], su0 = SCL[NEXP + ea], su1 = SCL[NEXP + eb];
        const float rs = 1.0f / sqrtf(sumsq[t] * (1.0f / DM) + RMS_EPS);
#if TBL_FP4
        const unsigned lo16 = (unsigned)lane * 16u, lo2 = 1024u + (unsigned)lane * 2u;
        unsigned xr[16];
#pragma unroll
        for (int j = 0; j < 8; ++j) { const u32x2 raw = *(const GAS u32x2*)(H1B + (size_t)t * DM + 256 * j + lane * 4); xr[2 * j] = raw.x; xr[2 * j + 1] = raw.y; }
        float hv0 = 0.f, hv1 = 0.f;
        Row6 bufA[4], bufB[4];
#elif TBL_FP6
        float xv[32];
#pragma unroll
        for (int j = 0; j < 8; ++j) { const u32x2 raw = *(const GAS u32x2*)(H1B + (size_t)t * DM + 256 * j + lane * 4); const int o = j * 4;
            xv[o + 0] = bflo(raw.x); xv[o + 1] = bfhi(raw.x); xv[o + 2] = bflo(raw.y); xv[o + 3] = bfhi(raw.y); }
        float hv0 = 0.f, hv1 = 0.f;
        Row6 bufA[4], bufB[4];
#else
#pragma unroll
        for (int c = 0; c < 2; ++c)
#pragma unroll
            for (int j = 0; j < 2; ++j) { const v4u raw = *(const GAS v4u*)(H1B + (size_t)t * DM + c * 1024 + lane * 16 + j * 8); const int o = c * 16 + j * 8;
                xv[o + 0] = bflo(raw.x); xv[o + 1] = bfhi(raw.x); xv[o + 2] = bflo(raw.y); xv[o + 3] = bfhi(raw.y); xv[o + 4] = bflo(raw.z); xv[o + 5] = bfhi(raw.z); xv[o + 6] = bflo(raw.w); xv[o + 7] = bfhi(raw.w); }
        float hv0 = 0.f, hv1 = 0.f;
        v4u bufA[4][2], bufB[4][2];
#endif
        if (GATHER_SYNC & 1) xcd_barrier(bar);
#if GATHER_TRIPLE
        Row6 bufC[4];
        G_ISSUE(bufA, 0); G_ISSUE(bufB, 1);
#pragma unroll 1
        for (int b = 0; b < 30; b += 3) { G_ISSUE(bufC, b + 2); G_DOWN(bufA, b); G_ISSUE(bufA, b + 3); G_DOWN(bufB, b + 1); G_ISSUE(bufB, b + 4); G_DOWN(bufC, b + 2); }
        G_ISSUE(bufC, 32); G_DOWN(bufA, 30); G_ISSUE(bufA, 33); G_DOWN(bufB, 31);
#else
        G_ISSUE(bufA, 0);
#if TBL_FP4
#pragma unroll 1
        for (int G = 0; G < 8; ++G) { float pp[16];
            G_ISSUE(bufB, 4 * G + 1); G_PART(bufA, 0); G_ISSUE(bufA, 4 * G + 2); G_PART(bufB, 4); G_ISSUE(bufB, 4 * G + 3); G_PART(bufA, 8); G_ISSUE(bufA, 4 * G + 4); G_PART(bufB, 12);
            G_RED16(G); }
#else
#pragma unroll 1
        for (int b = 0; b < 32; b += 2) { G_ISSUE(bufB, b + 1); G_DOWN(bufA, b); G_ISSUE(bufA, b + 2); G_DOWN(bufB, b + 1); }
#endif
#endif
#if TBL_FP4
        const float z0 = hv0 * rs, z1 = hv1 * rs;
        const float c0 = g0 * 0.5f * z0 * (1.0f + erff(z0 * 0.70710678118654752f)), c1 = g1 * 0.5f * z1 * (1.0f + erff(z1 * 0.70710678118654752f));
#else
        const float z0 = hv0 * rs * sd0, z1 = hv1 * rs * sd1;
        const float c0 = g0 * su0 * 0.5f * z0 * (1.0f + erff(z0 * 0.70710678118654752f)), c1 = g1 * su1 * 0.5f * z1 * (1.0f + erff(z1 * 0.70710678118654752f));
#endif
        float acc[32];
#pragma unroll
        for (int i = 0; i < 32; ++i) acc[i] = 0.f;
        if (GATHER_SYNC & 2) xcd_barrier(bar);
#if GATHER_TRIPLE
        G_ISSUE(bufB, 34); G_UP(bufC, 0);
#pragma unroll 1
        for (int u = 1; u < 31; u += 3) { G_ISSUE(bufC, 32 + u + 2); G_UP(bufA, u); G_ISSUE(bufA, 32 + u + 3); G_UP(bufB, u + 1); G_ISSUE(bufB, (32 + u + 4) & 63); G_UP(bufC, u + 2); }
        G_UP(bufA, 31);
#else
#pragma unroll 1
        for (int b = 0; b < 32; b += 2) { G_ISSUE(bufB, 32 + b + 1); G_UP(bufA, b); if (b + 2 < 32) G_ISSUE(bufA, 32 + b + 2); G_UP(bufB, b + 1); }
#endif
#if TBL_FP6
        {
#pragma unroll
            for (int j = 0; j < 8; ++j) { const u32x2 raw = *(const GAS u32x2*)(H1B + (size_t)t * DM + 256 * j + lane * 4);
                *(GAS f32x4*)(F.out + (size_t)t * DM + 256 * j + lane * 4) = (f32x4){bflo(raw.x) + acc[j * 4 + 0], bfhi(raw.x) + acc[j * 4 + 1], bflo(raw.y) + acc[j * 4 + 2], bfhi(raw.y) + acc[j * 4 + 3]}; }
        }
#else
#pragma unroll
        for (int c = 0; c < 2; ++c) {
            GAS f32x4* op = (GAS f32x4*)(F.out + (size_t)t * DM + c * 1024 + lane * 16);
#pragma unroll
            for (int j = 0; j < 4; ++j) { f32x4 a = op[j]; a.x += acc[c * 16 + j * 4 + 0]; a.y += acc[c * 16 + j * 4 + 1]; a.z += acc[c * 16 + j * 4 + 2]; a.w += acc[c * 16 + j * 4 + 3]; op[j] = a; }
        }
#endif
    }
}

DI float dot4_fp8(unsigned w, const f32x4& x) { float a, b, c, d; fp8x4_f32(w, a, b, c, d); return (a * x.x + b * x.y) + (c * x.z + d * x.w); }
struct SliceMap { int slice, rank, nblk; };
DI SliceMap slice_map(Frame& F, const XcdBarrier& bar) {
    SliceMap m; m.slice = (int)(blockIdx.x & 7); m.rank = (int)(blockIdx.x >> 3); m.nblk = (F.G + 7 - m.slice) / 8;
    if (!MK_SPLIT && (F.G & 7) == 0) {
        bool ok = true;
#pragma unroll
        for (int j = 0; j < 16; ++j) { const unsigned cnt = xb_ld(&bar.bar[XB_XCNT(j)]); ok = ok && (j < 8 ? cnt == (unsigned)(F.G / 8) : cnt == 0u); }
        if (ok) { m.slice = (int)bar.x; m.rank = (int)F.MISC[10]; m.nblk = F.G / 8; }
    }
    return m;
}
#define GS_ISSUE(buf, i0_, i1_, q) do { const int ids_ = ((q) & 2) ? (i1_) : (i0_); const int lb_ = ((q) & 1) * 32; \
    _Pragma("unroll") for (int k = 0; k < 32; ++k) buf[k] = *(const GAS unsigned*)(T8 + (size_t)__builtin_amdgcn_readlane(ids_, lb_ + k) * 256); } while (0)
#define GS_DOWN(buf, q) do { float p[32]; \
    _Pragma("unroll") for (int k = 0; k < 32; ++k) p[k] = dot4_fp8(buf[k], xc); \
    _Pragma("unroll") for (int d = 16; d >= 1; d >>= 1) { const bool hi_ = (lane & d) != 0; \
        _Pragma("unroll") for (int i = 0; i < d; ++i) { const float keep_ = hi_ ? p[i + d] : p[i], send_ = hi_ ? p[i] : p[i + d]; p[i] = keep_ + __shfl_xor(send_, d); } } \
    const float tot_ = p[0] + __shfl_xor(p[0], 32); \
    if (lane < 32 && vc) PART[(size_t)tc * NSEL + 32 * (q) + lane] = tot_; } while (0)
#define GSD_TOK(Ba, Bb, Bc) do { \
    const int in_ = it + 1; const bool vn = in_ < ntok; const int tn = vn ? wv + in_ * NWV : wv; \
    const int n0 = IDX[(size_t)tn * NSEL + lane], n1 = IDX[(size_t)tn * NSEL + 64 + lane]; \
    const u32x2 xr_ = *(const GAS u32x2*)(H1B + (size_t)tn * DM + 256 * sm.slice + 4 * lane); \
    GS_ISSUE(Bc, c0i, c1i, 2); \
    GS_DOWN(Ba, 0); GS_ISSUE(Ba, c0i, c1i, 3); \
    GS_DOWN(Bb, 1); GS_ISSUE(Bb, n0, n1, 0); \
    GS_DOWN(Bc, 2); GS_ISSUE(Bc, n0, n1, 1); \
    GS_DOWN(Ba, 3); \
    c0i = n0; c1i = n1; xc = (f32x4){bflo(xr_.x), bfhi(xr_.x), bflo(xr_.y), bfhi(xr_.y)}; tc = tn; vc = vn; ++it; } while (0)
DI void gather_down_sliced(Frame& F, const XcdBarrier& bar) {
    const int lane = F.lane, wave = F.wave;
    const SliceMap sm = slice_map(F, bar);
    const int* IDX = (const int*)(F.ws + WS_IDX);
    const unsigned char* T8 = F.ws + WS_TD + (size_t)sm.slice * ((size_t)NEXP * 256) + lane * 4;
    const bf16* H1B = (const bf16*)(F.ws + WS_H1B);
    float* PART = (float*)(F.ws + WS_PART) + (size_t)sm.slice * TR * NSEL;
    const int wv = sm.rank * NWAVES + wave, NWV = sm.nblk * NWAVES;
    const int ntok = wv < TR ? (TR - wv + NWV - 1) / NWV : 0;
    int it = 0; int tc = wv < TR ? wv : 0; bool vc = ntok > 0;
    int c0i = IDX[(size_t)tc * NSEL + lane], c1i = IDX[(size_t)tc * NSEL + 64 + lane];
    f32x4 xc; { const u32x2 xr = *(const GAS u32x2*)(H1B + (size_t)tc * DM + 256 * sm.slice + 4 * lane); xc = (f32x4){bflo(xr.x), bfhi(xr.x), bflo(xr.y), bfhi(xr.y)}; }
    unsigned b0[32], b1[32], b2[32];
    GS_ISSUE(b0, c0i, c1i, 0); GS_ISSUE(b1, c0i, c1i, 1);
    while (it < ntok) { GSD_TOK(b0, b1, b2); GSD_TOK(b1, b2, b0); GSD_TOK(b2, b0, b1); }
}
#define GS_UP(buf, q) do { const float cs_ = ((q) & 2) ? cc1 : cc0; const int lb_ = ((q) & 1) * 32; \
    _Pragma("unroll") for (int k = 0; k < 32; ++k) { float a_, b_, c_, d_; fp8x4_f32(buf[k], a_, b_, c_, d_); const float ck_ = rdlane(cs_, lb_ + k); \
        if (k & 1) { acc1.x += ck_ * a_; acc1.y += ck_ * b_; acc1.z += ck_ * c_; acc1.w += ck_ * d_; } else { acc0.x += ck_ * a_; acc0.y += ck_ * b_; acc0.z += ck_ * c_; acc0.w += ck_ * d_; } } } while (0)
#define GSU_COEF(tq, i0_, i1_, o0, o1) do { float h0_ = 0.f, h1_ = 0.f; \
    _Pragma("unroll") for (int xs = 0; xs < 8; ++xs) { h0_ += PART[((size_t)xs * TR + (tq)) * NSEL + lane]; h1_ += PART[((size_t)xs * TR + (tq)) * NSEL + 64 + lane]; } \
    const float rs_ = frsq(sumsq[tq] * (1.0f / DM) + RMS_EPS); const float z0_ = h0_ * rs_ * SCL[i0_], z1_ = h1_ * rs_ * SCL[i1_]; \
    o0 = GATE[(size_t)(tq) * NSEL + lane] * SCL[NEXP + (i0_)] * 0.5f * z0_ * (1.0f + erff(z0_ * 0.70710678118654752f)); \
    o1 = GATE[(size_t)(tq) * NSEL + 64 + lane] * SCL[NEXP + (i1_)] * 0.5f * z1_ * (1.0f + erff(z1_ * 0.70710678118654752f)); } while (0)
#define GSU_TOK(Ba, Bb, Bc) do { \
    const int in_ = it + 1; const bool vn = in_ < ntok; const int tn = vn ? wv + in_ * NWV : wv; \
    const int n0 = IDX[(size_t)tn * NSEL + lane], n1 = IDX[(size_t)tn * NSEL + 64 + lane]; \
    f32x4 acc0 = (f32x4){0.f, 0.f, 0.f, 0.f}, acc1 = (f32x4){0.f, 0.f, 0.f, 0.f}; \
    GS_ISSUE(Bc, c0i, c1i, 2); \
    GS_UP(Ba, 0); GS_ISSUE(Ba, c0i, c1i, 3); \
    float nc0, nc1; GSU_COEF(tn, n0, n1, nc0, nc1); \
    GS_UP(Bb, 1); GS_ISSUE(Bb, n0, n1, 0); \
    GS_UP(Bc, 2); GS_ISSUE(Bc, n0, n1, 1); \
    GS_UP(Ba, 3); \
    if (vc) { GAS f32x4* op = (GAS f32x4*)(F.out + (size_t)tc * DM + 256 * sm.slice + 4 * lane); f32x4 o = *op; o = o + acc0 + acc1; *op = o; } \
    c0i = n0; c1i = n1; cc0 = nc0; cc1 = nc1; tc = tn; vc = vn; ++it; } while (0)
DI void gather_up_sliced(Frame& F, const XcdBarrier& bar) {
    const int lane = F.lane, wave = F.wave;
    const SliceMap sm = slice_map(F, bar);
    const int* IDX = (const int*)(F.ws + WS_IDX); const float* GATE = (const float*)(F.ws + WS_GATE);
    const unsigned char* T8 = F.ws + WS_TU + (size_t)sm.slice * ((size_t)NEXP * 256) + lane * 4;
    const float* PART = (const float*)(F.ws + WS_PART); const float* SCL = (const float*)(F.ws + WS_SCL);
    const float* sumsq = (const float*)(F.ws + WS_SUMSQ);
    const int wv = sm.rank * NWAVES + wave, NWV = sm.nblk * NWAVES;
    const int ntok = wv < TR ? (TR - wv + NWV - 1) / NWV : 0;
    int it = 0; int tc = wv < TR ? wv : 0; bool vc = ntok > 0;
    int c0i = IDX[(size_t)tc * NSEL + lane], c1i = IDX[(size_t)tc * NSEL + 64 + lane];
    float cc0, cc1; GSU_COEF(tc, c0i, c1i, cc0, cc1);
    unsigned b0[32], b1[32], b2[32];
    GS_ISSUE(b0, c0i, c1i, 0); GS_ISSUE(b1, c0i, c1i, 1);
    while (it < ntok) { GSU_TOK(b0, b1, b2); GSU_TOK(b1, b2, b0); GSU_TOK(b2, b0, b1); }
}

#ifndef REP_ATT
#define REP_ATT 1
#endif
#ifndef REP_RWKV
#define REP_RWKV 1
#endif
struct Args { const float* in[24]; float* out; unsigned char* ws; int ph_lo, ph_hi, li, pad; };
__global__ void __launch_bounds__(NTHR, 2) hybrid_fwd(Args args) {
    extern __shared__ __attribute__((aligned(16))) unsigned char lds[];
    Frame F;
    F.lds = (LAS unsigned char*)lds;
    F.MISC = (volatile LAS unsigned*)(F.lds + MISC_OFF);
    F.tid = threadIdx.x; F.lane = F.tid & 63; F.wave = __builtin_amdgcn_readfirstlane(F.tid >> 6);
    F.G = gridDim.x; { const int bx = blockIdx.x; F.vcu = (F.G % 8 == 0) ? (bx % 8) * (F.G / 8) + bx / 8 : bx; }
    F.ws = args.ws; F.out = args.out; F.ctl = (gu32*)(args.ws + WS_CTL);
#pragma unroll
    for (int i = 0; i < 24; ++i) F.in[i] = args.in[i];
    for (int u = F.tid; u < (LDS_BYTES - LDSCTL_OFF) / 4; u += NTHR) ((LAS unsigned*)(F.lds + LDSCTL_OFF))[u] = 0u;
    __syncthreads();
    XcdBarrier bar; bar.bar = (unsigned*)(F.ctl + CW_BAR); bar.x = 0; bar.st = nullptr;
    if (!MK_SPLIT) {
        bar.x = xb_xcc_id(); bar.st = F.MISC + 8;
        if (F.tid == 0) F.MISC[10] = xb_add(&bar.bar[XB_XCNT(bar.x)], 1u);
        __syncthreads();
    }
    const int lo = args.ph_lo, hi = args.ph_hi;
#ifndef PH_MASK
#define PH_MASK 0x1ff
#endif
#define IN(k) (((PH_MASK >> (k)) & 1) && lo <= (k) && (k) < hi)
#define SEAM(k) do { if (IN(k) && IN((k) + 1)) xcd_barrier(bar); } while (0)
    bf16* Win_t = (bf16*)(F.ws + WS_WIN); bf16* Wout_t = (bf16*)(F.ws + WS_WOUT); bf16* Wqs_t = (bf16*)(F.ws + WS_WQS);
    bf16* U = (bf16*)(F.ws + WS_U); bf16* P = (bf16*)(F.ws + WS_P); bf16* H1B = (bf16*)(F.ws + WS_H1B);
    float* sumsq = (float*)(F.ws + WS_SUMSQ); float* SC = (float*)(F.ws + WS_SC);

#ifndef PH_DUP
#define PH_DUP 0
#endif
#define DUP(k) for (int rep_ = 0; rep_ < (((PH_DUP >> (k)) & 1) ? 2 : 1); ++rep_)
    if (IN(0)) { DUP(0) { p0_prologue(F); __syncthreads(); } } SEAM(0);
    if (IN(1)) {
        pg8::Gemm g{U, Win_t, MIN_ROWS, NP, DM}; pg8::StaticOrder S; S.init(MIN_ROWS, NP, F.G, (int)blockIdx.x);
        pg8::EpiBf16<0> E{P, NP, nullptr, 0, 0, 1.f};
        pg8::gemm_phase<pg8::EpiBf16<0>, pg8::StaticOrder, true, true>(F.lds, g, S, E);
#if (PH_DUP >> 1) & 1
        __syncthreads(); pg8::gemm_phase<pg8::EpiBf16<0>, pg8::StaticOrder, true, true>(F.lds, g, S, E);
#endif
    } SEAM(1);
    if (IN(2)) {
        for (int rep = 0; rep < REP_ATT; ++rep) for (int u = blockIdx.x; u < 256; u += F.G) attn_unit(F, u);
        for (int rep = 0; rep < REP_RWKV; ++rep) for (int u = blockIdx.x; u < 256; u += F.G) rwkv_pass1(F, u);
    } SEAM(2);
    if (IN(3)) {
        for (int u = blockIdx.x; u < 256; u += F.G) rwkv_pass2(F, u);
    } SEAM(3);
    if (IN(4)) {
        pg8::Gemm g{U, Wout_t, TR, DM, DM}; pg8::StaticOrder S; S.init(TR, DM, F.G, (int)blockIdx.x);
        pg8::EpiOut E{F.in[IN_X], F.out, H1B, sumsq, DM};
        pg8::gemm_phase<pg8::EpiOut, pg8::StaticOrder, true, true>(F.lds, g, S, E);
    } SEAM(4);
    if (IN(5)) {
        pg8::Gemm g{H1B, Wqs_t, TR, DM, DM}; pg8::StaticOrder S; S.init(TR, DM, F.G, (int)blockIdx.x);
        pg8::EpiScores E{sumsq, SC, DM, RMS_EPS};
        pg8::gemm_phase<pg8::EpiScores, pg8::StaticOrder, true, true>(F.lds, g, S, E);
#if (PH_DUP >> 5) & 1
        __syncthreads(); pg8::gemm_phase<pg8::EpiScores, pg8::StaticOrder, true, true>(F.lds, g, S, E);
#endif
    } SEAM(5);
#if !FUSE_TOPK || GATHER_SLICED
    if (IN(6)) { DUP(6) topk_phase(F); } SEAM(6);
#endif
#if GATHER_SLICED
    if (IN(7)) { gather_down_sliced(F, bar); } SEAM(7);
    if (IN(8)) { gather_up_sliced(F, bar); }
#else
    if (IN(7)) { gather_phase(F, bar); }
#endif
#undef IN
#undef SEAM
}

extern "C" void kernel_launch(void* const* d_in, const int* in_sizes, int n_in, void* d_out, int out_size, void* d_ws, size_t ws_size, hipStream_t stream) {
    static int grid = 0;
    if (grid == 0) {
        if (n_in != 24 || in_sizes[0] != TR * DM || out_size != TR * DM || ws_size < WS_END) { fprintf(stderr, "kernel_launch: unexpected shapes: n_in %d in0 %d out %d ws %zu\n", n_in, n_in > 0 ? in_sizes[0] : -1, out_size, ws_size); grid = -1; return; }
        int dev = 0, cus = 0, per_cu = 0;
        if (hipGetDevice(&dev) != hipSuccess || hipDeviceGetAttribute(&cus, hipDeviceAttributeMultiprocessorCount, dev) != hipSuccess) { grid = -1; return; }
        if (hipFuncSetAttribute((const void*)hybrid_fwd, hipFuncAttributeMaxDynamicSharedMemorySize, LDS_BYTES) != hipSuccess) { fprintf(stderr, "kernel_launch: hipFuncSetAttribute failed\n"); grid = -1; return; }
        if (hipOccupancyMaxActiveBlocksPerMultiprocessor(&per_cu, (const void*)hybrid_fwd, NTHR, LDS_BYTES) != hipSuccess || per_cu < 1) fprintf(stderr, "kernel_launch: occupancy query says %d\n", per_cu);
        (void)hipGetLastError();
        grid = cus;
    }
    if (grid < 0) return;
    if (hipMemsetAsync((char*)d_ws + WS_CTL, 0, CTL_ZERO_BYTES, stream) != hipSuccess) return;
    Args a{};
    for (int i = 0; i < 24; ++i) a.in[i] = (const float*)d_in[i];
    a.out = (float*)d_out; a.ws = (unsigned char*)d_ws;
#if MK_SPLIT
    for (int li = 0; li < NPHASE; ++li) { a.ph_lo = li; a.ph_hi = li + 1; a.li = li; hipLaunchKernelGGL(hybrid_fwd, dim3(grid), dim3(NTHR), LDS_BYTES, stream, a); }
#else
    a.ph_lo = 0; a.ph_hi = NPHASE; a.li = 0;
    hipLaunchKernelGGL(hybrid_fwd, dim3(grid), dim3(NTHR), LDS_BYTES, stream, a);
#endif
}
```

```cpp
#include <hip/hip_runtime.h>
#include <cstdio>
#include <cstdint>
namespace pg8 {
#define PG8_LAS __attribute__((address_space(3)))
typedef unsigned short bf16_t;
typedef short bf16x8 __attribute__((ext_vector_type(8)));
typedef float f32x4 __attribute__((ext_vector_type(4)));
typedef unsigned u32x4 __attribute__((ext_vector_type(4)));
constexpr int BM = 256, BK = 64, HALF = 128, HTB = HALF * BK * 2  , STAGE_BYTES = 8 * HTB, NXCD = 8, WGM = 8;

__host__ __device__ __forceinline__ int lds_byte(int r, int c) { const int st = (r >> 4) * 2 + (c >> 5), rr = r & 15, cc = c & 31, ob = rr * 64 + cc * 2; return st * 1024 + (ob ^ (((ob >> 9) & 1) << 5)); }
__host__ __device__ __forceinline__ void stage_rc(int b, int& R, int& C) { const int st = b / 1024, sb = b % 1024, swz = sb ^ (((sb >> 9) & 1) << 5); R = (st >> 1) * 16 + swz / 64; C = (st & 1) * 32 + (swz % 64) / 2; }
__host__ __device__ __forceinline__ int perm32(int rho) { const int n = rho >> 4, i = rho & 15; return 8 * (i >> 2) + 4 * n + (i & 3); }

struct Unit { int pm, pn; };
struct Gemm { const bf16_t* A; const bf16_t* Bt; int M, N, K; };

struct StaticOrder {
    int nM, nN, nwg, G, c;
    __host__ __device__ void init(int M, int N, int G_, int c_) { nM = M / BM; nN = N / BM; nwg = nM * nN; G = G_; c = c_; }
    __host__ __device__ bool next(int i, Unit& u) const {
        const long L = (long)i * G + c; if (L >= nwg) return false;
        int wgid = (int)L; { const int q = nwg / NXCD, r = nwg % NXCD, xcd = wgid % NXCD, off = wgid / NXCD; wgid = (xcd < r ? xcd * (q + 1) : r * (q + 1) + (xcd - r) * q) + off; }
        const int nig = WGM * nN, gid = wgid / nig, fm = gid * WGM, gsz = (nM - fm) < WGM ? (nM - fm) : WGM;
        u.pm = fm + ((wgid % nig) % gsz); u.pn = (wgid % nig) / gsz; return true;
    }
    __device__ __forceinline__ void a_ready(const Unit&) const {}
    __device__ __forceinline__ void done(const Unit&) const {}
};

__device__ __forceinline__ unsigned cvt_pk_bf16(float lo, float hi) { unsigned r; asm volatile("v_cvt_pk_bf16_f32 %0, %1, %2" : "=v"(r) : "v"(lo), "v"(hi)); return r; }
typedef float f32x2 __attribute__((ext_vector_type(2)));
__device__ __forceinline__ f32x2 gelu_pk(f32x2 v) {
    const f32x2 av = __builtin_elementwise_abs(v), d = av * 0.2316418882f + 1.0f;
    f32x2 t; t.x = __builtin_amdgcn_rcpf(d.x); t.y = __builtin_amdgcn_rcpf(d.y);
    f32x2 q = t * 0.5307027145f + (-0.7265760135f); q = q * t + 0.7107068705f; q = q * t + (-0.142248368f); q = q * t + 0.127414796f; q = q * t;
    const f32x2 s = (v * v) * (-0.72134752044f);
    f32x2 e; e.x = __builtin_amdgcn_exp2f(s.x); e.y = __builtin_amdgcn_exp2f(s.y);
    const f32x2 m = v * (q * e), r = v - m;
    f32x2 o; o.x = v.x < 0.f ? m.x : r.x; o.y = v.y < 0.f ? m.y : r.y; return o;
}

template <int ACT  > struct EpiBf16 {
    static constexpr bool PERM = true, AFTER_DRAIN = false; static_assert(ACT == 0 || ACT == 1, "EpiBf16: ACT is 0 (none) or 1 (gelu_pk)");
    bf16_t* O; int ldc; const float* bias; int split_cols; size_t split_stride; float scale0;
    __device__ __forceinline__ void operator()(const f32x4 (&acc)[2][2][4][2], const Unit& u, int wr, int wc, int fr, int fq) const {
        const int row0 = u.pm * BM + wr * 64 + fr; int colt = u.pn * BM; bf16_t* base = O;
        float sc = 1.f; if (split_cols) { const int t = colt / split_cols; base += (size_t)t * split_stride; colt -= t * split_cols; if (t == 0) sc = scale0; }
        const int col0 = colt + wc * 32 + 8 * fq, bcol0 = u.pn * BM + wc * 32 + 8 * fq;
        f32x4 bv[2][2];
#pragma unroll
        for (int bj = 0; bj < 2; ++bj)
#pragma unroll
            for (int n = 0; n < 2; ++n) bv[bj][n] = bias ? *(const f32x4*)(bias + bcol0 + bj * HALF + 4 * n) : (f32x4){0.f, 0.f, 0.f, 0.f};
#pragma unroll
        for (int ai = 0; ai < 2; ++ai)
#pragma unroll
            for (int m = 0; m < 4; ++m) { bf16_t* rowp = base + (size_t)(row0 + ai * HALF + m * 16) * ldc + col0;
#pragma unroll
                for (int bj = 0; bj < 2; ++bj) { f32x4 v0 = acc[ai][bj][m][0] + bv[bj][0], v1 = acc[ai][bj][m][1] + bv[bj][1];
                    if (ACT == 1) { f32x2 a = gelu_pk((f32x2){v0[0], v0[1]}), b = gelu_pk((f32x2){v0[2], v0[3]}), c = gelu_pk((f32x2){v1[0], v1[1]}), d = gelu_pk((f32x2){v1[2], v1[3]});
                        v0 = (f32x4){a.x, a.y, b.x, b.y}; v1 = (f32x4){c.x, c.y, d.x, d.y}; }
                    v0 = v0 * sc; v1 = v1 * sc; u32x4 w; w.x = cvt_pk_bf16(v0[0], v0[1]); w.y = cvt_pk_bf16(v0[2], v0[3]); w.z = cvt_pk_bf16(v1[0], v1[1]); w.w = cvt_pk_bf16(v1[2], v1[3]);
                    *(u32x4*)(rowp + bj * HALF) = w; } }
    }
};

typedef unsigned u32x2 __attribute__((ext_vector_type(2)));
#define H1_BF16_ONLY 1
struct EpiOut {
    static constexpr bool PERM = false, AFTER_DRAIN = false;
    const float* x; float* out; bf16_t* hb; float* sumsq; int ldc;
    __device__ __forceinline__ void operator()(const f32x4 (&acc)[2][2][4][2], const Unit& u, int wr, int wc, int fr, int fq) const {
        const int row0 = u.pm * BM + wr * 64 + fr, col0 = u.pn * BM + wc * 32 + 4 * fq;
#pragma unroll
        for (int ai = 0; ai < 2; ++ai)
#pragma unroll
            for (int m = 0; m < 4; ++m) {
                const int row = row0 + ai * HALF + m * 16; const size_t off = (size_t)row * ldc + col0; float ss = 0.f;
#pragma unroll
                for (int bj = 0; bj < 2; ++bj)
#pragma unroll
                    for (int n = 0; n < 2; ++n) {
                        const size_t o = off + bj * HALF + n * 16;
                        const f32x4 xv = *(const f32x4*)(x + o); const f32x4 v = xv + acc[ai][bj][m][n];
#if !defined(H1_BF16_ONLY)
                        *(f32x4*)(out + o) = v;
#endif
                        ss += (v[0] * v[0] + v[1] * v[1]) + (v[2] * v[2] + v[3] * v[3]);
                        u32x2 w; w.x = cvt_pk_bf16(v[0], v[1]); w.y = cvt_pk_bf16(v[2], v[3]); *(u32x2*)(hb + o) = w;
                    }
                ss += __shfl_xor(ss, 16); ss += __shfl_xor(ss, 32);
                if (fq == 0) atomicAdd(sumsq + row, ss);
            }
    }
};
struct EpiScores {
    static constexpr bool PERM = false, AFTER_DRAIN = false;
    const float* sumsq; float* S; int ldc; float eps;
    __device__ __forceinline__ void operator()(const f32x4 (&acc)[2][2][4][2], const Unit& u, int wr, int wc, int fr, int fq) const {
        const int row0 = u.pm * BM + wr * 64 + fr, col0 = u.pn * BM + wc * 32 + 4 * fq;
#pragma unroll
        for (int ai = 0; ai < 2; ++ai)
#pragma unroll
            for (int m = 0; m < 4; ++m) {
                const int row = row0 + ai * HALF + m * 16; const size_t off = (size_t)row * ldc + col0;
                const float rs = 1.0f / sqrtf(sumsq[row] * (1.0f / 2048.0f) + eps);
#pragma unroll
                for (int bj = 0; bj < 2; ++bj)
#pragma unroll
                    for (int n = 0; n < 2; ++n) *(f32x4*)(S + off + bj * HALF + n * 16) = acc[ai][bj][m][n] * rs;
            }
    }
};
template <class Epi, class Sched, bool ALIGN_EPI = false, bool SP2 = false>
__device__ __forceinline__ void gemm_phase(PG8_LAS unsigned char* lds, const Gemm g, const Sched& S, const Epi& E) {
    const int tid = threadIdx.x, wid = __builtin_amdgcn_readfirstlane(tid >> 6), lane = tid & 63, wr = wid >> 2, wc = wid & 3, fr = lane & 15, fq = lane >> 4;
    const int K = g.K, nt = K / BK;
    unsigned voffA[2], voffB[2];
#pragma unroll
    for (int i = 0; i < 2; ++i) { int R, C; stage_rc(tid * 16 + i * 8192, R, C); const int Rb = Epi::PERM ? ((R & ~31) + perm32(R & 31)) : R;
        voffA[i] = (unsigned)(R * K + C) * 2u; voffB[i] = (unsigned)(Rb * K + C) * 2u; }
    const size_t kstep = (size_t)(BK * 2);
    const size_t hstep = (size_t)HALF * K * 2;
    const size_t tstep = 2 * hstep;
    const unsigned ldsw = (unsigned)wid * 1024u;
    const int aoff = lds_byte(wr * 64 + fr, fq * 8), boff = lds_byte(wc * 32 + fr, fq * 8);
#define PG8_SA(b, h) (((b) * 2 + (h)) * HTB)
#define PG8_SB(b, h) ((4 + (b) * 2 + (h)) * HTB)
#define PG8_STAGE(bufoff, gbase, voff) do { _Pragma("unroll") for (int _i = 0; _i < 2; ++_i) \
        __builtin_amdgcn_global_load_lds((const unsigned*)((const char*)(gbase) + (voff)[_i]), (PG8_LAS unsigned*)(lds + (bufoff) + ldsw + _i * 8192), 16, 0, 0); } while (0)
#define PG8_LDA(dst, b, h) do { _Pragma("unroll") for (int m = 0; m < 4; ++m) _Pragma("unroll") for (int k = 0; k < 2; ++k) dst[m][k] = *(const PG8_LAS bf16x8*)(lds + PG8_SA(b, h) + aoff + m * 2048 + k * 1024); } while (0)
#define PG8_LDB(dst, b, h) do { _Pragma("unroll") for (int n = 0; n < 2; ++n) _Pragma("unroll") for (int k = 0; k < 2; ++k) dst[n][k] = *(const PG8_LAS bf16x8*)(lds + PG8_SB(b, h) + boff + n * 2048 + k * 1024); } while (0)
#define PG8_MMA(ai, bj, At, Bt) do { __builtin_amdgcn_s_setprio(1); _Pragma("unroll") for (int m = 0; m < 4; ++m) _Pragma("unroll") for (int n = 0; n < 2; ++n) _Pragma("unroll") for (int k = 0; k < 2; ++k) \
        acc[ai][bj][m][n] = __builtin_amdgcn_mfma_f32_16x16x32_bf16(Bt[n][k], At[m][k], acc[ai][bj][m][n], 0, 0, 0); __builtin_amdgcn_s_setprio(0); } while (0)
#define PG8_WAIT_V(n) asm volatile("s_waitcnt vmcnt(" #n ")" ::: "memory")
#define PG8_WAIT_L(n) asm volatile("s_waitcnt lgkmcnt(" #n ")" ::: "memory")
#define PG8_BAR __builtin_amdgcn_s_barrier()
#define PG8_SCHED __builtin_amdgcn_sched_barrier(0)
    Unit cur, nxt; int ui = 0;
    if (!S.next(0, cur)) return;
    f32x4 acc[2][2][4][2];
#pragma unroll
    for (int a = 0; a < 2; ++a)
#pragma unroll
        for (int b = 0; b < 2; ++b)
#pragma unroll
            for (int m = 0; m < 4; ++m)
#pragma unroll
                for (int n = 0; n < 2; ++n) acc[a][b][m][n] = (f32x4){0.f, 0.f, 0.f, 0.f};
    bf16x8 At[4][2], B0[2][2], B1[2][2];
    const char* cA = (const char*)g.A + (size_t)cur.pm * tstep; const char* cB = (const char*)g.Bt + (size_t)cur.pn * tstep;
    S.a_ready(cur);
    if constexpr (SP2) {
        PG8_STAGE(PG8_SB(0, 0), cB, voffB); PG8_STAGE(PG8_SB(0, 1), cB + hstep, voffB); PG8_STAGE(PG8_SA(0, 0), cA, voffA); PG8_STAGE(PG8_SA(0, 1), cA + hstep, voffA);
        if (wr == 1) PG8_BAR;
        PG8_WAIT_V(2); PG8_BAR;
        PG8_STAGE(PG8_SB(1, 0), cB + kstep, voffB); PG8_STAGE(PG8_SA(1, 0), cA + kstep, voffA); PG8_STAGE(PG8_SB(1, 1), cB + hstep + kstep, voffB);
        PG8_WAIT_V(6); PG8_BAR;
    } else {
        PG8_STAGE(PG8_SB(0, 0), cB, voffB); PG8_STAGE(PG8_SA(0, 0), cA, voffA); PG8_STAGE(PG8_SB(0, 1), cB + hstep, voffB); PG8_STAGE(PG8_SA(0, 1), cA + hstep, voffA);
        if (wr == 1) PG8_BAR;
        PG8_WAIT_V(4); PG8_BAR;
        PG8_STAGE(PG8_SB(1, 0), cB + kstep, voffB); PG8_STAGE(PG8_SA(1, 0), cA + kstep, voffA); PG8_STAGE(PG8_SB(1, 1), cB + hstep + kstep, voffB);
        PG8_WAIT_V(6); PG8_BAR;
    }
    for (;;) {
        const bool has_next = S.next(ui + 1, nxt);
        const char* nA = has_next ? (const char*)g.A + (size_t)nxt.pm * tstep : cA; const char* nB = has_next ? (const char*)g.Bt + (size_t)nxt.pn * tstep : cB;
        for (int t = 0; t < nt; t += 2) {
            const bool last = (t == nt - 2);
            const char* a1 = cA + (size_t)(t + 1) * kstep;
            const char* a2 = last ? nA : cA + (size_t)(t + 2) * kstep; const char* b2 = last ? nB : cB + (size_t)(t + 2) * kstep;
            const char* a3 = a2 + kstep; const char* b3 = b2 + kstep;
            if (last && has_next) S.a_ready(nxt);
            if constexpr (SP2) {
            PG8_LDB(B0, 0, 0); PG8_LDB(B1, 0, 1); PG8_SCHED; PG8_LDA(At, 0, 0); PG8_STAGE(PG8_SA(1, 1), a1 + hstep, voffA);
            PG8_WAIT_V(8); PG8_WAIT_L(0); PG8_BAR; PG8_MMA(0, 0, At, B0); PG8_MMA(0, 1, At, B1); PG8_BAR; PG8_SCHED;
            PG8_LDA(At, 0, 1); PG8_STAGE(PG8_SB(0, 0), b2, voffB); PG8_STAGE(PG8_SB(0, 1), b2 + hstep, voffB); PG8_STAGE(PG8_SA(0, 0), a2, voffA);
            PG8_WAIT_V(8); PG8_WAIT_L(0); PG8_BAR; PG8_MMA(1, 0, At, B0); PG8_MMA(1, 1, At, B1); PG8_BAR; PG8_SCHED;
            PG8_LDB(B0, 1, 0); PG8_LDB(B1, 1, 1); PG8_SCHED; PG8_LDA(At, 1, 0); PG8_STAGE(PG8_SA(0, 1), a2 + hstep, voffA);
            PG8_WAIT_V(8); PG8_WAIT_L(0); PG8_BAR; PG8_MMA(0, 0, At, B0); PG8_MMA(0, 1, At, B1); PG8_BAR; PG8_SCHED;
            PG8_LDA(At, 1, 1); PG8_STAGE(PG8_SB(1, 0), b3, voffB); PG8_STAGE(PG8_SB(1, 1), b3 + hstep, voffB); PG8_STAGE(PG8_SA(1, 0), a3, voffA);
            PG8_WAIT_V(8); PG8_WAIT_L(0); PG8_BAR; PG8_MMA(1, 0, At, B0); PG8_MMA(1, 1, At, B1); PG8_BAR; PG8_SCHED;
            } else {
            PG8_LDB(B0, 0, 0); PG8_SCHED; PG8_LDA(At, 0, 0); PG8_STAGE(PG8_SA(1, 1), a1 + hstep, voffA);
            PG8_WAIT_L(8); PG8_BAR; PG8_WAIT_L(0); PG8_MMA(0, 0, At, B0); PG8_BAR; PG8_SCHED;
            PG8_LDB(B1, 0, 1); PG8_STAGE(PG8_SB(0, 0), b2, voffB);
            PG8_BAR; PG8_WAIT_L(0); PG8_MMA(0, 1, At, B1); PG8_BAR;
            PG8_LDA(At, 0, 1); PG8_STAGE(PG8_SA(0, 0), a2, voffA);
            PG8_BAR; PG8_WAIT_L(0); PG8_MMA(1, 0, At, B0); PG8_BAR; PG8_SCHED;
            PG8_STAGE(PG8_SB(0, 1), b2 + hstep, voffB);
            PG8_WAIT_V(6); PG8_BAR; PG8_MMA(1, 1, At, B1); PG8_BAR;
            PG8_LDB(B0, 1, 0); PG8_SCHED; PG8_LDA(At, 1, 0); PG8_STAGE(PG8_SA(0, 1), a2 + hstep, voffA);
            PG8_WAIT_L(8); PG8_BAR; PG8_WAIT_L(0); PG8_MMA(0, 0, At, B0); PG8_BAR; PG8_SCHED;
            PG8_LDB(B1, 1, 1); PG8_STAGE(PG8_SB(1, 0), b3, voffB);
            PG8_BAR; PG8_WAIT_L(0); PG8_MMA(0, 1, At, B1); PG8_BAR;
            PG8_LDA(At, 1, 1); PG8_STAGE(PG8_SA(1, 0), a3, voffA);
            PG8_BAR; PG8_WAIT_L(0); PG8_MMA(1, 0, At, B0); PG8_BAR; PG8_SCHED;
            PG8_STAGE(PG8_SB(1, 1), b3 + hstep, voffB);
            PG8_WAIT_V(6); PG8_BAR; PG8_MMA(1, 1, At, B1); PG8_BAR;
            }
        }
        if constexpr (ALIGN_EPI) { if (wr == 0) PG8_BAR; }
        if constexpr (!Epi::AFTER_DRAIN) { E(acc, cur, wr, wc, fr, fq); S.done(cur); }
        if (!has_next) break;
#pragma unroll
        for (int a = 0; a < 2; ++a)
#pragma unroll
            for (int b = 0; b < 2; ++b)
#pragma unroll
                for (int m = 0; m < 4; ++m)
#pragma unroll
                    for (int n = 0; n < 2; ++n) acc[a][b][m][n] = (f32x4){0.f, 0.f, 0.f, 0.f};
        cur = nxt; cA = nA; cB = nB; ++ui;
        if constexpr (ALIGN_EPI) { if (wr == 1) PG8_BAR; }
    }
    PG8_WAIT_V(0);
    if constexpr (!ALIGN_EPI) { if (wr == 0) PG8_BAR; }
    PG8_BAR;
    if constexpr (Epi::AFTER_DRAIN) { E.fused(acc, cur, wr, wc, fr, fq, lds, wid, lane); S.done(cur); }
#undef PG8_SA
#undef PG8_SB
#undef PG8_STAGE
#undef PG8_LDA
#undef PG8_LDB
#undef PG8_MMA
#undef PG8_WAIT_V
#undef PG8_WAIT_L
#undef PG8_BAR
#undef PG8_SCHED
}
}
#define GAS __attribute__((address_space(1)))
#define LAS __attribute__((address_space(3)))
typedef unsigned short bf16;
typedef unsigned v4u __attribute__((ext_vector_type(4)));
typedef float f32x4 __attribute__((ext_vector_type(4)));
typedef short bf16x8 __attribute__((ext_vector_type(8)));
typedef GAS unsigned gu32;
typedef GAS unsigned long long gu64;
#define RLX_AGENT __ATOMIC_RELAXED, __HIP_MEMORY_SCOPE_AGENT
#define LDS_WAIT() asm volatile("s_waitcnt lgkmcnt(0)" ::: "memory")
#define VM_WAIT() asm volatile("s_waitcnt vmcnt(0)" ::: "memory")
__device__ __forceinline__ unsigned long long rt() { return __builtin_amdgcn_s_memrealtime(); }
__device__ __forceinline__ unsigned f2bf(float f) { unsigned u = __builtin_bit_cast(unsigned, f); return (u + 0x7fffu + ((u >> 16) & 1u)) >> 16; }
__device__ __forceinline__ unsigned pk2(float lo, float hi) { return f2bf(lo) | (f2bf(hi) << 16); }

#define XB_TMO      128
#define XB_XCNT(j)  (256  + 64 * (j))
#define XB_XSUB(j)  (1280 + 64 * (j))
#define XB_XGEN(j)  (2304 + 64 * (j))
#define XB_TOP      3328
#define XB_TOPGEN   3392
#define XCD_BAR_WORDS 3456
#define XB_SPIN_CAP (1u << 18)

__device__ __forceinline__ unsigned xb_ld(unsigned* p)              { return __hip_atomic_load(p, __ATOMIC_RELAXED, __HIP_MEMORY_SCOPE_AGENT); }
__device__ __forceinline__ unsigned xb_add(unsigned* p, unsigned v) { return __hip_atomic_fetch_add(p, v, __ATOMIC_RELAXED, __HIP_MEMORY_SCOPE_AGENT); }
__device__ __forceinline__ unsigned xb_xcc_id() { return (unsigned)__builtin_amdgcn_s_getreg((3 << 11) | 20) & 0xFu; }
#define XB_SPIN(cond, bar) do { unsigned _sp = 0; while (cond) { __builtin_amdgcn_s_sleep(1); \
    if ((++_sp & 255u) == 0u) { if (xb_ld(&(bar)[XB_TMO])) break; if (_sp > XB_SPIN_CAP) { atomicAdd(&(bar)[XB_TMO], 1u); break; } } } } while (0)

struct XcdBarrier {
    unsigned* bar; unsigned x;
    volatile LAS unsigned* st;
};

__device__ __forceinline__ XcdBarrier xcd_barrier_post(unsigned* bar, volatile LAS unsigned* st) {
    XcdBarrier b; b.bar = bar; b.x = xb_xcc_id(); b.st = st;
    if (threadIdx.x == 0) (void)xb_add(&bar[XB_XCNT(b.x)], 1u);
    return b;
}
__device__ __forceinline__ void xcd_barrier_complete(unsigned* bar, unsigned x, unsigned& nloc, unsigned& nx) {
    const unsigned G = gridDim.x * gridDim.y * gridDim.z;
    unsigned sum, cnt, mine, sp = 0u;
    for (;;) {
        sum = 0u; cnt = 0u; mine = 0u;
#pragma unroll
        for (unsigned j = 0; j < 16; ++j) { const unsigned c = xb_ld(&bar[XB_XCNT(j)]); sum += c; cnt += (c > 0u) ? 1u : 0u; mine = (j == x) ? c : mine; }
        if (sum == G) break;
        __builtin_amdgcn_s_sleep(1);
        if ((++sp & 255u) == 0u) { if (xb_ld(&bar[XB_TMO])) break; if (sp > XB_SPIN_CAP) { atomicAdd(&bar[XB_TMO], 1u); break; } }
    }
    nloc = mine > 0u ? mine : 1u; nx = cnt > 0u ? cnt : 1u;
}

__device__ __forceinline__ void xcd_barrier(const XcdBarrier& b) {
    asm volatile("s_waitcnt vmcnt(0)" ::: "memory");
    __syncthreads();
    if (threadIdx.x == 0) {
        unsigned* bar = b.bar;
        __builtin_amdgcn_s_waitcnt(0);
        unsigned nloc = b.st[0], nx = b.st[1];
        if (nloc == 0u) { xcd_barrier_complete(bar, b.x, nloc, nx); b.st[0] = nloc; b.st[1] = nx; }
        const unsigned old = xb_add(&bar[XB_XSUB(b.x)], 1u);
        const unsigned gen = old / nloc;
        if (old + 1u == (gen + 1u) * nloc) {
            __builtin_amdgcn_fence(__ATOMIC_RELEASE, "agent");
            asm volatile("s_waitcnt vmcnt(0)" ::: "memory");
            const unsigned og = xb_add(&bar[XB_TOP], 1u);
            const unsigned tg = og / nx;
            if (og + 1u == (tg + 1u) * nx) xb_add(&bar[XB_TOPGEN], 1u);
            else XB_SPIN(xb_ld(&bar[XB_TOPGEN]) == tg, bar);
            __builtin_amdgcn_fence(__ATOMIC_ACQUIRE, "agent");
            xb_add(&bar[XB_XGEN(b.x)], 1u);
            asm volatile("s_waitcnt vmcnt(0)" ::: "memory");
        } else {
            XB_SPIN(xb_ld(&bar[XB_XGEN(b.x)]) == gen, bar);
            __builtin_amdgcn_fence(__ATOMIC_ACQUIRE, "agent");
            asm volatile("s_waitcnt vmcnt(0)" ::: "memory");
        }
    }
    __syncthreads();
}

#define DI __device__ __forceinline__
constexpr int NWAVES = 8, NTHR = 512;
constexpr int BATCH = 4, SEQ = 4096, DM = 2048, TR = BATCH * SEQ, NMETA = 16, MIN_ROWS = 16640;
constexpr int INC = 4640, NP = 4864;
constexpr int CQ = 0, CK = 1024, CV = 1152, CR = 1280, CPK = 2304, CPV = 3328, CW = 4352, CA = 4416, CG = 4480;
constexpr int NEXP = 16384, NSEL = 128;
constexpr float RMS_EPS = 1e-6f, GN_EPS = 64e-5f;
constexpr int NPHASE = 9;
#ifndef MK_SPLIT
#define MK_SPLIT 0
#endif

constexpr size_t MiB = 1u << 20;
constexpr size_t WS_CTL = 0, CTL_ZERO_BYTES = 1 * MiB;
constexpr size_t WS_WIN = 1 * MiB, WS_WOUT = 20 * MiB, WS_WQS = 28 * MiB, WS_SUMSQ = 36 * MiB;
constexpr size_t WS_U = 40 * MiB;
constexpr size_t WS_P = 106 * MiB;
constexpr size_t WS_TD = 262 * MiB, WS_TU = 294 * MiB;
constexpr size_t WS_SCL = 37 * MiB;
constexpr size_t WS_LW = 38 * MiB;
constexpr size_t WS_IDX = 390 * MiB, WS_GATE = 398 * MiB;
#ifndef TBL_FP6
#define TBL_FP6 1
#endif
#ifndef TBL_FP4
#define TBL_FP4 1
#endif
constexpr int ROWB = TBL_FP4 ? 1152 : 1536;
#ifndef UP_TR
#define UP_TR 1
#endif
constexpr int ROWU = 1024, UR_PITCH = 1040, UR_BUF = 8 * UR_PITCH, UR_BASE = 8192, UR_WAVE = 2 * UR_BUF;
#ifndef GATHER_SLICED
#define GATHER_SLICED 0
#endif
constexpr size_t WS_PART = 40 * MiB;
constexpr size_t WS_RW = 330 * MiB;
constexpr size_t WS_RWS = 460 * MiB;
constexpr size_t WS_END = 470 * MiB;
constexpr size_t WS_SC = 40 * MiB;
constexpr size_t WS_H1B = 170 * MiB;
static_assert(WS_U + (size_t)MIN_ROWS * DM * 2 <= WS_P && WS_P + (size_t)MIN_ROWS * NP * 2 <= WS_TD && WS_SC + (size_t)TR * DM * 4 <= WS_H1B && WS_H1B + (size_t)TR * DM * 2 <= WS_TD, "ws map");
constexpr int CW_BAR = 4096;
constexpr int RING_BYTES = 131072, LDSCTL_OFF = 159744, MISC_OFF = LDSCTL_OFF + 320, LDS_BYTES = 160256;

DI float bflo(unsigned w) { return __uint_as_float(w << 16); }
DI float bfhi(unsigned w) { return __uint_as_float(w & 0xffff0000u); }
DI float wave_sum(float v) {
#pragma unroll
    for (int o = 1; o < 64; o <<= 1) v += __shfl_xor(v, o);
    return v;
}
template <int CTRL> DI float dppf(float v) { return __int_as_float(__builtin_amdgcn_update_dpp(0, __float_as_int(v), CTRL, 0xf, 0xf, true)); }
DI float red8(float v) { v += dppf<0xB1>(v); v += dppf<0x4E>(v); v += dppf<0x141>(v); return v; }
DI float red16(float v) { v = red8(v); v += dppf<0x140>(v); return v; }
DI float max16(float v) { v = fmaxf(v, dppf<0xB1>(v)); v = fmaxf(v, dppf<0x4E>(v)); v = fmaxf(v, dppf<0x141>(v)); v = fmaxf(v, dppf<0x140>(v)); return v; }
DI float rdlane(float v, int l) { return __int_as_float(__builtin_amdgcn_readlane(__float_as_int(v), l)); }
DI float wave_max(float v) {
    v = max16(v);
    const float a = rdlane(v, 0), b = rdlane(v, 16), c = rdlane(v, 32), d = rdlane(v, 48);
    return fmaxf(fmaxf(a, b), fmaxf(c, d));
}
DI float frcp(float x) { return __builtin_amdgcn_rcpf(x); }
DI float frsq(float x) { return __builtin_amdgcn_rsqf(x); }
DI float sigmoidf_(float x) { return frcp(1.0f + __expf(-x)); }
DI float tanhf_(float x) { return 1.0f - 2.0f * frcp(1.0f + __expf(2.0f * x)); }
DI float softplusf_(float x) { return fmaxf(x, 0.f) + __logf(1.0f + __expf(-fabsf(x))); }
DI void rw_piece(int pi, int& tt, int& pc) {
    if (pi < 768) { tt = pi / 24; pc = pi - tt * 24; }
    else if (pi < 1024) { const int q = pi - 768; tt = q >> 3; pc = 24 + (q & 7); }
    else if (pi < 1280) { const int q = pi - 1024; tt = q >> 3; pc = 32 + (q & 7); }
    else { const int q = pi - 1280; tt = q / 20; pc = 40 + (q - tt * 20); }
}
typedef unsigned u32x2 __attribute__((ext_vector_type(2)));
typedef float f32x16 __attribute__((ext_vector_type(16)));
DI int crow(int reg, int h) { return (reg & 3) + 8 * (reg >> 2) + 4 * h; }
#define MFMA32(a, b, c) __builtin_amdgcn_mfma_f32_32x32x16_bf16((a), (b), (c), 0, 0, 0)
#define MFMA16(a, b, c) __builtin_amdgcn_mfma_f32_16x16x32_bf16((a), (b), (c), 0, 0, 0)
#define LBAR() do { asm volatile("s_waitcnt lgkmcnt(0)" ::: "memory"); __builtin_amdgcn_s_barrier(); asm volatile("" ::: "memory"); } while (0)

struct Frame {
    LAS unsigned char* lds;
    volatile LAS unsigned* MISC;
    gu32* ctl;
    int tid, lane, wave;
    int vcu, G;
    const float* in[24];
    float* out; unsigned char* ws;
};
#define IN_X 0
#define IN_META 1
#define IN_N1G 2
#define IN_WIN 3
#define IN_MU 4
#define IN_W0 5
#define IN_WUP 6
#define IN_A0 7
#define IN_AUP 8
#define IN_GUP 9
#define IN_KK 10
#define IN_KA 11
#define IN_RK 12
#define IN_GNW 13
#define IN_GNB 14
#define IN_QG 15
#define IN_KG 16
#define IN_SINK 17
#define IN_WOUT 18
#define IN_N2G 19
#define IN_PQ 20
#define IN_PSK 21
#define IN_PD 22
#define IN_PU 23

DI void p0_transpose_item(const float* W, int K, int N, bf16* WT, int row_off, LAS float* scr, int item, int lane) {
    const int nblk = N / 32, kb = item / nblk, nb = item % nblk, k0 = 64 * kb, n0 = 32 * nb;
#pragma unroll 8
    for (int i = 0; i < 32; ++i) { const int kk = 2 * i + (lane >> 5); scr[kk * 33 + (lane & 31)] = W[(size_t)(k0 + kk) * N + n0 + (lane & 31)]; }
    LDS_WAIT(); asm volatile("" ::: "memory");
    const int c = lane & 7;
#pragma unroll
    for (int j = 0; j < 4; ++j) { const int n = (lane >> 3) + 8 * j; const LAS float* s = scr + (8 * c) * 33 + n;
        v4u o; o.x = pk2(s[0 * 33], s[1 * 33]); o.y = pk2(s[2 * 33], s[3 * 33]); o.z = pk2(s[4 * 33], s[5 * 33]); o.w = pk2(s[6 * 33], s[7 * 33]);
        *(GAS v4u*)(WT + (size_t)(row_off + n0 + n) * K + k0 + 8 * c) = o; }
    LDS_WAIT(); asm volatile("" ::: "memory");
}
DI void rms_row_to_bf16(const float* xrow, const float* g, bf16* orow, int lane) {
    const GAS f32x4* xr = (const GAS f32x4*)xrow + lane; const GAS f32x4* gr = (const GAS f32x4*)g + lane;
    f32x4 v[8]; float s = 0.f;
#pragma unroll
    for (int j = 0; j < 8; ++j) { v[j] = xr[64 * j]; s += (v[j].x * v[j].x + v[j].y * v[j].y) + (v[j].z * v[j].z + v[j].w * v[j].w); }
    const float rs = 1.0f / sqrtf(wave_sum(s) * (1.0f / DM) + RMS_EPS);
    GAS unsigned long long* o8 = (GAS unsigned long long*)orow + lane;
#pragma unroll
    for (int j = 0; j < 8; ++j) { const f32x4 gg = gr[64 * j];
        o8[64 * j] = (unsigned long long)pk2(v[j].x * rs * gg.x, v[j].y * rs * gg.y) | ((unsigned long long)pk2(v[j].z * rs * gg.z, v[j].w * rs * gg.w) << 32); }
}
#ifndef P0_REP
#define P0_REP 0
#endif
DI void p0_prologue(Frame& F) {
    const int tid = F.tid, lane = F.lane, wave = F.wave;
    const int gw = F.vcu * NWAVES + wave, NGW = F.G * NWAVES;
    const size_t gt = (size_t)blockIdx.x * NTHR + tid, NT = (size_t)F.G * NTHR;
    bf16* Win_t = (bf16*)(F.ws + WS_WIN); bf16* Wout_t = (bf16*)(F.ws + WS_WOUT); bf16* Wqs_t = (bf16*)(F.ws + WS_WQS);
    bf16* U = (bf16*)(F.ws + WS_U);
    float* sumsq = (float*)(F.ws + WS_SUMSQ);
    for (int rp_ = 0; rp_ < ((P0_REP & 1) ? 2 : 1); ++rp_)
    {
        LAS float* scr = (LAS float*)(F.lds + wave * 16384);
        constexpr int I_IN = (DM / 64) * (INC / 32), I_OUT = (DM / 64) * (DM / 32);
        for (int it = gw; it < I_IN + I_OUT; it += NGW) {
            if (it < I_IN) p0_transpose_item(F.in[IN_WIN], DM, INC, Win_t, 0, scr, it, lane);
            else p0_transpose_item(F.in[IN_WOUT], DM, DM, Wout_t, 0, scr, it - I_IN, lane);
        }
        const size_t nz = (size_t)(NP - INC) * DM * 2 / 16;
        GAS v4u* z = (GAS v4u*)(Win_t + (size_t)INC * DM);
        for (size_t i = gt; i < nz; i += NT) z[i] = (v4u){0u, 0u, 0u, 0u};
    }
    for (int rp_ = 0; rp_ < ((P0_REP & 2) ? 2 : 1); ++rp_)
    for (int m = gw; m < MIN_ROWS; m += NGW) {
        if (m < TR) rms_row_to_bf16(F.in[IN_X] + (size_t)m * DM, F.in[IN_N1G], U + (size_t)m * DM, lane);
        else if (m < TR + NMETA) rms_row_to_bf16(F.in[IN_META] + (size_t)(m - TR) * DM, F.in[IN_N1G], U + (size_t)m * DM, lane);
        else { GAS v4u* o = (GAS v4u*)(U + (size_t)m * DM) + lane;
#pragma unroll
            for (int j = 0; j < 4; ++j) o[64 * j] = (v4u){0u, 0u, 0u, 0u}; }
    }
#if TBL_FP6 && !GATHER_SLICED
    for (int rp_ = 0; rp_ < ((P0_REP & 4) ? 2 : 1); ++rp_)
    {
        unsigned char* T8D = F.ws + WS_TD; unsigned char* T8U = F.ws + WS_TU; float* SCL = (float*)(F.ws + WS_SCL);
        const float* g2 = F.in[IN_N2G];
        typedef float f32x16v __attribute__((ext_vector_type(16)));
        f32x4 nv[8];
        if (gw < 2 * NEXP) { const float* src = (gw >= NEXP ? F.in[IN_PU] + (size_t)(gw - NEXP) * DM : F.in[IN_PD] + (size_t)gw * DM) + lane * 4;
#pragma unroll
            for (int j = 0; j < 8; ++j) nv[j] = *(const GAS f32x4*)(src + 256 * j); }
#pragma unroll 1
        for (int row = gw; row < 2 * NEXP; row += NGW) {
            const bool up = row >= NEXP; const int e = up ? row - NEXP : row;
            f32x4 v[8]; float m = 0.f;
#pragma unroll
            for (int j = 0; j < 8; ++j) v[j] = nv[j];
            { const int nr = row + NGW < 2 * NEXP ? row + NGW : row; const float* src = (nr >= NEXP ? F.in[IN_PU] + (size_t)(nr - NEXP) * DM : F.in[IN_PD] + (size_t)nr * DM) + lane * 4;
#pragma unroll
              for (int j = 0; j < 8; ++j) nv[j] = *(const GAS f32x4*)(src + 256 * j); }
#pragma unroll
            for (int j = 0; j < 8; ++j) {
                f32x4 a = v[j];
                if (!up) a = a * *(const GAS f32x4*)(g2 + 256 * j + lane * 4);
                v[j] = a; m = fmaxf(m, fmaxf(fmaxf(fabsf(a.x), fabsf(a.y)), fmaxf(fabsf(a.z), fabsf(a.w))));
            }
#if TBL_FP4 && UP_TR
            if (up) {
                const float mr = wave_max(m); const float su = mr > 0.f ? mr * (1.0f / 7.0f) : 1.0f, inv = mr > 0.f ? 7.0f / mr : 0.f;
                v4u d;
#pragma unroll
                for (int w = 0; w < 4; ++w) { unsigned o = 0u;
#pragma unroll
                    for (int i = 7; i >= 0; --i) { const f32x4 vv = v[2 * w + (i >> 2)]; const float x_ = (i & 3) == 0 ? vv.x : (i & 3) == 1 ? vv.y : (i & 3) == 2 ? vv.z : vv.w;
                        o = (o << 4) | (__float_as_uint(x_ * inv + 12582912.0f) & 15u); }
                    d[w] = o; }
                *(GAS v4u*)(T8U + (size_t)e * ROWU + 16 * lane) = d;
                if (lane == 0) SCL[row] = su;
                continue;
            }
#endif
#if TBL_FP4
            {
                float bsf = m > 0.f ? m * (1.0f / 6.0f) : 1.0f;
                const unsigned bsb = (__float_as_uint(bsf) + 0xffffu) >> 16; bsf = __uint_as_float(bsb << 16);
                const float inv = 1.0f / bsf;
                v4u d;
#pragma unroll
                for (int w = 0; w < 4; ++w) { unsigned o = 0u;
                    o = __builtin_amdgcn_cvt_scalef32_pk_fp4_f32(o, v[2 * w].x * inv, v[2 * w].y * inv, 1.0f, 0);
                    o = __builtin_amdgcn_cvt_scalef32_pk_fp4_f32(o, v[2 * w].z * inv, v[2 * w].w * inv, 1.0f, 1);
                    o = __builtin_amdgcn_cvt_scalef32_pk_fp4_f32(o, v[2 * w + 1].x * inv, v[2 * w + 1].y * inv, 1.0f, 2);
                    o = __builtin_amdgcn_cvt_scalef32_pk_fp4_f32(o, v[2 * w + 1].z * inv, v[2 * w + 1].w * inv, 1.0f, 3);
                    d[w] = o; }
                unsigned char* dst = (up ? T8U : T8D) + (size_t)e * ROWB;
                *(GAS v4u*)(dst + 16 * lane) = d; *(GAS unsigned short*)(dst + 1024 + 2 * lane) = (unsigned short)bsb;
                continue;
            }
#endif
            m = wave_max(m);
            const float sc = m > 0.f ? 7.0f / m : 1.0f;
            f32x16v x0, x1;
#pragma unroll
            for (int j = 0; j < 8; ++j) { x0[2 * j] = v[j].x * sc; x1[2 * j] = v[j].y * sc; x0[2 * j + 1] = v[j].z * sc; x1[2 * j + 1] = v[j].w * sc; }
            const auto pk = __builtin_amdgcn_cvt_scalef32_2xpk16_fp6_f32(x0, x1, 1.0f);
            unsigned char* dst = (up ? T8U : T8D) + (size_t)e * 1536 + lane * 24;
            *(GAS u32x2*)(dst) = (u32x2){pk[0], pk[1]}; *(GAS u32x2*)(dst + 8) = (u32x2){pk[2], pk[3]}; *(GAS u32x2*)(dst + 16) = (u32x2){pk[4], pk[5]};
            if (lane == 0) SCL[row] = m > 0.f ? m * (1.0f / 7.0f) : 1.0f;
        }
    }
#else
    {
        unsigned char* T8D = F.ws + WS_TD; unsigned char* T8U = F.ws + WS_TU; float* SCL = (float*)(F.ws + WS_SCL);
        const float* g2 = F.in[IN_N2G];
        for (int row = gw; row < 2 * NEXP; row += NGW) {
            const bool up = row >= NEXP; const int e = up ? row - NEXP : row;
            const float* src = (up ? F.in[IN_PU] : F.in[IN_PD]) + (size_t)e * DM;
            f32x4 v[2][4]; float m = 0.f;
#pragma unroll
            for (int c = 0; c < 2; ++c)
#pragma unroll
                for (int j = 0; j < 4; ++j) {
                    const int col = c * 1024 + lane * 16 + j * 4;
                    f32x4 a = *(const GAS f32x4*)(src + col);
                    if (!up) a = a * *(const GAS f32x4*)(g2 + col);
                    v[c][j] = a; m = fmaxf(m, fmaxf(fmaxf(fabsf(a.x), fabsf(a.y)), fmaxf(fabsf(a.z), fabsf(a.w))));
                }
            m = wave_max(m);
            const float sc = m > 0.f ? 440.0f / m : 1.0f;
#pragma unroll
            for (int c = 0; c < 2; ++c) {
                v4u o; unsigned w;
                w = (unsigned)__builtin_amdgcn_cvt_pk_fp8_f32(v[c][0].x * sc, v[c][0].y * sc, 0, false); w = (unsigned)__builtin_amdgcn_cvt_pk_fp8_f32(v[c][0].z * sc, v[c][0].w * sc, (int)w, true); o.x = w;
                w = (unsigned)__builtin_amdgcn_cvt_pk_fp8_f32(v[c][1].x * sc, v[c][1].y * sc, 0, false); w = (unsigned)__builtin_amdgcn_cvt_pk_fp8_f32(v[c][1].z * sc, v[c][1].w * sc, (int)w, true); o.y = w;
                w = (unsigned)__builtin_amdgcn_cvt_pk_fp8_f32(v[c][2].x * sc, v[c][2].y * sc, 0, false); w = (unsigned)__builtin_amdgcn_cvt_pk_fp8_f32(v[c][2].z * sc, v[c][2].w * sc, (int)w, true); o.z = w;
                w = (unsigned)__builtin_amdgcn_cvt_pk_fp8_f32(v[c][3].x * sc, v[c][3].y * sc, 0, false); w = (unsigned)__builtin_amdgcn_cvt_pk_fp8_f32(v[c][3].z * sc, v[c][3].w * sc, (int)w, true); o.w = w;
#if GATHER_SLICED
                *(GAS v4u*)((up ? T8U : T8D) + (size_t)(4 * c + (lane >> 4)) * ((size_t)NEXP * 256) + (size_t)e * 256 + (lane & 15) * 16) = o;
#else
                *(GAS v4u*)((up ? T8U : T8D) + (size_t)e * DM + c * 1024 + lane * 16) = o;
#endif
            }
            if (lane == 0) SCL[row] = m > 0.f ? m * (1.0f / 440.0f) : 1.0f;
        }
    }
#endif
    {
        bf16* LWU = (bf16*)(F.ws + WS_LW); bf16* LWA = LWU + 1024 * 64; bf16* LWG = LWA + 1024 * 64;
        for (size_t i = gt; i < (size_t)1024 * 64; i += NT) { const int n = (int)(i >> 6), k = (int)(i & 63); LWU[i] = (bf16)f2bf(F.in[IN_WUP][k * 1024 + n]); LWA[i] = (bf16)f2bf(F.in[IN_AUP][k * 1024 + n]); }
        for (size_t i = gt; i < (size_t)1024 * 160; i += NT) { const int n = (int)(i / 160), k = (int)(i % 160); LWG[i] = (bf16)f2bf(F.in[IN_GUP][k * 1024 + n]); }
    }
    for (size_t i = gt; i < (size_t)TR; i += NT) sumsq[i] = 0.f;
    __syncthreads();
    for (int rp_ = 0; rp_ < ((P0_REP & 8) ? 2 : 1); ++rp_)
    {
        LAS float* sk = (LAS float*)F.lds;
        LAS float* wq = (LAS float*)(F.lds + 128 * 132 * 4);
        const float* PQ = F.in[IN_PQ]; const float* PSK = F.in[IN_PSK]; const float* g2 = F.in[IN_N2G];
        for (int unit = F.vcu; unit < 512; unit += F.G) {
            const int hc = unit >> 5, k0 = (unit & 31) * 64;
            for (int i = tid; i < 128 * 32; i += NTHR) { const int n = i >> 5, d4 = (i & 31) * 4; *(LAS f32x4*)(sk + n * 132 + d4) = *(const GAS f32x4*)(PSK + (size_t)hc * 16384 + n * 128 + d4); }
            for (int i = tid; i < 64 * 32; i += NTHR) { const int k = i >> 5, d4 = (i & 31) * 4; *(LAS f32x4*)(wq + k * 132 + d4) = *(const GAS f32x4*)(PQ + (size_t)(k0 + k) * DM + hc * 128 + d4); }
            __syncthreads();
            const int n4 = tid >> 4, k4 = tid & 15;
            float acc[4][4];
#pragma unroll
            for (int i = 0; i < 4; ++i)
#pragma unroll
                for (int j = 0; j < 4; ++j) acc[i][j] = 0.f;
            for (int d = 0; d < 128; d += 4) {
                f32x4 a[4], b[4];
#pragma unroll
                for (int i = 0; i < 4; ++i) a[i] = *(LAS f32x4*)(sk + (n4 + 32 * i) * 132 + d);
#pragma unroll
                for (int j = 0; j < 4; ++j) b[j] = *(LAS f32x4*)(wq + (k4 + 16 * j) * 132 + d);
#pragma unroll
                for (int i = 0; i < 4; ++i)
#pragma unroll
                    for (int j = 0; j < 4; ++j) acc[i][j] += (a[i].x * b[j].x + a[i].y * b[j].y) + (a[i].z * b[j].z + a[i].w * b[j].w);
            }
#pragma unroll
            for (int i = 0; i < 4; ++i)
#pragma unroll
                for (int j = 0; j < 4; ++j) { const int n = n4 + 32 * i, k = k0 + k4 + 16 * j; Wqs_t[(size_t)(hc * 128 + n) * DM + k] = (bf16)f2bf(acc[i][j] * g2[k]); }
            __syncthreads();
        }
    }
}

DI int attn_keyrow(int b, int n, int kk) {
    if (kk >= 128) return b * SEQ + 128 * n + (kk - 128);
    if (n > 0) return b * SEQ + 128 * (n - 1) + kk;
    return kk >= 112 ? TR + (kk - 112) : -1;
}
DI void attn_unit(Frame& F, int u) {
    const int tid = F.tid, lane = F.lane, wave = F.wave;
    const int b = u >> 6, kvh = (u >> 5) & 1, n = u & 31;
    const bf16* P = (const bf16*)(F.ws + WS_P); bf16* Y = (bf16*)(F.ws + WS_U);
    LAS bf16* Ks = (LAS bf16*)F.lds;
    LAS bf16* VT = (LAS bf16*)(F.lds + 256 * 144);
    const float* kg = F.in[IN_KG]; const float* qg = F.in[IN_QG];
    for (int c = tid; c < 2048; c += NTHR) {
        const int key = c >> 3, ch = c & 7; const int row = attn_keyrow(b, n, key);
        v4u rk = (v4u){0u, 0u, 0u, 0u}, rv = (v4u){0u, 0u, 0u, 0u};
        if (row >= 0) { rk = *(const GAS v4u*)(P + (size_t)row * NP + CK + kvh * 64 + ch * 8); rv = *(const GAS v4u*)(P + (size_t)row * NP + CV + kvh * 64 + ch * 8); }
        float kv[8] = {bflo(rk.x), bfhi(rk.x), bflo(rk.y), bfhi(rk.y), bflo(rk.z), bfhi(rk.z), bflo(rk.w), bfhi(rk.w)};
        float ss = 0.f;
#pragma unroll
        for (int e = 0; e < 8; ++e) ss += kv[e] * kv[e];
        ss = red8(ss);
        const float rs = 1.0f / sqrtf(ss * (1.0f / 64.0f) + RMS_EPS);
#pragma unroll
        for (int e = 0; e < 8; ++e) kv[e] = kv[e] * rs * kg[ch * 8 + e];
        v4u o; o.x = pk2(kv[0], kv[1]); o.y = pk2(kv[2], kv[3]); o.z = pk2(kv[4], kv[5]); o.w = pk2(kv[6], kv[7]);
        *(LAS v4u*)(Ks + key * 72 + ch * 8) = o;
        LAS bf16* vt = VT + (ch * 8) * 260 + key;
        vt[0 * 260] = (bf16)(rv.x & 0xffffu); vt[1 * 260] = (bf16)(rv.x >> 16); vt[2 * 260] = (bf16)(rv.y & 0xffffu); vt[3 * 260] = (bf16)(rv.y >> 16);
        vt[4 * 260] = (bf16)(rv.z & 0xffffu); vt[5 * 260] = (bf16)(rv.z >> 16); vt[6 * 260] = (bf16)(rv.w & 0xffffu); vt[7 * 260] = (bf16)(rv.w >> 16);
    }
    __syncthreads();
    const int r = lane & 31, hh = lane >> 5, hq = kvh * 8 + wave;
    const float sink = F.in[IN_SINK][hq];
#pragma unroll 1
    for (int qb = 0; qb < 4; ++qb) {
        const int qi = 32 * qb + r;
        const size_t qrow = (size_t)(b * SEQ + 128 * n + qi);
        bf16x8 qf[4];
        {
            v4u raw[4]; float ss = 0.f;
#pragma unroll
            for (int s4 = 0; s4 < 4; ++s4) {
                raw[s4] = *(const GAS v4u*)(P + qrow * NP + CQ + hq * 64 + 16 * s4 + 8 * hh);
                const float q0 = bflo(raw[s4].x), q1 = bfhi(raw[s4].x), q2 = bflo(raw[s4].y), q3 = bfhi(raw[s4].y), q4 = bflo(raw[s4].z), q5 = bfhi(raw[s4].z), q6 = bflo(raw[s4].w), q7 = bfhi(raw[s4].w);
                ss += (q0 * q0 + q1 * q1) + (q2 * q2 + q3 * q3) + (q4 * q4 + q5 * q5) + (q6 * q6 + q7 * q7);
            }
            ss += __shfl_xor(ss, 32);
            const float rs = 0.125f / sqrtf(ss * (1.0f / 64.0f) + RMS_EPS);
#pragma unroll
            for (int s4 = 0; s4 < 4; ++s4) {
                const float* gq = qg + 16 * s4 + 8 * hh;
                v4u w;
                w.x = pk2(bflo(raw[s4].x) * rs * gq[0], bfhi(raw[s4].x) * rs * gq[1]);
                w.y = pk2(bflo(raw[s4].y) * rs * gq[2], bfhi(raw[s4].y) * rs * gq[3]);
                w.z = pk2(bflo(raw[s4].z) * rs * gq[4], bfhi(raw[s4].z) * rs * gq[5]);
                w.w = pk2(bflo(raw[s4].w) * rs * gq[6], bfhi(raw[s4].w) * rs * gq[7]);
                qf[s4] = __builtin_bit_cast(bf16x8, w);
            }
        }
        f32x16 acc[5];
        float mx = sink;
#pragma unroll
        for (int j = 0; j < 5; ++j) {
            const int kt = qb + j;
#pragma unroll
            for (int g = 0; g < 16; ++g) acc[j][g] = 0.f;
#pragma unroll
            for (int s4 = 0; s4 < 4; ++s4) { const bf16x8 a = *(const LAS bf16x8*)(Ks + (32 * kt + r) * 72 + 16 * s4 + 8 * hh); acc[j] = MFMA32(a, qf[s4], acc[j]); }
#pragma unroll
            for (int g = 0; g < 16; ++g) {
                const int kk = 32 * kt + crow(g, hh);
                const bool valid = (kk < 128) ? (kk > qi && (n > 0 || kk >= 112)) : (kk - 128 <= qi);
                const float sv = valid ? acc[j][g] : -INFINITY;
                acc[j][g] = sv; mx = fmaxf(mx, sv);
            }
        }
        mx = fmaxf(mx, __shfl_xor(mx, 32));
        float l = 0.f;
#pragma unroll
        for (int j = 0; j < 5; ++j)
#pragma unroll
            for (int g = 0; g < 16; ++g) { const float p = __expf(acc[j][g] - mx); acc[j][g] = p; l += p; }
        l += __shfl_xor(l, 32);
        l += __expf(sink - mx);
        const float inv = 1.0f / l;
        f32x16 o[2];
#pragma unroll
        for (int g = 0; g < 16; ++g) { o[0][g] = 0.f; o[1][g] = 0.f; }
#pragma unroll
        for (int j = 0; j < 5; ++j) {
            const int kt = qb + j;
#pragma unroll
            for (int s2 = 0; s2 < 2; ++s2) {
                v4u w;
                w.x = pk2(acc[j][8 * s2 + 0], acc[j][8 * s2 + 1]); w.y = pk2(acc[j][8 * s2 + 2], acc[j][8 * s2 + 3]);
                w.z = pk2(acc[j][8 * s2 + 4], acc[j][8 * s2 + 5]); w.w = pk2(acc[j][8 * s2 + 6], acc[j][8 * s2 + 7]);
                const bf16x8 pb = __builtin_bit_cast(bf16x8, w);
#pragma unroll
                for (int dt = 0; dt < 2; ++dt) {
                    const LAS bf16* vp = VT + (32 * dt + r) * 260 + 32 * kt + 16 * s2 + 4 * hh;
                    const u32x2 lo = *(const LAS u32x2*)vp, hi = *(const LAS u32x2*)(vp + 8);
                    v4u av; av.x = lo.x; av.y = lo.y; av.z = hi.x; av.w = hi.y;
                    o[dt] = MFMA32(__builtin_bit_cast(bf16x8, av), pb, o[dt]);
                }
            }
        }
#pragma unroll
        for (int dt = 0; dt < 2; ++dt)
#pragma unroll
            for (int gg = 0; gg < 4; ++gg) {
                u32x2 w; w.x = pk2(o[dt][4 * gg + 0] * inv, o[dt][4 * gg + 1] * inv); w.y = pk2(o[dt][4 * gg + 2] * inv, o[dt][4 * gg + 3] * inv);
                *(GAS u32x2*)(Y + qrow * DM + 1024 + hq * 64 + 32 * dt + 8 * gg + 4 * hh) = w;
            }
    }
    __syncthreads();
}

constexpr int RC = 32;
DI int rwkv_row(int b, int sg) { return sg >= 32 ? b * SEQ + (sg - 32) : (sg >= 16 ? TR + (sg - 16) : -1); }
constexpr int RW_NCH = (32 + SEQ) / 32, RW_SEG0 = 33, RW_SEGN = 32;
DI void rwkv_pass1(Frame& F, int unit) {
    const int tid = F.tid, lane = F.lane, wave = F.wave;
    const int bh = unit & 63, seg = unit >> 6;
    const int b = bh >> 4, h = bh & 15;
    const int c_lo = seg == 0 ? 0 : RW_SEG0 + RW_SEGN * (seg - 1), c_hi = RW_SEG0 + RW_SEGN * seg;
    unsigned char* const blob0 = F.ws + WS_RW + (size_t)bh * RW_NCH * 16384;
    float* const HS = (float*)(F.ws + WS_RWS) + (size_t)(bh * 4 + seg) * 8192;
    const bf16* P = (const bf16*)(F.ws + WS_P); bf16* Y = (bf16*)(F.ws + WS_U);
    const bf16* LWU = (const bf16*)(F.ws + WS_LW); const bf16* LWA = LWU + 1024 * 64; const bf16* LWG = LWA + 1024 * 64;
    LAS float* XR = (LAS float*)(F.lds + 0);
    LAS float* XK = (LAS float*)(F.lds + 8192);
    LAS float* XV = (LAS float*)(F.lds + 16384);
    LAS float* LD = (LAS float*)(F.lds + 24576);
    LAS float* AA = (LAS float*)(F.lds + 32768);
    LAS float* GG = (LAS float*)(F.lds + 40960);
    LAS bf16* TW = (LAS bf16*)(F.lds + 57344);
    LAS bf16* XA = (LAS bf16*)(F.lds + 57344 + 4608);
    LAS bf16* SG = (LAS bf16*)(F.lds + 57344 + 9216);
    LAS bf16* At = (LAS bf16*)(F.lds + 57344);
    LAS bf16* Rt = At + 32 * 72; LAS bf16* Bt = Rt + 32 * 72; LAS bf16* Kt = Bt + 32 * 72;
    LAS bf16* BTt = (LAS bf16*)(F.lds + 77312);
    LAS bf16* KTt = BTt + 64 * 40; LAS bf16* VT = KTt + 64 * 40;
    LAS bf16* LAK = (LAS bf16*)(F.lds + 92672);
    LAS bf16* MRB = LAK + 32 * 40; LAS bf16* MRK = MRB + 32 * 40; LAS bf16* LAB = MRK + 32 * 40;
    LAS float* LAB32 = (LAS float*)(F.lds + 102912);
    LAS bf16* TJ = (LAS bf16*)(F.lds + 107520);
    LAS float* GAM = (LAS float*)(F.lds + 110080);
    LAS bf16* SwAll = (LAS bf16*)(F.lds + 118528);
    LAS bf16* USCAll = (LAS bf16*)(F.lds + 0);
    LAS bf16* UTAll = (LAS bf16*)(F.lds + 10240);
    LAS float* MUL = (LAS float*)(F.lds + 49152);
    LAS float* HC = (LAS float*)(F.lds + 49152 + 1920);
    LAS bf16* GUt = (LAS bf16*)(F.lds + 137984);
    __syncthreads();
    for (int i = tid; i < (110336 - 107520) / 4; i += NTHR) ((LAS unsigned*)(F.lds + 107520))[i] = 0u;
    if (tid < 480) { const int pc = tid >> 3, e = tid & 7; const int mui = pc < 8 ? h * 64 + pc * 8 : (pc < 16 ? 1024 + h * 64 + (pc - 8) * 8 : (pc < 24 ? 2048 + h * 64 + (pc - 16) * 8 : 3072 + (pc - 24) * 8)); MUL[tid] = F.in[IN_MU][mui + e]; }
    if (tid < 448) { const int q = tid >> 6, j = tid & 63; const float* src = q == 0 ? F.in[IN_W0] : (q == 1 ? F.in[IN_A0] : (q == 2 ? F.in[IN_KK] : (q == 3 ? F.in[IN_KA] : (q == 4 ? F.in[IN_RK] : (q == 5 ? F.in[IN_GNW] : F.in[IN_GNB]))))); HC[tid] = src[h * 64 + j]; }
    const int cw = wave & 3; const bool idw = wave >= 4;
    LAS bf16* Sw = SwAll + wave * 16 * 72; LAS bf16* USC = USCAll + wave * 16 * 40; LAS bf16* UT = UTAll + wave * 16 * 40;
    f32x4 accZ[4];
    {
        const int r16i = lane & 15, kqi = lane >> 4;
#pragma unroll
        for (int q = 0; q < 4; ++q) {
#pragma unroll
            for (int e = 0; e < 4; ++e) accZ[q][e] = (idw && (16 * q + 4 * kqi + e == 16 * cw + r16i)) ? 1.f : 0.f;
            *(LAS u32x2*)(Sw + r16i * 72 + 16 * q + 4 * kqi) = (u32x2){pk2(accZ[q][0], accZ[q][1]), pk2(accZ[q][2], accZ[q][3])};
        }
    }
    const int lmat = wave >> 1, lnt = wave & 1;
    bf16x8 bw[4];
    {
        const int r = lane & 31, hh = lane >> 5;
        const bf16* Bg = (lmat == 1 ? LWA : LWU) + (size_t)(h * 64 + 32 * lnt + r) * 64 + 8 * hh;
#pragma unroll
        for (int sx = 0; sx < 4; ++sx) bw[sx] = __builtin_bit_cast(bf16x8, *(const GAS v4u*)(Bg + 16 * sx));
    }
    for (int i = tid; i < 64 * 20; i += NTHR) { const int nn = i / 20, k8 = (i % 20) * 8; *(LAS v4u*)(GUt + nn * 168 + k8) = *(const GAS v4u*)(LWG + (size_t)(h * 64 + nn) * 160 + k8); }
    v4u pfc[4], pfp[4];
#define RW_PREFETCH(cc) do { _Pragma("unroll") for (int it = 0; it < 4; ++it) { const int pi = tid + NTHR * it; pfc[it] = (v4u){0u, 0u, 0u, 0u}; pfp[it] = (v4u){0u, 0u, 0u, 0u}; \
        if (pi < RC * 60) { int tt, pc; rw_piece(pi, tt, pc); const int col = pc < 8 ? CR + h * 64 + pc * 8 : (pc < 16 ? CPK + h * 64 + (pc - 8) * 8 : (pc < 24 ? CPV + h * 64 + (pc - 16) * 8 : CW + (pc - 24) * 8)); \
            const int sg = RC * (cc) + tt; const int row = rwkv_row(b, sg), rowp = rwkv_row(b, sg - 1); \
            if (row >= 0) pfc[it] = *(const GAS v4u*)(P + (size_t)row * NP + col); if (rowp >= 0) pfp[it] = *(const GAS v4u*)(P + (size_t)rowp * NP + col); } } } while (0)
    RW_PREFETCH(c_lo);
    __syncthreads();
    for (int c = c_lo; c < c_hi; ++c) {
        int tidv = tid; asm volatile("" : "+v"(tidv));
        const int lanev = tidv & 63; const int r16 = lanev & 15, kq = lanev >> 4;
#pragma unroll
        for (int it = 0; it < 4; ++it) {
            const int pi = tidv + NTHR * it;
            if (pi < RC * 60) {
                int tt, pc; rw_piece(pi, tt, pc);
                const v4u rc_ = pfc[it], rp_ = pfp[it];
                const float cu[8] = {bflo(rc_.x), bfhi(rc_.x), bflo(rc_.y), bfhi(rc_.y), bflo(rc_.z), bfhi(rc_.z), bflo(rc_.w), bfhi(rc_.w)};
                const float pr[8] = {bflo(rp_.x), bfhi(rp_.x), bflo(rp_.y), bfhi(rp_.y), bflo(rp_.z), bfhi(rp_.z), bflo(rp_.w), bfhi(rp_.w)};
                const f32x4 m0 = *(LAS f32x4*)(MUL + pc * 8), m1 = *(LAS f32x4*)(MUL + pc * 8 + 4);
                const float mv[8] = {m0.x, m0.y, m0.z, m0.w, m1.x, m1.y, m1.z, m1.w};
                float xs[8];
#pragma unroll
                for (int e = 0; e < 8; ++e) xs[e] = cu[e] + mv[e] * (pr[e] - cu[e]);
                if (pc < 24) {
                    LAS float* dst = (pc < 8 ? XR : (pc < 16 ? XK : XV)) + tt * 64 + (pc & 7) * 8;
                    *(LAS f32x4*)dst = (f32x4){xs[0], xs[1], xs[2], xs[3]}; *(LAS f32x4*)(dst + 4) = (f32x4){xs[4], xs[5], xs[6], xs[7]};
                } else if (pc < 32) {
                    v4u o; o.x = pk2(tanhf_(xs[0]), tanhf_(xs[1])); o.y = pk2(tanhf_(xs[2]), tanhf_(xs[3])); o.z = pk2(tanhf_(xs[4]), tanhf_(xs[5])); o.w = pk2(tanhf_(xs[6]), tanhf_(xs[7]));
                    *(LAS v4u*)(TW + tt * 72 + (pc - 24) * 8) = o;
                } else if (pc < 40) {
                    v4u o; o.x = pk2(xs[0], xs[1]); o.y = pk2(xs[2], xs[3]); o.z = pk2(xs[4], xs[5]); o.w = pk2(xs[6], xs[7]);
                    *(LAS v4u*)(XA + tt * 72 + (pc - 32) * 8) = o;
                } else {
                    v4u o; o.x = pk2(sigmoidf_(xs[0]), sigmoidf_(xs[1])); o.y = pk2(sigmoidf_(xs[2]), sigmoidf_(xs[3])); o.z = pk2(sigmoidf_(xs[4]), sigmoidf_(xs[5])); o.w = pk2(sigmoidf_(xs[6]), sigmoidf_(xs[7]));
                    *(LAS v4u*)(SG + tt * 168 + (pc - 40) * 8) = o;
                }
            }
        }
        if (c + 1 < c_hi) RW_PREFETCH(c + 1);
        LBAR();
        if (wave < 6) {
            const int r = lanev & 31, hh = lanev >> 5;
            const LAS bf16* Ab = lmat == 0 ? TW : (lmat == 1 ? XA : SG);
            const int sa = lmat == 2 ? 168 : 72;
            f32x16 acc;
#pragma unroll
            for (int g = 0; g < 16; ++g) acc[g] = 0.f;
            if (lmat == 2) {
#pragma unroll
                for (int sx = 0; sx < 10; ++sx) acc = MFMA32(*(const LAS bf16x8*)(Ab + r * sa + 16 * sx + 8 * hh), *(const LAS bf16x8*)(GUt + (32 * lnt + r) * 168 + 16 * sx + 8 * hh), acc);
            } else {
#pragma unroll
                for (int sx = 0; sx < 4; ++sx) acc = MFMA32(*(const LAS bf16x8*)(Ab + r * sa + 16 * sx + 8 * hh), bw[sx], acc);
            }
            const int nn = 32 * lnt + r;
            if (lmat == 0) {
                const float w0 = HC[nn];
                float ldv[16], rsum[4], osum[4];
#pragma unroll
                for (int g = 0; g < 16; ++g) { const float wl = w0 + acc[g]; const float wlog = -softplusf_(-wl) - 0.5f; ldv[g] = -__expf(wlog); }
#pragma unroll
                for (int gg = 0; gg < 4; ++gg) { rsum[gg] = (ldv[4 * gg] + ldv[4 * gg + 1]) + (ldv[4 * gg + 2] + ldv[4 * gg + 3]); osum[gg] = __shfl_xor(rsum[gg], 32); }
                float off = 0.f;
#pragma unroll
                for (int gg = 0; gg < 4; ++gg) {
                    float cs = off + (hh ? osum[gg] : 0.f);
#pragma unroll
                    for (int e = 0; e < 4; ++e) { cs += ldv[4 * gg + e]; LD[(8 * gg + 4 * hh + e) * 64 + nn] = cs; }
                    off += rsum[gg] + osum[gg];
                }
            } else if (lmat == 1) { const float a0 = HC[64 + nn];
#pragma unroll
                for (int g = 0; g < 16; ++g) AA[crow(g, hh) * 64 + nn] = sigmoidf_(a0 + acc[g]); }
            else {
#pragma unroll
                for (int g = 0; g < 16; ++g) GG[crow(g, hh) * 64 + nn] = acc[g]; }
        }
        LBAR();
        {
            const int tt = tidv >> 4, j0 = (tidv & 15) * 4;
            const f32x4 xk = *(LAS f32x4*)(XK + tt * 64 + j0), av = *(LAS f32x4*)(AA + tt * 64 + j0);
            const f32x4 kkw = *(LAS f32x4*)(HC + 128 + j0), kaw = *(LAS f32x4*)(HC + 192 + j0);
            f32x4 kr = xk * kkw;
            float ss = (kr.x * kr.x + kr.y * kr.y) + (kr.z * kr.z + kr.w * kr.w);
            ss = red16(ss);
            const float inv = frsq(fmaxf(ss, 1e-24f));
            const f32x4 kkv = kr * inv, bb = kkv * av, km = xk * (1.0f + (av - 1.0f) * kaw);
            *(LAS f32x4*)(XK + tt * 64 + j0) = km;
            const f32x4 cum = *(LAS f32x4*)(LD + tt * 64 + j0);
            f32x4 cx = (f32x4){0.f, 0.f, 0.f, 0.f}; if (tt > 0) cx = *(LAS f32x4*)(LD + (tt - 1) * 64 + j0);
            const f32x4 rr = *(LAS f32x4*)(XR + tt * 64 + j0), vv = *(LAS f32x4*)(XV + tt * 64 + j0);
            float ep[4], en[4], ex[4];
#pragma unroll
            for (int e = 0; e < 4; ++e) { ep[e] = __expf(cum[e]); en[e] = __expf(-cum[e]); ex[e] = __expf(cx[e]); }
            unsigned short a_[4], b_[4], k_[4], r_[4], v_[4];
#pragma unroll
            for (int e = 0; e < 4; ++e) { a_[e] = (unsigned short)f2bf(-kkv[e] * ex[e]); b_[e] = (unsigned short)f2bf(bb[e] * en[e]); k_[e] = (unsigned short)f2bf(km[e] * en[e]); r_[e] = (unsigned short)f2bf(rr[e] * ep[e]); v_[e] = (unsigned short)f2bf(vv[e]); }
            *(LAS u32x2*)(At + tt * 72 + j0) = (u32x2){(unsigned)a_[0] | ((unsigned)a_[1] << 16), (unsigned)a_[2] | ((unsigned)a_[3] << 16)};
            *(LAS u32x2*)(Bt + tt * 72 + j0) = (u32x2){(unsigned)b_[0] | ((unsigned)b_[1] << 16), (unsigned)b_[2] | ((unsigned)b_[3] << 16)};
            *(LAS u32x2*)(Kt + tt * 72 + j0) = (u32x2){(unsigned)k_[0] | ((unsigned)k_[1] << 16), (unsigned)k_[2] | ((unsigned)k_[3] << 16)};
            *(LAS u32x2*)(Rt + tt * 72 + j0) = (u32x2){(unsigned)r_[0] | ((unsigned)r_[1] << 16), (unsigned)r_[2] | ((unsigned)r_[3] << 16)};
#pragma unroll
            for (int e = 0; e < 4; ++e) { BTt[(j0 + e) * 40 + tt] = b_[e]; KTt[(j0 + e) * 40 + tt] = k_[e]; VT[(j0 + e) * 40 + tt] = v_[e]; }
            if (tt == RC - 1) *(LAS f32x4*)(GAM + j0) = (f32x4){ep[0], ep[1], ep[2], ep[3]};
            const f32x4 gg = *(LAS f32x4*)(GG + tt * 64 + j0);
            const f32x4 rk = *(LAS f32x4*)(HC + 256 + j0), gw = *(LAS f32x4*)(HC + 320 + j0), gb = *(LAS f32x4*)(HC + 384 + j0);
            const f32x4 t3 = rr * km * rk;
            const float bonus = red16((t3.x + t3.y) + (t3.z + t3.w));
            {
                unsigned char* blob = blob0 + (size_t)c * 16384;
                const f32x4 g1 = gw * gg, e1 = (gb + vv * bonus) * gg;
                *(GAS u32x2*)(blob + 8192 + (tt * 64 + j0) * 2) = (u32x2){pk2(g1.x, g1.y), pk2(g1.z, g1.w)};
                *(GAS u32x2*)(blob + 12288 + (tt * 64 + j0) * 2) = (u32x2){pk2(e1.x, e1.y), pk2(e1.z, e1.w)};
            }
        }
        LBAR();
        if (wave < 4) {
            const int r = lanev & 31, hh = lanev >> 5;
            const LAS bf16* Aimg = (wave == 0 || wave == 2) ? Kt : Bt;
            const LAS bf16* Bimg = (wave == 0 || wave == 3) ? At : Rt;
            LAS bf16* Oimg = wave == 0 ? LAK : (wave == 1 ? MRB : (wave == 2 ? MRK : LAB));
            const bool incl = (wave == 1 || wave == 2);
            f32x16 acc;
#pragma unroll
            for (int g = 0; g < 16; ++g) acc[g] = 0.f;
#pragma unroll
            for (int s = 0; s < 4; ++s) {
                const bf16x8 a = *(const LAS bf16x8*)(Aimg + r * 72 + 16 * s + 8 * hh);
                const bf16x8 bq = *(const LAS bf16x8*)(Bimg + r * 72 + 16 * s + 8 * hh);
                acc = MFMA32(a, bq, acc);
            }
            const int t = r;
#pragma unroll
            for (int gg = 0; gg < 4; ++gg) {
                float x[4];
#pragma unroll
                for (int e = 0; e < 4; ++e) { const int tau = 8 * gg + 4 * hh + e; const bool keep = incl ? (tau <= t) : (tau < t); x[e] = keep ? acc[4 * gg + e] : 0.f; }
                *(LAS u32x2*)(Oimg + t * 40 + 8 * gg + 4 * hh) = (u32x2){pk2(x[0], x[1]), pk2(x[2], x[3])};
                if (wave == 3) *(LAS f32x4*)(LAB32 + t * 36 + 8 * gg + 4 * hh) = (f32x4){x[0], x[1], x[2], x[3]};
            }
        }
        LBAR();
        f32x4 accN[2], accY[2];
        if (wave == 4) {
            const int blk = (lanev >> 4) & 1, cc = lanev & 15;
            const LAS float* Lb = LAB32 + (16 * blk) * 36 + 16 * blk;
            float Tc[16];
            f32x4 ln[4];
#pragma unroll
            for (int q = 0; q < 4; ++q) ln[q] = *(const LAS f32x4*)(Lb + 1 * 36 + 4 * q);
            Tc[0] = (cc == 0) ? 1.f : 0.f;
#pragma unroll
            for (int t = 1; t < 16; ++t) {
                f32x4 lc[4];
#pragma unroll
                for (int q = 0; q < 4; ++q) lc[q] = ln[q];
                if (t + 1 < 16) {
#pragma unroll
                    for (int q = 0; q < 4; ++q) if (4 * q < t + 1) ln[q] = *(const LAS f32x4*)(Lb + (t + 1) * 36 + 4 * q);
                }
                float s0 = (t == cc) ? 1.f : 0.f, s1 = 0.f, s2 = 0.f, s3 = 0.f;
#pragma unroll
                for (int tau = 0; tau < t; ++tau) { const float pr_ = lc[tau >> 2][tau & 3] * Tc[tau]; if ((tau & 3) == 0) s0 += pr_; else if ((tau & 3) == 1) s1 += pr_; else if ((tau & 3) == 2) s2 += pr_; else s3 += pr_; }
                Tc[t] = (s0 + s1) + (s2 + s3);
            }
            if (lanev < 32) {
#pragma unroll
                for (int t = 0; t < 16; ++t) TJ[blk * 640 + t * 40 + cc] = (unsigned short)f2bf(Tc[t]);
            }
        }
        const bf16x8 bzero = (bf16x8){0, 0, 0, 0, 0, 0, 0, 0};
        {
#pragma unroll
            for (int m = 0; m < 2; ++m) {
                f32x4 an = (f32x4){0.f, 0.f, 0.f, 0.f}, ay = (f32x4){0.f, 0.f, 0.f, 0.f};
#pragma unroll
                for (int ks = 0; ks < 2; ++ks) {
                    const bf16x8 sb_ = *(const LAS bf16x8*)(Sw + r16 * 72 + 32 * ks + 8 * kq);
                    an = MFMA16(*(const LAS bf16x8*)(At + (16 * m + r16) * 72 + 32 * ks + 8 * kq), sb_, an);
                    ay = MFMA16(*(const LAS bf16x8*)(Rt + (16 * m + r16) * 72 + 32 * ks + 8 * kq), sb_, ay);
                }
                const bf16x8 vb = idw ? bzero : *(const LAS bf16x8*)(VT + (16 * cw + r16) * 40 + 8 * kq);
                an = MFMA16(*(const LAS bf16x8*)(LAK + (16 * m + r16) * 40 + 8 * kq), vb, an);
                ay = MFMA16(*(const LAS bf16x8*)(MRK + (16 * m + r16) * 40 + 8 * kq), vb, ay);
                accN[m] = an; accY[m] = ay;
            }
        }
        LBAR();
        {
            const f32x4 z4 = (f32x4){0.f, 0.f, 0.f, 0.f};
            *(LAS u32x2*)(USC + r16 * 40 + 16 + 4 * kq) = (u32x2){0u, 0u};
            *(LAS u32x2*)(USC + r16 * 40 + 4 * kq) = (u32x2){pk2(accN[0][0], accN[0][1]), pk2(accN[0][2], accN[0][3])};
            LDS_WAIT();
            f32x4 u0 = MFMA16(*(const LAS bf16x8*)(TJ + r16 * 40 + 8 * kq), *(const LAS bf16x8*)(USC + r16 * 40 + 8 * kq), z4);
            {
                const u32x2 uw = (u32x2){pk2(u0[0], u0[1]), pk2(u0[2], u0[3])};
                LDS_WAIT();
                *(LAS u32x2*)(USC + r16 * 40 + 4 * kq) = uw; *(LAS u32x2*)(UT + r16 * 40 + 4 * kq) = uw;
            }
            LDS_WAIT();
            f32x4 n1 = MFMA16(*(const LAS bf16x8*)(LAB + (16 + r16) * 40 + 8 * kq), *(const LAS bf16x8*)(USC + r16 * 40 + 8 * kq), accN[1]);
            LDS_WAIT();
            *(LAS u32x2*)(USC + r16 * 40 + 4 * kq) = (u32x2){pk2(n1[0], n1[1]), pk2(n1[2], n1[3])};
            LDS_WAIT();
            f32x4 u1 = MFMA16(*(const LAS bf16x8*)(TJ + 640 + r16 * 40 + 8 * kq), *(const LAS bf16x8*)(USC + r16 * 40 + 8 * kq), z4);
            *(LAS u32x2*)(UT + r16 * 40 + 16 + 4 * kq) = (u32x2){pk2(u1[0], u1[1]), pk2(u1[2], u1[3])};
            LDS_WAIT();
            const bf16x8 ub = *(const LAS bf16x8*)(UT + r16 * 40 + 8 * kq);
            const bf16x8 vb = idw ? bzero : *(const LAS bf16x8*)(VT + (16 * cw + r16) * 40 + 8 * kq);
            unsigned char* blob = blob0 + (size_t)c * 16384;
#pragma unroll
            for (int m = 0; m < 2; ++m) {
                const f32x4 yv = MFMA16(*(const LAS bf16x8*)(MRB + (16 * m + r16) * 40 + 8 * kq), ub, accY[m]);
                if (!idw) *(GAS u32x2*)(blob + ((cw * 2 + m) * 64 + lanev) * 8) = (u32x2){pk2(yv[0], yv[1]), pk2(yv[2], yv[3])};
                else {
#pragma unroll
                    for (int e = 0; e < 4; ++e) *(GAS unsigned short*)(blob + 4096 + ((16 * m + 4 * kq + e) * 64 + 16 * cw + r16) * 2) = (unsigned short)f2bf(yv[e]);
                }
            }
#pragma unroll
            for (int jt = 0; jt < 4; ++jt) {
                f32x4 zz = MFMA16(*(const LAS bf16x8*)(BTt + (16 * jt + r16) * 40 + 8 * kq), ub, accZ[jt]);
                zz = MFMA16(*(const LAS bf16x8*)(KTt + (16 * jt + r16) * 40 + 8 * kq), vb, zz);
                const f32x4 gm = *(const LAS f32x4*)(GAM + 16 * jt + 4 * kq);
                zz = zz * gm; accZ[jt] = zz;
                *(LAS u32x2*)(Sw + r16 * 72 + 16 * jt + 4 * kq) = (u32x2){pk2(zz[0], zz[1]), pk2(zz[2], zz[3])};
            }
        }
        LBAR();
    }
    {
        const int r16 = lane & 15, kq = lane >> 4;
#pragma unroll
        for (int jt = 0; jt < 4; ++jt) {
            if (!idw) *(GAS f32x4*)(HS + (16 * cw + r16) * 64 + 16 * jt + 4 * kq) = accZ[jt];
            else {
#pragma unroll
                for (int e = 0; e < 4; ++e) HS[4096 + (16 * jt + 4 * kq + e) * 64 + 16 * cw + r16] = accZ[jt][e];
            }
        }
    }
    __syncthreads();
}


DI void rwkv_pass2(Frame& F, int unit) {
    const int tid = F.tid, lane = F.lane, wave = F.wave;
    const int bh = unit & 63, seg = unit >> 6;
    const int b = bh >> 4, h = bh & 15;
    const int c_lo = seg == 0 ? 0 : RW_SEG0 + RW_SEGN * (seg - 1), c_hi = RW_SEG0 + RW_SEGN * seg;
    const unsigned char* const blob0 = F.ws + WS_RW + (size_t)bh * RW_NCH * 16384;
    const float* const HS0 = (const float*)(F.ws + WS_RWS) + (size_t)(bh * 4) * 8192;
    bf16* Y = (bf16*)(F.ws + WS_U);
    LAS float* ZA = (LAS float*)(F.lds + 0);
    LAS float* ZB = (LAS float*)(F.lds + 17408);
    LAS float* GL = (LAS float*)(F.lds + 34816);
    LAS bf16* SIN = (LAS bf16*)(F.lds + 52224);
    LAS float* YY = (LAS float*)(F.lds + 61440);
    __syncthreads();
    if (seg > 0) {
        for (int i = tid; i < 64 * 16; i += NTHR) { const int r = i >> 4, c4 = (i & 15) * 4; *(LAS f32x4*)(ZA + r * 68 + c4) = *(const GAS f32x4*)(HS0 + r * 64 + c4); }
        LAS float* zc = ZA; LAS float* zn = ZB;
        for (int sx = 1; sx < seg; ++sx) {
            for (int i = tid; i < 64 * 16; i += NTHR) { const int r = i >> 4, c4 = (i & 15) * 4; *(LAS f32x4*)(GL + r * 68 + c4) = *(const GAS f32x4*)(HS0 + (size_t)sx * 8192 + 4096 + r * 64 + c4); }
            __syncthreads();
            const int i = tid >> 3, j0 = (tid & 7) * 8;
            float acc[8];
#pragma unroll
            for (int e = 0; e < 8; ++e) acc[e] = HS0[(size_t)sx * 8192 + i * 64 + j0 + e];
            for (int m = 0; m < 64; m += 4) {
                const f32x4 z = *(LAS f32x4*)(zc + i * 68 + m);
#pragma unroll
                for (int e = 0; e < 8; ++e) { const f32x4 gv = *(LAS f32x4*)(GL + (j0 + e) * 68 + m); acc[e] += (z.x * gv.x + z.y * gv.y) + (z.z * gv.z + z.w * gv.w); }
            }
#pragma unroll
            for (int e = 0; e < 8; ++e) zn[i * 68 + j0 + e] = acc[e];
            __syncthreads();
            LAS float* t_ = zc; zc = zn; zn = t_;
        }
        __syncthreads();
        for (int i = tid; i < 64 * 16; i += NTHR) { const int r = i >> 4, c4 = (i & 15) * 4; const f32x4 z = *(LAS f32x4*)(zc + r * 68 + c4); *(LAS u32x2*)(SIN + r * 72 + c4) = (u32x2){pk2(z.x, z.y), pk2(z.z, z.w)}; }
        __syncthreads();
    }
    const int r16 = lane & 15, kq = lane >> 4, ct = wave & 3, m2 = wave >> 2;
    const int tt = tid >> 4, i0 = (tid & 15) * 4;
    u32x2 pyl, pg1, pe1; v4u pyh[2];
#define RW2_LOAD(cc) do { const unsigned char* bl_ = blob0 + (size_t)(cc) * 16384; pyl = *(const GAS u32x2*)(bl_ + ((ct * 2 + m2) * 64 + lane) * 8); \
        pyh[0] = *(const GAS v4u*)(bl_ + 4096 + ((16 * m2 + r16) * 64 + 8 * kq) * 2); pyh[1] = *(const GAS v4u*)(bl_ + 4096 + ((16 * m2 + r16) * 64 + 32 + 8 * kq) * 2); \
        pg1 = *(const GAS u32x2*)(bl_ + 8192 + (tt * 64 + i0) * 2); pe1 = *(const GAS u32x2*)(bl_ + 12288 + (tt * 64 + i0) * 2); } while (0)
    RW2_LOAD(c_lo);
    for (int c = c_lo; c < c_hi; ++c) {
        f32x4 acc = (f32x4){bflo(pyl.x), bfhi(pyl.x), bflo(pyl.y), bfhi(pyl.y)};
        const v4u yh0 = pyh[0], yh1 = pyh[1]; const u32x2 g1w = pg1, e1w = pe1;
        if (c + 1 < c_hi) RW2_LOAD(c + 1);
        if (seg > 0) {
            acc = MFMA16(__builtin_bit_cast(bf16x8, yh0), *(const LAS bf16x8*)(SIN + (16 * ct + r16) * 72 + 8 * kq), acc);
            acc = MFMA16(__builtin_bit_cast(bf16x8, yh1), *(const LAS bf16x8*)(SIN + (16 * ct + r16) * 72 + 32 + 8 * kq), acc);
        }
        LAS float* yb = YY + (c & 1) * 2048;
#pragma unroll
        for (int e = 0; e < 4; ++e) yb[(16 * m2 + 4 * kq + e) * 64 + 16 * ct + r16] = acc[e];
        LBAR();
        {
            const f32x4 y4 = *(LAS f32x4*)(yb + tt * 64 + i0);
            const float mean = red16((y4.x + y4.y) + (y4.z + y4.w)) * (1.0f / 64.0f);
            const f32x4 d = y4 - mean;
            const float var = red16((d.x * d.x + d.y * d.y) + (d.z * d.z + d.w * d.w)) * (1.0f / 64.0f);
            const float rstd = frsq(var + GN_EPS);
            const f32x4 g1 = (f32x4){bflo(g1w.x), bfhi(g1w.x), bflo(g1w.y), bfhi(g1w.y)}, e1 = (f32x4){bflo(e1w.x), bfhi(e1w.x), bflo(e1w.y), bfhi(e1w.y)};
            const f32x4 ov = (d * rstd) * g1 + e1;
            const int sg = RC * c + tt;
            if (sg >= 32) { u32x2 w; w.x = pk2(ov.x, ov.y); w.y = pk2(ov.z, ov.w); *(GAS u32x2*)(Y + (size_t)(b * SEQ + sg - 32) * DM + h * 64 + i0) = w; }
        }
    }
    __syncthreads();
}

DI int f2key(float f) { const int b = __float_as_int(f); return b ^ ((b >> 31) & 0x7fffffff); }
DI float key2f(int k) { return __int_as_float(k ^ ((k >> 31) & 0x7fffffff)); }
template <int CTRL> DI int dppi(int v) { return __builtin_amdgcn_update_dpp(0, v, CTRL, 0xf, 0xf, true); }
DI int imax2(int a, int b) { return a > b ? a : b; }
DI int imin2(int a, int b) { return a < b ? a : b; }
DI int imax16(int v) { v = imax2(v, dppi<0xB1>(v)); v = imax2(v, dppi<0x4E>(v)); v = imax2(v, dppi<0x141>(v)); v = imax2(v, dppi<0x140>(v)); return v; }
constexpr int KMIN = -2147483647 - 1;
#define CEX(a, b) do { const int lo_ = imin2(a, b), hi_ = imax2(a, b); a = hi_; b = lo_; } while (0)
DI int top16_of8(int (&x)[8], int l16) {
    CEX(x[0], x[1]); CEX(x[2], x[3]); CEX(x[4], x[5]); CEX(x[6], x[7]);
    CEX(x[0], x[2]); CEX(x[1], x[3]); CEX(x[4], x[6]); CEX(x[5], x[7]);
    CEX(x[1], x[2]); CEX(x[5], x[6]); CEX(x[0], x[4]); CEX(x[3], x[7]);
    CEX(x[1], x[5]); CEX(x[2], x[6]);
    CEX(x[1], x[4]); CEX(x[3], x[6]);
    CEX(x[2], x[4]); CEX(x[3], x[5]);
    CEX(x[3], x[4]);
    int res = KMIN;
#pragma unroll
    for (int k = 0; k < 16; ++k) {
        const int m = imax16(x[0]);
        const bool hit = x[0] == m;
#pragma unroll
        for (int q = 0; q < 7; ++q) x[q] = hit ? x[q + 1] : x[q];
        x[7] = hit ? KMIN : x[7];
        res = (l16 == k) ? m : res;
    }
    return res;
}
DI int top16_of4(int (&x)[4], int l16) {
    CEX(x[0], x[1]); CEX(x[2], x[3]); CEX(x[0], x[2]); CEX(x[1], x[3]); CEX(x[1], x[2]);
    int res = KMIN;
#pragma unroll
    for (int k = 0; k < 16; ++k) {
        const int m = imax16(x[0]);
        const bool hit = x[0] == m;
        x[0] = hit ? x[1] : x[0]; x[1] = hit ? x[2] : x[1]; x[2] = hit ? x[3] : x[2]; x[3] = hit ? KMIN : x[3];
        res = (l16 == k) ? m : res;
    }
    return res;
}
DI void topk_setup(LAS unsigned char* TAB, int lane) {
    {
        unsigned char v = 0xFF; int q = lane, i = 0;
#pragma unroll
        for (int ii = 0; ii < 16; ++ii) { const int cnt = 16 / (ii + 1); if (i == ii) { if (q < cnt) { v = (unsigned char)((ii << 4) | q); i = 99; } else { q -= cnt; i = ii + 1; } } }
        TAB[lane] = v;
    }
    asm volatile("s_waitcnt lgkmcnt(0)" ::: "memory");
}
DI void topk_pass(const float* SC, int t, int pass, int lane, LAS int* KA, LAS int* KB, int& eidx, float& gate) {
    const int g = lane >> 4, l16 = lane & 15;
    const LAS unsigned char* TAB = (const LAS unsigned char*)(KA + 128);
    const int hd = 4 * pass + g;
    const float* srow = SC + (size_t)t * DM + hd * 256 + 8 * l16;
    const f32x4 a0 = *(const GAS f32x4*)(srow), a1 = *(const GAS f32x4*)(srow + 4), b0 = *(const GAS f32x4*)(srow + 128), b1 = *(const GAS f32x4*)(srow + 132);
    int xa[8], xb[8];
#pragma unroll
    for (int q = 0; q < 4; ++q) { xa[q] = (f2key(a0[q]) & ~0x7F) | (8 * l16 + q); xa[4 + q] = (f2key(a1[q]) & ~0x7F) | (8 * l16 + 4 + q);
                                  xb[q] = (f2key(b0[q]) & ~0x7F) | (8 * l16 + q); xb[4 + q] = (f2key(b1[q]) & ~0x7F) | (8 * l16 + 4 + q); }
    const int ra = top16_of8(xa, l16), rb = top16_of8(xb, l16);
    KA[g * 16 + l16] = ra; KB[g * 16 + l16] = rb;
    asm volatile("s_waitcnt lgkmcnt(0)" ::: "memory");
    int cs[4];
#pragma unroll
    for (int e = 0; e < 4; ++e) {
        const int ij = TAB[4 * l16 + e]; const int ka = KA[g * 16 + ((ij >> 4) & 15)], kb = KB[g * 16 + (ij & 15)];
        const float sv = key2f(ka & ~0x7F) + key2f(kb & ~0x7F);
        cs[e] = (ij == 0xFF) ? KMIN : ((f2key(sv) & ~0xFF) | ij);
    }
    const int rc = top16_of4(cs, l16);
    const int ij = rc & 0xFF;
    const int ia = KA[g * 16 + (ij >> 4)] & 0x7F, ib = KB[g * 16 + (ij & 15)] & 0x7F;
    const float sv = key2f(rc & ~0xFF);
    const float smax = key2f(imax16(rc) & ~0xFF);
    const float ex = __expf(sv - smax);
    const float sum = red16(ex);
    eidx = ia * 128 + ib; gate = ex * frcp(sum);
    asm volatile("s_waitcnt lgkmcnt(0)" ::: "memory");
}
#ifndef FUSE_TOPK
#define FUSE_TOPK 1
#endif
DI void topk_phase(Frame& F) {
    const int lane = F.lane, wave = F.wave;
    const int gw = F.vcu * NWAVES + wave, NGW = F.G * NWAVES;
    const float* SC = (const float*)(F.ws + WS_SC); int* IDX = (int*)(F.ws + WS_IDX); float* GATE = (float*)(F.ws + WS_GATE);
    LAS int* KA = (LAS int*)(F.lds + wave * 1024); LAS int* KB = KA + 64;
    topk_setup((LAS unsigned char*)(F.lds + wave * 1024 + 512), lane);
    for (int t = gw; t < TR; t += NGW) {
#pragma unroll 1
        for (int pass = 0; pass < 2; ++pass) {
            int e; float gt; topk_pass(SC, t, pass, lane, KA, KB, e, gt);
            IDX[(size_t)t * NSEL + 64 * pass + lane] = e; GATE[(size_t)t * NSEL + 64 * pass + lane] = gt;
        }
    }
}

typedef float f32x2v __attribute__((ext_vector_type(2)));
typedef int v2i_t __attribute__((ext_vector_type(2)));
#ifndef GATHER_NT
#define GATHER_NT 0
#endif
#if GATHER_NT
#define G_LD(p) __builtin_nontemporal_load(p)
#else
#define G_LD(p) (*(p))
#endif
#if TBL_FP4
typedef unsigned v4u8 __attribute__((ext_vector_type(4), aligned(8)));
typedef unsigned u32x6v __attribute__((ext_vector_type(6)));
struct Row6 { v4u a; unsigned s; };
#define G_ISSUE(buf, gb) do { const int tb_ = (gb) < 32 ? 0 : (int)(WS_TU - WS_TD); const int kb_ = ((gb) & 31) * 4; \
    _Pragma("unroll") for (int q = 0; q < 4; ++q) { const int k_ = kb_ + q; const int e_ = __builtin_amdgcn_readlane(k_ < 64 ? id0 : id1, k_ & 63); \
        const int so_ = tb_ + e_ * ROWB; buf[q].a = __builtin_amdgcn_raw_buffer_load_b128(trs, (int)lo16, so_, 0); buf[q].s = __builtin_amdgcn_raw_buffer_load_b16(trs, (int)lo2, so_, 0); } } while (0)
#define G_DEC4(r, y_) do { _Pragma("unroll") for (int w_ = 0; w_ < 4; ++w_) { \
    { const auto f_ = __builtin_amdgcn_cvt_scalef32_pk_f32_fp4((r).a[w_], 1.0f, 0); y_[8 * w_ + 0] = f_[0]; y_[8 * w_ + 1] = f_[1]; } \
    { const auto f_ = __builtin_amdgcn_cvt_scalef32_pk_f32_fp4((r).a[w_], 1.0f, 1); y_[8 * w_ + 2] = f_[0]; y_[8 * w_ + 3] = f_[1]; } \
    { const auto f_ = __builtin_amdgcn_cvt_scalef32_pk_f32_fp4((r).a[w_], 1.0f, 2); y_[8 * w_ + 4] = f_[0]; y_[8 * w_ + 5] = f_[1]; } \
    { const auto f_ = __builtin_amdgcn_cvt_scalef32_pk_f32_fp4((r).a[w_], 1.0f, 3); y_[8 * w_ + 6] = f_[0]; y_[8 * w_ + 7] = f_[1]; } } } while (0)
typedef __bf16 bf16x2p __attribute__((ext_vector_type(2)));
#define G_D2(w_, bs_, acc_) acc_ = __builtin_amdgcn_fdot2_f32_bf16(__builtin_amdgcn_cvt_scalef32_pk_bf16_fp4(rr_.a[w_], 1.0f, bs_), __builtin_bit_cast(bf16x2p, xr[4 * (w_) + (bs_)]), acc_, false)
#define G_PART(buf, j0) do { _Pragma("unroll") for (int q = 0; q < 4; ++q) { const Row6 rr_ = buf[q]; float s_ = 0.f; \
        _Pragma("unroll") for (int w = 0; w < 4; ++w) { G_D2(w, 0, s_); G_D2(w, 1, s_); G_D2(w, 2, s_); G_D2(w, 3, s_); } \
        pp[(j0) + q] = s_ * __uint_as_float(rr_.s << 16); } } while (0)
#define G_RED16(G) do { \
    _Pragma("unroll") for (int i = 0; i < 8; ++i) { const auto r_ = __builtin_amdgcn_permlane32_swap(__float_as_uint(pp[i]), __float_as_uint(pp[i + 8]), false, false); pp[i] = __uint_as_float(r_[0]) + __uint_as_float(r_[1]); } \
    _Pragma("unroll") for (int i = 0; i < 4; ++i) { const auto r_ = __builtin_amdgcn_permlane16_swap(__float_as_uint(pp[i]), __float_as_uint(pp[i + 4]), false, false); pp[i] = __uint_as_float(r_[0]) + __uint_as_float(r_[1]); } \
    { const bool b3_ = (lane & 8) != 0; _Pragma("unroll") for (int i = 0; i < 2; ++i) { const float keep_ = b3_ ? pp[i + 2] : pp[i], send_ = b3_ ? pp[i] : pp[i + 2]; pp[i] = keep_ + dppf<0x128>(send_); } } \
    { const bool b2_ = (lane & 4) != 0; const float keep_ = b2_ ? pp[1] : pp[0], send_ = b2_ ? pp[0] : pp[1]; pp[0] = keep_ + dppf<0x141>(send_); } \
    float tot_ = pp[0]; tot_ += dppf<0xB1>(tot_); tot_ += dppf<0x4E>(tot_); \
    if ((lane & 3) == ((G) & 3)) { if ((G) < 4) hv0 = tot_; else hv1 = tot_; } } while (0)
#define G_DOWN(buf, b) do { float p_[4]; \
    _Pragma("unroll") for (int q = 0; q < 4; ++q) { const Row6 rr_ = buf[q]; float s0_ = 0.f, s1_ = 0.f, s2_ = 0.f, s3_ = 0.f; \
        _Pragma("unroll") for (int w = 0; w < 4; ++w) { G_D2(w, 0, s0_); G_D2(w, 1, s1_); G_D2(w, 2, s2_); G_D2(w, 3, s3_); } \
        p_[q] = ((s0_ + s1_) + (s2_ + s3_)) * __uint_as_float(rr_.s << 16); } \
    { const bool h5_ = (lane & 32) != 0; _Pragma("unroll") for (int i = 0; i < 2; ++i) { const float keep_ = h5_ ? p_[i + 2] : p_[i], send_ = h5_ ? p_[i] : p_[i + 2]; p_[i] = keep_ + __shfl_xor(send_, 32); } } \
    { const bool h4_ = (lane & 16) != 0; const float keep_ = h4_ ? p_[1] : p_[0], send_ = h4_ ? p_[0] : p_[1]; p_[0] = keep_ + __shfl_xor(send_, 16); } \
    const float tot_ = red16(p_[0]); \
    if ((lane & 15) == ((b) & 15)) { if ((b) < 16) hv0 = tot_; else hv1 = tot_; } } while (0)
#define G_UP(buf, b) do { _Pragma("unroll") for (int q = 0; q < 4; ++q) { Row6 rr_ = buf[q]; asm volatile("" : "+v"(rr_.a) : "v"(acc[0]), "v"(acc[31]));        \
        const float ck_ = rdlane((b) < 16 ? c0 : c1, 16 * ((b) & 3) + 4 * q + (((b) >> 2) & 3)) * __uint_as_float(rr_.s << 16); float y_[32]; G_DEC4(rr_, y_); \
        _Pragma("unroll") for (int i = 0; i < 32; ++i) acc[i] += ck_ * y_[i]; } } while (0)
DI void fp8x4_f32(unsigned w, float& a, float& b, float& c, float& d) { const auto lo = __builtin_amdgcn_cvt_pk_f32_fp8((int)w, false); const auto hi = __builtin_amdgcn_cvt_pk_f32_fp8((int)w, true); a = lo[0]; b = lo[1]; c = hi[0]; d = hi[1]; }
#elif TBL_FP6
typedef unsigned v4u8 __attribute__((ext_vector_type(4), aligned(8)));
typedef unsigned u32x6v __attribute__((ext_vector_type(6)));
struct Row6 { v4u a; u32x2 b; };
#define G_ISSUE(buf, gb) do { const unsigned char* tb_ = (gb) < 32 ? T8D : T8U; const int kb_ = ((gb) & 31) * 4; \
    _Pragma("unroll") for (int q = 0; q < 4; ++q) { const int k_ = kb_ + q; const int e_ = __builtin_amdgcn_readlane(k_ < 64 ? id0 : id1, k_ & 63); \
        const unsigned char* p_ = tb_ + (size_t)e_ * 1536 + lane * 24; buf[q].a = *(const GAS v4u8*)p_; buf[q].b = *(const GAS u32x2*)(p_ + 16); } } while (0)
#define G_DEC(r) __builtin_amdgcn_cvt_scalef32_pk32_f32_fp6((u32x6v){(r).a.x, (r).a.y, (r).a.z, (r).a.w, (r).b.x, (r).b.y}, 1.0f)
#define G_DOWN(buf, b) do { float p_[4]; \
    _Pragma("unroll") for (int q = 0; q < 4; ++q) { const auto y_ = G_DEC(buf[q]); float s0_ = 0.f, s1_ = 0.f, s2_ = 0.f, s3_ = 0.f; \
        _Pragma("unroll") for (int i = 0; i < 32; i += 4) { s0_ += y_[i] * xv[i]; s1_ += y_[i + 1] * xv[i + 1]; s2_ += y_[i + 2] * xv[i + 2]; s3_ += y_[i + 3] * xv[i + 3]; } p_[q] = (s0_ + s1_) + (s2_ + s3_); } \
    { const bool h5_ = (lane & 32) != 0; _Pragma("unroll") for (int i = 0; i < 2; ++i) { const float keep_ = h5_ ? p_[i + 2] : p_[i], send_ = h5_ ? p_[i] : p_[i + 2]; p_[i] = keep_ + __shfl_xor(send_, 32); } } \
    { const bool h4_ = (lane & 16) != 0; const float keep_ = h4_ ? p_[1] : p_[0], send_ = h4_ ? p_[0] : p_[1]; p_[0] = keep_ + __shfl_xor(send_, 16); } \
    const float tot_ = red16(p_[0]); \
    if ((lane & 15) == ((b) & 15)) { if ((b) < 16) hv0 = tot_; else hv1 = tot_; } } while (0)
#define G_UP(buf, b) do { _Pragma("unroll") for (int q = 0; q < 4; ++q) { const float ck_ = rdlane((b) < 16 ? c0 : c1, 16 * q + ((b) & 15)); const auto y_ = G_DEC(buf[q]); \
        _Pragma("unroll") for (int i = 0; i < 32; ++i) acc[i] += ck_ * y_[i]; } } while (0)
DI void fp8x4_f32(unsigned w, float& a, float& b, float& c, float& d) { const auto lo = __builtin_amdgcn_cvt_pk_f32_fp8((int)w, false); const auto hi = __builtin_amdgcn_cvt_pk_f32_fp8((int)w, true); a = lo[0]; b = lo[1]; c = hi[0]; d = hi[1]; }
#else
#define G_ISSUE(buf, gb) do { const unsigned char* tb_ = (gb) < 32 ? T8D : T8U; const int kb_ = ((gb) & 31) * 4; \
    _Pragma("unroll") for (int q = 0; q < 4; ++q) { const int k_ = kb_ + q; const int e_ = __builtin_amdgcn_readlane(k_ < 64 ? id0 : id1, k_ & 63); \
        const unsigned char* p_ = tb_ + (size_t)e_ * DM + lane * 16; buf[q][0] = G_LD((const GAS v4u*)p_); buf[q][1] = G_LD((const GAS v4u*)(p_ + 1024)); } } while (0)
DI void fp8x4_f32(unsigned w, float& a, float& b, float& c, float& d) { const auto lo = __builtin_amdgcn_cvt_pk_f32_fp8((int)w, false); const auto hi = __builtin_amdgcn_cvt_pk_f32_fp8((int)w, true); a = lo[0]; b = lo[1]; c = hi[0]; d = hi[1]; }
DI float fp8_dot4(unsigned w, float x0, float x1, float x2, float x3) { float a, b, c, d; fp8x4_f32(w, a, b, c, d); return (a * x0 + b * x1) + (c * x2 + d * x3); }
#define G_DOT4(w, xo) fp8_dot4((w), xv[(xo) + 0], xv[(xo) + 1], xv[(xo) + 2], xv[(xo) + 3])
#define G_DOWN(buf, b) do { float p_[4]; \
    _Pragma("unroll") for (int q = 0; q < 4; ++q) { float s0_ = 0.f, s1_ = 0.f; \
        s0_ += G_DOT4(buf[q][0].x, 0); s1_ += G_DOT4(buf[q][0].y, 4); s0_ += G_DOT4(buf[q][0].z, 8); s1_ += G_DOT4(buf[q][0].w, 12); \
        s0_ += G_DOT4(buf[q][1].x, 16); s1_ += G_DOT4(buf[q][1].y, 20); s0_ += G_DOT4(buf[q][1].z, 24); s1_ += G_DOT4(buf[q][1].w, 28); p_[q] = s0_ + s1_; } \
    { const bool h5_ = (lane & 32) != 0; _Pragma("unroll") for (int i = 0; i < 2; ++i) { const float keep_ = h5_ ? p_[i + 2] : p_[i], send_ = h5_ ? p_[i] : p_[i + 2]; p_[i] = keep_ + __shfl_xor(send_, 32); } } \
    { const bool h4_ = (lane & 16) != 0; const float keep_ = h4_ ? p_[1] : p_[0], send_ = h4_ ? p_[0] : p_[1]; p_[0] = keep_ + __shfl_xor(send_, 16); } \
    const float tot_ = red16(p_[0]); \
    if ((lane & 15) == ((b) & 15)) { if ((b) < 16) hv0 = tot_; else hv1 = tot_; } } while (0)
#define G_FMA4(w, ao, ck) do { float a_, b_, c_, d_; fp8x4_f32((w), a_, b_, c_, d_); \
    acc[(ao) + 0] += (ck) * a_; acc[(ao) + 1] += (ck) * b_; acc[(ao) + 2] += (ck) * c_; acc[(ao) + 3] += (ck) * d_; } while (0)
#define G_UP(buf, b) do { _Pragma("unroll") for (int q = 0; q < 4; ++q) { const float ck_ = rdlane((b) < 16 ? c0 : c1, 16 * q + ((b) & 15)); \
        G_FMA4(buf[q][0].x, 0, ck_); G_FMA4(buf[q][0].y, 4, ck_); G_FMA4(buf[q][0].z, 8, ck_); G_FMA4(buf[q][0].w, 12, ck_); \
        G_FMA4(buf[q][1].x, 16, ck_); G_FMA4(buf[q][1].y, 20, ck_); G_FMA4(buf[q][1].z, 24, ck_); G_FMA4(buf[q][1].w, 28, ck_); } } while (0)
#endif
DI void bitonic128(int& a, int& b, int lane) {
#pragma unroll
    for (int k = 2; k <= 128; k <<= 1) {
#pragma unroll
        for (int j = k >> 1; j >= 1; j >>= 1) {
            if (j == 64) { const int lo = imin2(a, b), hi = imax2(a, b); a = lo; b = hi; }
            else {
                const int oa = __shfl_xor(a, j), ob = __shfl_xor(b, j);
                const bool lower = (lane & j) == 0;
                const bool up_a = k == 128 ? true : (k == 64 ? true : ((lane & k) == 0));
                const bool up_b = k == 128 ? true : (k == 64 ? false : ((lane & k) == 0));
                a = (lower == up_a) ? imin2(a, oa) : imax2(a, oa);
                b = (lower == up_b) ? imin2(b, ob) : imax2(b, ob);
            }
        }
    }
}
#ifndef GATHER_SORT
#define GATHER_SORT 1
#endif
#ifndef GATHER_TRIPLE
#define GATHER_TRIPLE 0
#endif
#ifndef GATHER_SYNC
#define GATHER_SYNC 0
#endif
DI void gather_phase(Frame& F, const XcdBarrier& bar) {
    const int lane = F.lane, wave = F.wave;
    const int gw = F.vcu * NWAVES + wave, NGW = F.G * NWAVES;
    const int* IDX = (const int*)(F.ws + WS_IDX); const float* GATE = (const float*)(F.ws + WS_GATE);
    const unsigned char* T8D = F.ws + WS_TD; const unsigned char* T8U = F.ws + WS_TU; const float* SCL = (const float*)(F.ws + WS_SCL);
    const bf16* H1B = (const bf16*)(F.ws + WS_H1B);
    const float* sumsq = (const float*)(F.ws + WS_SUMSQ);
#if TBL_FP4
    const __amdgpu_buffer_rsrc_t trs = __builtin_amdgcn_make_buffer_rsrc((void*)T8D, 0, 0x7fffffff, 0x00020000);
#endif
#if FUSE_TOPK
    const float* SC = (const float*)(F.ws + WS_SC);
    LAS int* KA = (LAS int*)(F.lds + wave * 1024); LAS int* KB = KA + 64;
    topk_setup((LAS unsigned char*)(F.lds + wave * 1024 + 512), lane);
#endif
    for (int t = gw; t < TR; t += NGW) {
#if FUSE_TOPK
        int id0, id1; float gr0, gr1;
        topk_pass(SC, t, 0, lane, KA, KB, id0, gr0); topk_pass(SC, t, 1, lane, KA, KB, id1, gr1);
#else
        int id0 = IDX[(size_t)t * NSEL + lane], id1 = IDX[(size_t)t * NSEL + 64 + lane];
#endif
#if TBL_FP4
        const int kA = 16 * (lane & 3) + (lane >> 2);
#else
        const int kA = 4 * (lane & 15) + (lane >> 4);
#endif
#if GATHER_SORT
        int key0 = (id0 << 7) | lane, key1 = (id1 << 7) | (lane + 64);
        bitonic128(key0, key1, lane);
        id0 = key0 >> 7; id1 = key1 >> 7;
        const int keyA = __shfl(key0, kA), keyB = __shfl(key1, kA);
        const int ea = keyA >> 7, eb = keyB >> 7;
#if FUSE_TOPK
        const int oA = keyA & 127, oB = keyB & 127;
        const float gA0 = __shfl(gr0, oA & 63), gA1 = __shfl(gr1, oA & 63), gB0 = __shfl(gr0, oB & 63), gB1 = __shfl(gr1, oB & 63);
        const float g0 = oA < 64 ? gA0 : gA1, g1 = oB < 64 ? gB0 : gB1;
#else
        const float g0 = GATE[(size_t)t * NSEL + (keyA & 127)], g1 = GATE[(size_t)t * NSEL + (keyB & 127)];
#endif
#else
        const int ea = IDX[(size_t)t * NSEL + kA], eb = IDX[(size_t)t * NSEL + 64 + kA];
        const float g0 = GATE[(size_t)t * NSEL + kA], g1 = GATE[(size_t)t * NSEL + 64 + kA];
#endif
        const float sd0 = SCL[ea], sd1 = SCL[eb], su0 = SCL[NEXP + ea], su1 = SCL[NEXP + eb];
        const float rs = 1.0f / sqrtf(sumsq[t] * (1.0f / DM) + RMS_EPS);
#if TBL_FP4
        const unsigned lo16 = (unsigned)lane * 16u, lo2 = 1024u + (unsigned)lane * 2u;
        unsigned xr[16];
#pragma unroll
        for (int j = 0; j < 8; ++j) { const u32x2 raw = *(const GAS u32x2*)(H1B + (size_t)t * DM + 256 * j + lane * 4); xr[2 * j] = raw.x; xr[2 * j + 1] = raw.y; }
        float hv0 = 0.f, hv1 = 0.f;
        Row6 bufA[4], bufB[4];
#elif TBL_FP6
        float xv[32];
#pragma unroll
        for (int j = 0; j < 8; ++j) { const u32x2 raw = *(const GAS u32x2*)(H1B + (size_t)t * DM + 256 * j + lane * 4); const int o = j * 4;
            xv[o + 0] = bflo(raw.x); xv[o + 1] = bfhi(raw.x); xv[o + 2] = bflo(raw.y); xv[o + 3] = bfhi(raw.y); }
        float hv0 = 0.f, hv1 = 0.f;
        Row6 bufA[4], bufB[4];
#else
#pragma unroll
        for (int c = 0; c < 2; ++c)
#pragma unroll
            for (int j = 0; j < 2; ++j) { const v4u raw = *(const GAS v4u*)(H1B + (size_t)t * DM + c * 1024 + lane * 16 + j * 8); const int o = c * 16 + j * 8;
                xv[o + 0] = bflo(raw.x); xv[o + 1] = bfhi(raw.x); xv[o + 2] = bflo(raw.y); xv[o + 3] = bfhi(raw.y); xv[o + 4] = bflo(raw.z); xv[o + 5] = bfhi(raw.z); xv[o + 6] = bflo(raw.w); xv[o + 7] = bfhi(raw.w); }
        float hv0 = 0.f, hv1 = 0.f;
        v4u bufA[4][2], bufB[4][2];
#endif
        if (GATHER_SYNC & 1) xcd_barrier(bar);
#if GATHER_TRIPLE
        Row6 bufC[4];
        G_ISSUE(bufA, 0); G_ISSUE(bufB, 1);
#pragma unroll 1
        for (int b = 0; b < 30; b += 3) { G_ISSUE(bufC, b + 2); G_DOWN(bufA, b); G_ISSUE(bufA, b + 3); G_DOWN(bufB, b + 1); G_ISSUE(bufB, b + 4); G_DOWN(bufC, b + 2); }
        G_ISSUE(bufC, 32); G_DOWN(bufA, 30); G_ISSUE(bufA, 33); G_DOWN(bufB, 31);
#else
        G_ISSUE(bufA, 0);
#if TBL_FP4
#pragma unroll 1
        for (int G = 0; G < 8; ++G) { float pp[16];
            G_ISSUE(bufB, 4 * G + 1); G_PART(bufA, 0); G_ISSUE(bufA, 4 * G + 2); G_PART(bufB, 4); G_ISSUE(bufB, 4 * G + 3); G_PART(bufA, 8); G_ISSUE(bufA, UP_TR && 4 * G + 4 > 31 ? 31 : 4 * G + 4); G_PART(bufB, 12);
            G_RED16(G); }
#else
#pragma unroll 1
        for (int b = 0; b < 32; b += 2) { G_ISSUE(bufB, b + 1); G_DOWN(bufA, b); G_ISSUE(bufA, b + 2); G_DOWN(bufB, b + 1); }
#endif
#endif
#if TBL_FP4
        const float z0 = hv0 * rs, z1 = hv1 * rs;
        const float c0 = (UP_TR ? su0 : 1.0f) * g0 * 0.5f * z0 * (1.0f + erff(z0 * 0.70710678118654752f)), c1 = (UP_TR ? su1 : 1.0f) * g1 * 0.5f * z1 * (1.0f + erff(z1 * 0.70710678118654752f));
#else
        const float z0 = hv0 * rs * sd0, z1 = hv1 * rs * sd1;
        const float c0 = g0 * su0 * 0.5f * z0 * (1.0f + erff(z0 * 0.70710678118654752f)), c1 = g1 * su1 * 0.5f * z1 * (1.0f + erff(z1 * 0.70710678118654752f));
#endif
        float acc[32];
#if TBL_FP4 && UP_TR
        {
            LAS unsigned char* cq = F.lds + wave * 1024;
            const float cmax = wave_max(fmaxf(fabsf(c0), fabsf(c1)));
            const float qs = cmax > 0.f ? 119.0f * frcp(cmax) : 0.f;
            { const int v0 = (int)rintf(fminf(fmaxf(c0 * qs, -119.0f), 119.0f)), v1 = (int)rintf(fminf(fmaxf(c1 * qs, -119.0f), 119.0f));
              const int h0 = (v0 + 8) >> 4, h1 = (v1 + 8) >> 4;
              cq[kA] = (unsigned char)h0; cq[kA + 64] = (unsigned char)h1; cq[128 + kA] = (unsigned char)(v0 - 16 * h0); cq[128 + kA + 64] = (unsigned char)(v1 - 16 * h1); }
            asm volatile("s_waitcnt lgkmcnt(0)" ::: "memory");
            if (lane < 32) { const unsigned x_ = *(const LAS unsigned*)(cq + 8 * lane) & 0x0f0f0f0fu, y_ = *(const LAS unsigned*)(cq + 8 * lane + 4) & 0x0f0f0f0fu;
                const unsigned tx_ = (x_ | (x_ >> 4)) & 0x00ff00ffu, ty_ = (y_ | (y_ >> 4)) & 0x00ff00ffu;
                *(LAS unsigned*)(cq + 256 + 4 * lane) = ((tx_ | (tx_ >> 8)) & 0xffffu) | (((ty_ | (ty_ >> 8)) & 0xffffu) << 16); }
            asm volatile("s_waitcnt lgkmcnt(0)" ::: "memory");
            LAS unsigned char* const ring = F.lds + UR_BASE + wave * UR_WAVE;
            const unsigned trb = (unsigned)(size_t)(ring + (lane & 7) * UR_PITCH + 8 * (lane >> 4));
            int ah[32], al[32];
#pragma unroll
            for (int i = 0; i < 32; ++i) { ah[i] = 0; al[i] = 0; }
#define UR_ISSUE(ch) do { _Pragma("unroll") for (int q = 0; q < 8; ++q) { const int k_ = 8 * (ch) + q; const int e_ = __builtin_amdgcn_readlane(k_ < 64 ? id0 : id1, k_ & 63); \
        __builtin_amdgcn_global_load_lds((const GAS unsigned*)(T8U + (size_t)e_ * ROWU + lane * 16), (LAS unsigned*)(ring + ((ch) & 1) * UR_BUF + q * UR_PITCH), 16, 0, 0); } } while (0)
            asm volatile("s_waitcnt vmcnt(0)" ::: "memory");
            UR_ISSUE(0); UR_ISSUE(1);
#pragma unroll 1
            for (int ch = 0; ch < 16; ++ch) {
                if (ch + 1 < 16) asm volatile("s_waitcnt vmcnt(8)" ::: "memory"); else asm volatile("s_waitcnt vmcnt(0)" ::: "memory");
                const int kh = *(const LAS int*)(cq + 256 + 4 * ch), kl = *(const LAS int*)(cq + 256 + 64 + 4 * ch);
                const unsigned tb_ = trb + (unsigned)((ch & 1) * UR_BUF);
                int rr[32];
#pragma unroll
                for (int T = 0; T < 32; ++T) {
                    const v2i_t r_ = __builtin_amdgcn_ds_read_tr4_b64_v2i32((LAS v2i_t*)(size_t)(tb_ + 32 * T)); rr[T] = r_.x; }
                asm volatile("s_waitcnt lgkmcnt(0)" ::: "memory");
                if (ch + 2 < 16) UR_ISSUE(ch + 2);
#pragma unroll
                for (int T = 0; T < 32; ++T) { ah[T] = __builtin_amdgcn_sdot8(rr[T], kh, ah[T], false); al[T] = __builtin_amdgcn_sdot8(rr[T], kl, al[T], false); }
            }
            const float os = cmax * (1.0f / 119.0f);
            { const int j_ = lane & 15, g_ = lane >> 4; const unsigned cb_ = 4u * (unsigned)(256 * ((16 * (g_ & 1) + j_) >> 2) + 4 * (g_ >> 1) + (j_ & 3));
#pragma unroll
              for (int T = 0; T < 32; ++T) *(LAS float*)(ring + cb_ + 32 * T) = os * (float)(16 * ah[T] + al[T]); }
            asm volatile("s_waitcnt lgkmcnt(0)" ::: "memory");
#pragma unroll
            for (int j = 0; j < 8; ++j) { const f32x4 o_ = *(const LAS f32x4*)(ring + 4 * (256 * j + 4 * lane)); acc[4 * j] = o_.x; acc[4 * j + 1] = o_.y; acc[4 * j + 2] = o_.z; acc[4 * j + 3] = o_.w; }
            asm volatile("s_waitcnt lgkmcnt(0)" ::: "memory");
        }
#else
#pragma unroll
        for (int i = 0; i < 32; ++i) acc[i] = 0.f;
        if (GATHER_SYNC & 2) xcd_barrier(bar);
#endif
#if TBL_FP4 && UP_TR
#elif GATHER_TRIPLE
        G_ISSUE(bufB, 34); G_UP(bufC, 0);
#pragma unroll 1
        for (int u = 1; u < 31; u += 3) { G_ISSUE(bufC, 32 + u + 2); G_UP(bufA, u); G_ISSUE(bufA, 32 + u + 3); G_UP(bufB, u + 1); G_ISSUE(bufB, (32 + u + 4) & 63); G_UP(bufC, u + 2); }
        G_UP(bufA, 31);
#else
#pragma unroll 1
        for (int b = 0; b < 32; b += 2) { G_ISSUE(bufB, 32 + b + 1); G_UP(bufA, b); if (b + 2 < 32) G_ISSUE(bufA, 32 + b + 2); G_UP(bufB, b + 1); }
#endif
#if TBL_FP6
        {
#pragma unroll
            for (int j = 0; j < 8; ++j) { const u32x2 raw = *(const GAS u32x2*)(H1B + (size_t)t * DM + 256 * j + lane * 4);
                *(GAS f32x4*)(F.out + (size_t)t * DM + 256 * j + lane * 4) = (f32x4){bflo(raw.x) + acc[j * 4 + 0], bfhi(raw.x) + acc[j * 4 + 1], bflo(raw.y) + acc[j * 4 + 2], bfhi(raw.y) + acc[j * 4 + 3]}; }
        }
#else
#pragma unroll
        for (int c = 0; c < 2; ++c) {
            GAS f32x4* op = (GAS f32x4*)(F.out + (size_t)t * DM + c * 1024 + lane * 16);
#pragma unroll
            for (int j = 0; j < 4; ++j) { f32x4 a = op[j]; a.x += acc[c * 16 + j * 4 + 0]; a.y += acc[c * 16 + j * 4 + 1]; a.z += acc[c * 16 + j * 4 + 2]; a.w += acc[c * 16 + j * 4 + 3]; op[j] = a; }
        }
#endif
    }
}

DI float dot4_fp8(unsigned w, const f32x4& x) { float a, b, c, d; fp8x4_f32(w, a, b, c, d); return (a * x.x + b * x.y) + (c * x.z + d * x.w); }
struct SliceMap { int slice, rank, nblk; };
DI SliceMap slice_map(Frame& F, const XcdBarrier& bar) {
    SliceMap m; m.slice = (int)(blockIdx.x & 7); m.rank = (int)(blockIdx.x >> 3); m.nblk = (F.G + 7 - m.slice) / 8;
    if (!MK_SPLIT && (F.G & 7) == 0) {
        bool ok = true;
#pragma unroll
        for (int j = 0; j < 16; ++j) { const unsigned cnt = xb_ld(&bar.bar[XB_XCNT(j)]); ok = ok && (j < 8 ? cnt == (unsigned)(F.G / 8) : cnt == 0u); }
        if (ok) { m.slice = (int)bar.x; m.rank = (int)F.MISC[10]; m.nblk = F.G / 8; }
    }
    return m;
}
#define GS_ISSUE(buf, i0_, i1_, q) do { const int ids_ = ((q) & 2) ? (i1_) : (i0_); const int lb_ = ((q) & 1) * 32; \
    _Pragma("unroll") for (int k = 0; k < 32; ++k) buf[k] = *(const GAS unsigned*)(T8 + (size_t)__builtin_amdgcn_readlane(ids_, lb_ + k) * 256); } while (0)
#define GS_DOWN(buf, q) do { float p[32]; \
    _Pragma("unroll") for (int k = 0; k < 32; ++k) p[k] = dot4_fp8(buf[k], xc); \
    _Pragma("unroll") for (int d = 16; d >= 1; d >>= 1) { const bool hi_ = (lane & d) != 0; \
        _Pragma("unroll") for (int i = 0; i < d; ++i) { const float keep_ = hi_ ? p[i + d] : p[i], send_ = hi_ ? p[i] : p[i + d]; p[i] = keep_ + __shfl_xor(send_, d); } } \
    const float tot_ = p[0] + __shfl_xor(p[0], 32); \
    if (lane < 32 && vc) PART[(size_t)tc * NSEL + 32 * (q) + lane] = tot_; } while (0)
#define GSD_TOK(Ba, Bb, Bc) do { \
    const int in_ = it + 1; const bool vn = in_ < ntok; const int tn = vn ? wv + in_ * NWV : wv; \
    const int n0 = IDX[(size_t)tn * NSEL + lane], n1 = IDX[(size_t)tn * NSEL + 64 + lane]; \
    const u32x2 xr_ = *(const GAS u32x2*)(H1B + (size_t)tn * DM + 256 * sm.slice + 4 * lane); \
    GS_ISSUE(Bc, c0i, c1i, 2); \
    GS_DOWN(Ba, 0); GS_ISSUE(Ba, c0i, c1i, 3); \
    GS_DOWN(Bb, 1); GS_ISSUE(Bb, n0, n1, 0); \
    GS_DOWN(Bc, 2); GS_ISSUE(Bc, n0, n1, 1); \
    GS_DOWN(Ba, 3); \
    c0i = n0; c1i = n1; xc = (f32x4){bflo(xr_.x), bfhi(xr_.x), bflo(xr_.y), bfhi(xr_.y)}; tc = tn; vc = vn; ++it; } while (0)
DI void gather_down_sliced(Frame& F, const XcdBarrier& bar) {
    const int lane = F.lane, wave = F.wave;
    const SliceMap sm = slice_map(F, bar);
    const int* IDX = (const int*)(F.ws + WS_IDX);
    const unsigned char* T8 = F.ws + WS_TD + (size_t)sm.slice * ((size_t)NEXP * 256) + lane * 4;
    const bf16* H1B = (const bf16*)(F.ws + WS_H1B);
    float* PART = (float*)(F.ws + WS_PART) + (size_t)sm.slice * TR * NSEL;
    const int wv = sm.rank * NWAVES + wave, NWV = sm.nblk * NWAVES;
    const int ntok = wv < TR ? (TR - wv + NWV - 1) / NWV : 0;
    int it = 0; int tc = wv < TR ? wv : 0; bool vc = ntok > 0;
    int c0i = IDX[(size_t)tc * NSEL + lane], c1i = IDX[(size_t)tc * NSEL + 64 + lane];
    f32x4 xc; { const u32x2 xr = *(const GAS u32x2*)(H1B + (size_t)tc * DM + 256 * sm.slice + 4 * lane); xc = (f32x4){bflo(xr.x), bfhi(xr.x), bflo(xr.y), bfhi(xr.y)}; }
    unsigned b0[32], b1[32], b2[32];
    GS_ISSUE(b0, c0i, c1i, 0); GS_ISSUE(b1, c0i, c1i, 1);
    while (it < ntok) { GSD_TOK(b0, b1, b2); GSD_TOK(b1, b2, b0); GSD_TOK(b2, b0, b1); }
}
#define GS_UP(buf, q) do { const float cs_ = ((q) & 2) ? cc1 : cc0; const int lb_ = ((q) & 1) * 32; \
    _Pragma("unroll") for (int k = 0; k < 32; ++k) { float a_, b_, c_, d_; fp8x4_f32(buf[k], a_, b_, c_, d_); const float ck_ = rdlane(cs_, lb_ + k); \
        if (k & 1) { acc1.x += ck_ * a_; acc1.y += ck_ * b_; acc1.z += ck_ * c_; acc1.w += ck_ * d_; } else { acc0.x += ck_ * a_; acc0.y += ck_ * b_; acc0.z += ck_ * c_; acc0.w += ck_ * d_; } } } while (0)
#define GSU_COEF(tq, i0_, i1_, o0, o1) do { float h0_ = 0.f, h1_ = 0.f; \
    _Pragma("unroll") for (int xs = 0; xs < 8; ++xs) { h0_ += PART[((size_t)xs * TR + (tq)) * NSEL + lane]; h1_ += PART[((size_t)xs * TR + (tq)) * NSEL + 64 + lane]; } \
    const float rs_ = frsq(sumsq[tq] * (1.0f / DM) + RMS_EPS); const float z0_ = h0_ * rs_ * SCL[i0_], z1_ = h1_ * rs_ * SCL[i1_]; \
    o0 = GATE[(size_t)(tq) * NSEL + lane] * SCL[NEXP + (i0_)] * 0.5f * z0_ * (1.0f + erff(z0_ * 0.70710678118654752f)); \
    o1 = GATE[(size_t)(tq) * NSEL + 64 + lane] * SCL[NEXP + (i1_)] * 0.5f * z1_ * (1.0f + erff(z1_ * 0.70710678118654752f)); } while (0)
#define GSU_TOK(Ba, Bb, Bc) do { \
    const int in_ = it + 1; const bool vn = in_ < ntok; const int tn = vn ? wv + in_ * NWV : wv; \
    const int n0 = IDX[(size_t)tn * NSEL + lane], n1 = IDX[(size_t)tn * NSEL + 64 + lane]; \
    f32x4 acc0 = (f32x4){0.f, 0.f, 0.f, 0.f}, acc1 = (f32x4){0.f, 0.f, 0.f, 0.f}; \
    GS_ISSUE(Bc, c0i, c1i, 2); \
    GS_UP(Ba, 0); GS_ISSUE(Ba, c0i, c1i, 3); \
    float nc0, nc1; GSU_COEF(tn, n0, n1, nc0, nc1); \
    GS_UP(Bb, 1); GS_ISSUE(Bb, n0, n1, 0); \
    GS_UP(Bc, 2); GS_ISSUE(Bc, n0, n1, 1); \
    GS_UP(Ba, 3); \
    if (vc) { GAS f32x4* op = (GAS f32x4*)(F.out + (size_t)tc * DM + 256 * sm.slice + 4 * lane); f32x4 o = *op; o = o + acc0 + acc1; *op = o; } \
    c0i = n0; c1i = n1; cc0 = nc0; cc1 = nc1; tc = tn; vc = vn; ++it; } while (0)
DI void gather_up_sliced(Frame& F, const XcdBarrier& bar) {
    const int lane = F.lane, wave = F.wave;
    const SliceMap sm = slice_map(F, bar);
    const int* IDX = (const int*)(F.ws + WS_IDX); const float* GATE = (const float*)(F.ws + WS_GATE);
    const unsigned char* T8 = F.ws + WS_TU + (size_t)sm.slice * ((size_t)NEXP * 256) + lane * 4;
    const float* PART = (const float*)(F.ws + WS_PART); const float* SCL = (const float*)(F.ws + WS_SCL);
    const float* sumsq = (const float*)(F.ws + WS_SUMSQ);
    const int wv = sm.rank * NWAVES + wave, NWV = sm.nblk * NWAVES;
    const int ntok = wv < TR ? (TR - wv + NWV - 1) / NWV : 0;
    int it = 0; int tc = wv < TR ? wv : 0; bool vc = ntok > 0;
    int c0i = IDX[(size_t)tc * NSEL + lane], c1i = IDX[(size_t)tc * NSEL + 64 + lane];
    float cc0, cc1; GSU_COEF(tc, c0i, c1i, cc0, cc1);
    unsigned b0[32], b1[32], b2[32];
    GS_ISSUE(b0, c0i, c1i, 0); GS_ISSUE(b1, c0i, c1i, 1);
    while (it < ntok) { GSU_TOK(b0, b1, b2); GSU_TOK(b1, b2, b0); GSU_TOK(b2, b0, b1); }
}

#ifndef REP_ATT
#define REP_ATT 1
#endif
#ifndef REP_RWKV
#define REP_RWKV 1
#endif
struct Args { const float* in[24]; float* out; unsigned char* ws; int ph_lo, ph_hi, li, pad; };
__global__ void __launch_bounds__(NTHR, 2) hybrid_fwd(Args args) {
    extern __shared__ __attribute__((aligned(16))) unsigned char lds[];
    Frame F;
    F.lds = (LAS unsigned char*)lds;
    F.MISC = (volatile LAS unsigned*)(F.lds + MISC_OFF);
    F.tid = threadIdx.x; F.lane = F.tid & 63; F.wave = __builtin_amdgcn_readfirstlane(F.tid >> 6);
    F.G = gridDim.x; { const int bx = blockIdx.x; F.vcu = (F.G % 8 == 0) ? (bx % 8) * (F.G / 8) + bx / 8 : bx; }
    F.ws = args.ws; F.out = args.out; F.ctl = (gu32*)(args.ws + WS_CTL);
#pragma unroll
    for (int i = 0; i < 24; ++i) F.in[i] = args.in[i];
    for (int u = F.tid; u < (LDS_BYTES - LDSCTL_OFF) / 4; u += NTHR) ((LAS unsigned*)(F.lds + LDSCTL_OFF))[u] = 0u;
    __syncthreads();
    XcdBarrier bar; bar.bar = (unsigned*)(F.ctl + CW_BAR); bar.x = 0; bar.st = nullptr;
    if (!MK_SPLIT) {
        bar.x = xb_xcc_id(); bar.st = F.MISC + 8;
        if (F.tid == 0) F.MISC[10] = xb_add(&bar.bar[XB_XCNT(bar.x)], 1u);
        __syncthreads();
    }
    const int lo = args.ph_lo, hi = args.ph_hi;
#ifndef PH_MASK
#define PH_MASK 0x1ff
#endif
#define IN(k) (((PH_MASK >> (k)) & 1) && lo <= (k) && (k) < hi)
#define SEAM(k) do { if (IN(k) && IN((k) + 1)) xcd_barrier(bar); } while (0)
    bf16* Win_t = (bf16*)(F.ws + WS_WIN); bf16* Wout_t = (bf16*)(F.ws + WS_WOUT); bf16* Wqs_t = (bf16*)(F.ws + WS_WQS);
    bf16* U = (bf16*)(F.ws + WS_U); bf16* P = (bf16*)(F.ws + WS_P); bf16* H1B = (bf16*)(F.ws + WS_H1B);
    float* sumsq = (float*)(F.ws + WS_SUMSQ); float* SC = (float*)(F.ws + WS_SC);

#ifndef PH_DUP
#define PH_DUP 0
#endif
#define DUP(k) for (int rep_ = 0; rep_ < (((PH_DUP >> (k)) & 1) ? 2 : 1); ++rep_)
    if (IN(0)) { DUP(0) { p0_prologue(F); __syncthreads(); } } SEAM(0);
    if (IN(1)) {
        pg8::Gemm g{U, Win_t, MIN_ROWS, NP, DM}; pg8::StaticOrder S; S.init(MIN_ROWS, NP, F.G, (int)blockIdx.x);
        pg8::EpiBf16<0> E{P, NP, nullptr, 0, 0, 1.f};
        pg8::gemm_phase<pg8::EpiBf16<0>, pg8::StaticOrder, true, true>(F.lds, g, S, E);
#if (PH_DUP >> 1) & 1
        __syncthreads(); pg8::gemm_phase<pg8::EpiBf16<0>, pg8::StaticOrder, true, true>(F.lds, g, S, E);
#endif
    } SEAM(1);
    if (IN(2)) {
        for (int rep = 0; rep < REP_ATT; ++rep) for (int u = blockIdx.x; u < 256; u += F.G) attn_unit(F, u);
        for (int rep = 0; rep < REP_RWKV; ++rep) for (int u = blockIdx.x; u < 256; u += F.G) rwkv_pass1(F, u);
    } SEAM(2);
    if (IN(3)) {
        for (int u = blockIdx.x; u < 256; u += F.G) rwkv_pass2(F, u);
    } SEAM(3);
    if (IN(4)) {
        pg8::Gemm g{U, Wout_t, TR, DM, DM}; pg8::StaticOrder S; S.init(TR, DM, F.G, (int)blockIdx.x);
        pg8::EpiOut E{F.in[IN_X], F.out, H1B, sumsq, DM};
        pg8::gemm_phase<pg8::EpiOut, pg8::StaticOrder, true, true>(F.lds, g, S, E);
    } SEAM(4);
    if (IN(5)) {
        pg8::Gemm g{H1B, Wqs_t, TR, DM, DM}; pg8::StaticOrder S; S.init(TR, DM, F.G, (int)blockIdx.x);
        pg8::EpiScores E{sumsq, SC, DM, RMS_EPS};
        pg8::gemm_phase<pg8::EpiScores, pg8::StaticOrder, true, true>(F.lds, g, S, E);
#if (PH_DUP >> 5) & 1
        __syncthreads(); pg8::gemm_phase<pg8::EpiScores, pg8::StaticOrder, true, true>(F.lds, g, S, E);
#endif
    } SEAM(5);
#if !FUSE_TOPK || GATHER_SLICED
    if (IN(6)) { DUP(6) topk_phase(F); } SEAM(6);
#endif
#if GATHER_SLICED
    if (IN(7)) { gather_down_sliced(F, bar); } SEAM(7);
    if (IN(8)) { gather_up_sliced(F, bar); }
#else
    if (IN(7)) { gather_phase(F, bar); }
#endif
#undef IN
#undef SEAM
}

extern "C" void kernel_launch(void* const* d_in, const int* in_sizes, int n_in, void* d_out, int out_size, void* d_ws, size_t ws_size, hipStream_t stream) {
    static int grid = 0;
    if (grid == 0) {
        if (n_in != 24 || in_sizes[0] != TR * DM || out_size != TR * DM || ws_size < WS_END) { fprintf(stderr, "kernel_launch: unexpected shapes: n_in %d in0 %d out %d ws %zu\n", n_in, n_in > 0 ? in_sizes[0] : -1, out_size, ws_size); grid = -1; return; }
        int dev = 0, cus = 0, per_cu = 0;
        if (hipGetDevice(&dev) != hipSuccess || hipDeviceGetAttribute(&cus, hipDeviceAttributeMultiprocessorCount, dev) != hipSuccess) { grid = -1; return; }
        if (hipFuncSetAttribute((const void*)hybrid_fwd, hipFuncAttributeMaxDynamicSharedMemorySize, LDS_BYTES) != hipSuccess) { fprintf(stderr, "kernel_launch: hipFuncSetAttribute failed\n"); grid = -1; return; }
        if (hipOccupancyMaxActiveBlocksPerMultiprocessor(&per_cu, (const void*)hybrid_fwd, NTHR, LDS_BYTES) != hipSuccess || per_cu < 1) fprintf(stderr, "kernel_launch: occupancy query says %d\n", per_cu);
        (void)hipGetLastError();
        grid = cus;
    }
    if (grid < 0) return;
    if (hipMemsetAsync((char*)d_ws + WS_CTL, 0, CTL_ZERO_BYTES, stream) != hipSuccess) return;
    Args a{};
    for (int i = 0; i < 24; ++i) a.in[i] = (const float*)d_in[i];
    a.out = (float*)d_out; a.ws = (unsigned char*)d_ws;
#if MK_SPLIT
    for (int li = 0; li < NPHASE; ++li) { a.ph_lo = li; a.ph_hi = li + 1; a.li = li; hipLaunchKernelGGL(hybrid_fwd, dim3(grid), dim3(NTHR), LDS_BYTES, stream, a); }
#else
    a.ph_lo = 0; a.ph_hi = NPHASE; a.li = 0;
    hipLaunchKernelGGL(hybrid_fwd, dim3(grid), dim3(NTHR), LDS_BYTES, stream, a);
#endif
}
```

```cpp
#include <hip/hip_runtime.h>
#include <cstdio>
#include <cstdint>
namespace pg8 {
#define PG8_LAS __attribute__((address_space(3)))
typedef unsigned short bf16_t;
typedef short bf16x8 __attribute__((ext_vector_type(8)));
typedef float f32x4 __attribute__((ext_vector_type(4)));
typedef unsigned u32x4 __attribute__((ext_vector_type(4)));
constexpr int BM = 256, BK = 64, HALF = 128, HTB = HALF * BK * 2  , STAGE_BYTES = 8 * HTB, NXCD = 8, WGM = 8;

__host__ __device__ __forceinline__ int lds_byte(int r, int c) { const int st = (r >> 4) * 2 + (c >> 5), rr = r & 15, cc = c & 31, ob = rr * 64 + cc * 2; return st * 1024 + (ob ^ (((ob >> 9) & 1) << 5)); }
__host__ __device__ __forceinline__ void stage_rc(int b, int& R, int& C) { const int st = b / 1024, sb = b % 1024, swz = sb ^ (((sb >> 9) & 1) << 5); R = (st >> 1) * 16 + swz / 64; C = (st & 1) * 32 + (swz % 64) / 2; }
__host__ __device__ __forceinline__ int perm32(int rho) { const int n = rho >> 4, i = rho & 15; return 8 * (i >> 2) + 4 * n + (i & 3); }

struct Unit { int pm, pn; };
struct Gemm { const bf16_t* A; const bf16_t* Bt; int M, N, K; };

struct StaticOrder {
    int nM, nN, nwg, G, c;
    __host__ __device__ void init(int M, int N, int G_, int c_) { nM = M / BM; nN = N / BM; nwg = nM * nN; G = G_; c = c_; }
    __host__ __device__ bool next(int i, Unit& u) const {
        const long L = (long)i * G + c; if (L >= nwg) return false;
        int wgid = (int)L; { const int q = nwg / NXCD, r = nwg % NXCD, xcd = wgid % NXCD, off = wgid / NXCD; wgid = (xcd < r ? xcd * (q + 1) : r * (q + 1) + (xcd - r) * q) + off; }
        const int nig = WGM * nN, gid = wgid / nig, fm = gid * WGM, gsz = (nM - fm) < WGM ? (nM - fm) : WGM;
        u.pm = fm + ((wgid % nig) % gsz); u.pn = (wgid % nig) / gsz; return true;
    }
    __device__ __forceinline__ void a_ready(const Unit&) const {}
    __device__ __forceinline__ void done(const Unit&) const {}
};

__device__ __forceinline__ unsigned cvt_pk_bf16(float lo, float hi) { unsigned r; asm volatile("v_cvt_pk_bf16_f32 %0, %1, %2" : "=v"(r) : "v"(lo), "v"(hi)); return r; }
typedef float f32x2 __attribute__((ext_vector_type(2)));
__device__ __forceinline__ f32x2 gelu_pk(f32x2 v) {
    const f32x2 av = __builtin_elementwise_abs(v), d = av * 0.2316418882f + 1.0f;
    f32x2 t; t.x = __builtin_amdgcn_rcpf(d.x); t.y = __builtin_amdgcn_rcpf(d.y);
    f32x2 q = t * 0.5307027145f + (-0.7265760135f); q = q * t + 0.7107068705f; q = q * t + (-0.142248368f); q = q * t + 0.127414796f; q = q * t;
    const f32x2 s = (v * v) * (-0.72134752044f);
    f32x2 e; e.x = __builtin_amdgcn_exp2f(s.x); e.y = __builtin_amdgcn_exp2f(s.y);
    const f32x2 m = v * (q * e), r = v - m;
    f32x2 o; o.x = v.x < 0.f ? m.x : r.x; o.y = v.y < 0.f ? m.y : r.y; return o;
}

template <int ACT  > struct EpiBf16 {
    static constexpr bool PERM = true, AFTER_DRAIN = false; static_assert(ACT == 0 || ACT == 1, "EpiBf16: ACT is 0 (none) or 1 (gelu_pk)");
    bf16_t* O; int ldc; const float* bias; int split_cols; size_t split_stride; float scale0;
    __device__ __forceinline__ void operator()(const f32x4 (&acc)[2][2][4][2], const Unit& u, int wr, int wc, int fr, int fq) const {
        const int row0 = u.pm * BM + wr * 64 + fr; int colt = u.pn * BM; bf16_t* base = O;
        float sc = 1.f; if (split_cols) { const int t = colt / split_cols; base += (size_t)t * split_stride; colt -= t * split_cols; if (t == 0) sc = scale0; }
        const int col0 = colt + wc * 32 + 8 * fq, bcol0 = u.pn * BM + wc * 32 + 8 * fq;
        f32x4 bv[2][2];
#pragma unroll
        for (int bj = 0; bj < 2; ++bj)
#pragma unroll
            for (int n = 0; n < 2; ++n) bv[bj][n] = bias ? *(const f32x4*)(bias + bcol0 + bj * HALF + 4 * n) : (f32x4){0.f, 0.f, 0.f, 0.f};
#pragma unroll
        for (int ai = 0; ai < 2; ++ai)
#pragma unroll
            for (int m = 0; m < 4; ++m) { bf16_t* rowp = base + (size_t)(row0 + ai * HALF + m * 16) * ldc + col0;
#pragma unroll
                for (int bj = 0; bj < 2; ++bj) { f32x4 v0 = acc[ai][bj][m][0] + bv[bj][0], v1 = acc[ai][bj][m][1] + bv[bj][1];
                    if (ACT == 1) { f32x2 a = gelu_pk((f32x2){v0[0], v0[1]}), b = gelu_pk((f32x2){v0[2], v0[3]}), c = gelu_pk((f32x2){v1[0], v1[1]}), d = gelu_pk((f32x2){v1[2], v1[3]});
                        v0 = (f32x4){a.x, a.y, b.x, b.y}; v1 = (f32x4){c.x, c.y, d.x, d.y}; }
                    v0 = v0 * sc; v1 = v1 * sc; u32x4 w; w.x = cvt_pk_bf16(v0[0], v0[1]); w.y = cvt_pk_bf16(v0[2], v0[3]); w.z = cvt_pk_bf16(v1[0], v1[1]); w.w = cvt_pk_bf16(v1[2], v1[3]);
                    *(u32x4*)(rowp + bj * HALF) = w; } }
    }
};

typedef unsigned u32x2 __attribute__((ext_vector_type(2)));
#define H1_BF16_ONLY 1
struct EpiOut {
    static constexpr bool PERM = true, AFTER_DRAIN = false;
    const float* x; float* out; bf16_t* hb; float* sumsq; int ldc;
    __device__ __forceinline__ void operator()(const f32x4 (&acc)[2][2][4][2], const Unit& u, int wr, int wc, int fr, int fq) const {
        const int row0 = u.pm * BM + wr * 64 + fr, col0 = u.pn * BM + wc * 32 + 8 * fq;
        f32x4 xb[4][4];
#pragma unroll
        for (int gi = 0; gi < 4; ++gi) { const size_t off = (size_t)(row0 + (gi >> 2) * HALF + (gi & 3) * 16) * ldc + col0;
#pragma unroll
            for (int q = 0; q < 4; ++q) xb[gi][q] = *(const f32x4*)(x + off + (q >> 1) * HALF + (q & 1) * 4); }
#pragma unroll
        for (int gi = 0; gi < 8; ++gi) {
            const int ai = gi >> 2, m = gi & 3;
            const int row = row0 + ai * HALF + m * 16; const size_t off = (size_t)row * ldc + col0; float ss = 0.f;
#pragma unroll
            for (int bj = 0; bj < 2; ++bj) {
                const size_t o = off + bj * HALF;
                const f32x4 v0 = xb[gi & 3][bj * 2] + acc[ai][bj][m][0], v1 = xb[gi & 3][bj * 2 + 1] + acc[ai][bj][m][1];
#if !defined(H1_BF16_ONLY)
                *(f32x4*)(out + o) = v0; *(f32x4*)(out + o + 4) = v1;
#endif
                ss += ((v0[0] * v0[0] + v0[1] * v0[1]) + (v0[2] * v0[2] + v0[3] * v0[3])) + ((v1[0] * v1[0] + v1[1] * v1[1]) + (v1[2] * v1[2] + v1[3] * v1[3]));
                u32x4 w; w.x = cvt_pk_bf16(v0[0], v0[1]); w.y = cvt_pk_bf16(v0[2], v0[3]); w.z = cvt_pk_bf16(v1[0], v1[1]); w.w = cvt_pk_bf16(v1[2], v1[3]); *(u32x4*)(hb + o) = w;
            }
            if (gi + 4 < 8) { const size_t offn = (size_t)(row0 + ((gi + 4) >> 2) * HALF + ((gi + 4) & 3) * 16) * ldc + col0;
#pragma unroll
                for (int q = 0; q < 4; ++q) xb[gi & 3][q] = *(const f32x4*)(x + offn + (q >> 1) * HALF + (q & 1) * 4); }
            ss += __shfl_xor(ss, 16); ss += __shfl_xor(ss, 32);
            if (fq == 0) atomicAdd(sumsq + row, ss);
        }
    }
};
struct EpiScores {
    static constexpr bool PERM = true, AFTER_DRAIN = false;
    const float* sumsq; float* S; int ldc; float eps;
    __device__ __forceinline__ void operator()(const f32x4 (&acc)[2][2][4][2], const Unit& u, int wr, int wc, int fr, int fq) const {
        const int row0 = u.pm * BM + wr * 64 + fr, col0 = u.pn * BM + wc * 32 + 8 * fq;
        float sq[8];
#pragma unroll
        for (int gi = 0; gi < 8; ++gi) sq[gi] = sumsq[row0 + (gi >> 2) * HALF + (gi & 3) * 16];
#pragma unroll
        for (int ai = 0; ai < 2; ++ai)
#pragma unroll
            for (int m = 0; m < 4; ++m) {
                const int row = row0 + ai * HALF + m * 16; const size_t off = (size_t)row * ldc + col0;
                const float rs = __builtin_amdgcn_rsqf(sq[ai * 4 + m] * (1.0f / 2048.0f) + eps);
#pragma unroll
                for (int bj = 0; bj < 2; ++bj) { const f32x4 v0 = acc[ai][bj][m][0] * rs, v1 = acc[ai][bj][m][1] * rs;
                    u32x4 w; w.x = cvt_pk_bf16(v0[0], v0[1]); w.y = cvt_pk_bf16(v0[2], v0[3]); w.z = cvt_pk_bf16(v1[0], v1[1]); w.w = cvt_pk_bf16(v1[2], v1[3]); *(u32x4*)((bf16_t*)S + off + bj * HALF) = w; }
            }
    }
};
template <class Epi, class Sched, bool ALIGN_EPI = false, bool SP2 = false>
__device__ __forceinline__ void gemm_phase(PG8_LAS unsigned char* lds, const Gemm g, const Sched& S, const Epi& E) {
    const int tid = threadIdx.x, wid = __builtin_amdgcn_readfirstlane(tid >> 6), lane = tid & 63, wr = wid >> 2, wc = wid & 3, fr = lane & 15, fq = lane >> 4;
    const int K = g.K, nt = K / BK;
    unsigned voffA[2], voffB[2];
#pragma unroll
    for (int i = 0; i < 2; ++i) { int R, C; stage_rc(tid * 16 + i * 8192, R, C); const int Rb = Epi::PERM ? ((R & ~31) + perm32(R & 31)) : R;
        voffA[i] = (unsigned)(R * K + C) * 2u; voffB[i] = (unsigned)(Rb * K + C) * 2u; }
    const size_t kstep = (size_t)(BK * 2);
    const size_t hstep = (size_t)HALF * K * 2;
    const size_t tstep = 2 * hstep;
    const unsigned ldsw = (unsigned)wid * 1024u;
    const int aoff = lds_byte(wr * 64 + fr, fq * 8), boff = lds_byte(wc * 32 + fr, fq * 8);
#define PG8_SA(b, h) (((b) * 2 + (h)) * HTB)
#define PG8_SB(b, h) ((4 + (b) * 2 + (h)) * HTB)
#define PG8_STAGE(bufoff, gbase, voff) do { _Pragma("unroll") for (int _i = 0; _i < 2; ++_i) \
        __builtin_amdgcn_global_load_lds((const unsigned*)((const char*)(gbase) + (voff)[_i]), (PG8_LAS unsigned*)(lds + (bufoff) + ldsw + _i * 8192), 16, 0, 0); } while (0)
#define PG8_LDA(dst, b, h) do { _Pragma("unroll") for (int m = 0; m < 4; ++m) _Pragma("unroll") for (int k = 0; k < 2; ++k) dst[m][k] = *(const PG8_LAS bf16x8*)(lds + PG8_SA(b, h) + aoff + m * 2048 + k * 1024); } while (0)
#define PG8_LDB(dst, b, h) do { _Pragma("unroll") for (int n = 0; n < 2; ++n) _Pragma("unroll") for (int k = 0; k < 2; ++k) dst[n][k] = *(const PG8_LAS bf16x8*)(lds + PG8_SB(b, h) + boff + n * 2048 + k * 1024); } while (0)
#define PG8_MMA(ai, bj, At, Bt) do { __builtin_amdgcn_s_setprio(1); _Pragma("unroll") for (int m = 0; m < 4; ++m) _Pragma("unroll") for (int n = 0; n < 2; ++n) _Pragma("unroll") for (int k = 0; k < 2; ++k) \
        acc[ai][bj][m][n] = __builtin_amdgcn_mfma_f32_16x16x32_bf16(Bt[n][k], At[m][k], acc[ai][bj][m][n], 0, 0, 0); __builtin_amdgcn_s_setprio(0); } while (0)
#define PG8_WAIT_V(n) asm volatile("s_waitcnt vmcnt(" #n ")" ::: "memory")
#define PG8_WAIT_L(n) asm volatile("s_waitcnt lgkmcnt(" #n ")" ::: "memory")
#define PG8_BAR __builtin_amdgcn_s_barrier()
#define PG8_SCHED __builtin_amdgcn_sched_barrier(0)
    Unit cur, nxt; int ui = 0;
    if (!S.next(0, cur)) return;
    f32x4 acc[2][2][4][2];
#pragma unroll
    for (int a = 0; a < 2; ++a)
#pragma unroll
        for (int b = 0; b < 2; ++b)
#pragma unroll
            for (int m = 0; m < 4; ++m)
#pragma unroll
                for (int n = 0; n < 2; ++n) acc[a][b][m][n] = (f32x4){0.f, 0.f, 0.f, 0.f};
    bf16x8 At[4][2], B0[2][2], B1[2][2];
    const char* cA = (const char*)g.A + (size_t)cur.pm * tstep; const char* cB = (const char*)g.Bt + (size_t)cur.pn * tstep;
    S.a_ready(cur);
    if constexpr (SP2) {
        PG8_STAGE(PG8_SB(0, 0), cB, voffB); PG8_STAGE(PG8_SB(0, 1), cB + hstep, voffB); PG8_STAGE(PG8_SA(0, 0), cA, voffA); PG8_STAGE(PG8_SA(0, 1), cA + hstep, voffA);
        if (wr == 1) PG8_BAR;
        PG8_WAIT_V(2); PG8_BAR;
        PG8_STAGE(PG8_SB(1, 0), cB + kstep, voffB); PG8_STAGE(PG8_SA(1, 0), cA + kstep, voffA); PG8_STAGE(PG8_SB(1, 1), cB + hstep + kstep, voffB);
        PG8_WAIT_V(6); PG8_BAR;
    } else {
        PG8_STAGE(PG8_SB(0, 0), cB, voffB); PG8_STAGE(PG8_SA(0, 0), cA, voffA); PG8_STAGE(PG8_SB(0, 1), cB + hstep, voffB); PG8_STAGE(PG8_SA(0, 1), cA + hstep, voffA);
        if (wr == 1) PG8_BAR;
        PG8_WAIT_V(4); PG8_BAR;
        PG8_STAGE(PG8_SB(1, 0), cB + kstep, voffB); PG8_STAGE(PG8_SA(1, 0), cA + kstep, voffA); PG8_STAGE(PG8_SB(1, 1), cB + hstep + kstep, voffB);
        PG8_WAIT_V(6); PG8_BAR;
    }
    for (;;) {
        const bool has_next = S.next(ui + 1, nxt);
        const char* nA = has_next ? (const char*)g.A + (size_t)nxt.pm * tstep : cA; const char* nB = has_next ? (const char*)g.Bt + (size_t)nxt.pn * tstep : cB;
        for (int t = 0; t < nt; t += 2) {
            const bool last = (t == nt - 2);
            const char* a1 = cA + (size_t)(t + 1) * kstep;
            const char* a2 = last ? nA : cA + (size_t)(t + 2) * kstep; const char* b2 = last ? nB : cB + (size_t)(t + 2) * kstep;
            const char* a3 = a2 + kstep; const char* b3 = b2 + kstep;
            if (last && has_next) S.a_ready(nxt);
            if constexpr (SP2) {
            PG8_LDB(B0, 0, 0); PG8_LDB(B1, 0, 1); PG8_SCHED; PG8_LDA(At, 0, 0); PG8_STAGE(PG8_SA(1, 1), a1 + hstep, voffA);
            PG8_WAIT_V(8); PG8_WAIT_L(0); PG8_BAR; PG8_MMA(0, 0, At, B0); PG8_MMA(0, 1, At, B1); PG8_BAR; PG8_SCHED;
            PG8_LDA(At, 0, 1); PG8_STAGE(PG8_SB(0, 0), b2, voffB); PG8_STAGE(PG8_SB(0, 1), b2 + hstep, voffB); PG8_STAGE(PG8_SA(0, 0), a2, voffA);
            PG8_WAIT_V(8); PG8_WAIT_L(0); PG8_BAR; PG8_MMA(1, 0, At, B0); PG8_MMA(1, 1, At, B1); PG8_BAR; PG8_SCHED;
            PG8_LDB(B0, 1, 0); PG8_LDB(B1, 1, 1); PG8_SCHED; PG8_LDA(At, 1, 0); PG8_STAGE(PG8_SA(0, 1), a2 + hstep, voffA);
            PG8_WAIT_V(8); PG8_WAIT_L(0); PG8_BAR; PG8_MMA(0, 0, At, B0); PG8_MMA(0, 1, At, B1); PG8_BAR; PG8_SCHED;
            PG8_LDA(At, 1, 1); PG8_STAGE(PG8_SB(1, 0), b3, voffB); PG8_STAGE(PG8_SB(1, 1), b3 + hstep, voffB); PG8_STAGE(PG8_SA(1, 0), a3, voffA);
            PG8_WAIT_V(8); PG8_WAIT_L(0); PG8_BAR; PG8_MMA(1, 0, At, B0); PG8_MMA(1, 1, At, B1); PG8_BAR; PG8_SCHED;
            } else {
            PG8_LDB(B0, 0, 0); PG8_SCHED; PG8_LDA(At, 0, 0); PG8_STAGE(PG8_SA(1, 1), a1 + hstep, voffA);
            PG8_WAIT_L(8); PG8_BAR; PG8_WAIT_L(0); PG8_MMA(0, 0, At, B0); PG8_BAR; PG8_SCHED;
            PG8_LDB(B1, 0, 1); PG8_STAGE(PG8_SB(0, 0), b2, voffB);
            PG8_BAR; PG8_WAIT_L(0); PG8_MMA(0, 1, At, B1); PG8_BAR;
            PG8_LDA(At, 0, 1); PG8_STAGE(PG8_SA(0, 0), a2, voffA);
            PG8_BAR; PG8_WAIT_L(0); PG8_MMA(1, 0, At, B0); PG8_BAR; PG8_SCHED;
            PG8_STAGE(PG8_SB(0, 1), b2 + hstep, voffB);
            PG8_WAIT_V(6); PG8_BAR; PG8_MMA(1, 1, At, B1); PG8_BAR;
            PG8_LDB(B0, 1, 0); PG8_SCHED; PG8_LDA(At, 1, 0); PG8_STAGE(PG8_SA(0, 1), a2 + hstep, voffA);
            PG8_WAIT_L(8); PG8_BAR; PG8_WAIT_L(0); PG8_MMA(0, 0, At, B0); PG8_BAR; PG8_SCHED;
            PG8_LDB(B1, 1, 1); PG8_STAGE(PG8_SB(1, 0), b3, voffB);
            PG8_BAR; PG8_WAIT_L(0); PG8_MMA(0, 1, At, B1); PG8_BAR;
            PG8_LDA(At, 1, 1); PG8_STAGE(PG8_SA(1, 0), a3, voffA);
            PG8_BAR; PG8_WAIT_L(0); PG8_MMA(1, 0, At, B0); PG8_BAR; PG8_SCHED;
            PG8_STAGE(PG8_SB(1, 1), b3 + hstep, voffB);
            PG8_WAIT_V(6); PG8_BAR; PG8_MMA(1, 1, At, B1); PG8_BAR;
            }
        }
        if constexpr (ALIGN_EPI) { if (wr == 0) PG8_BAR; }
        if constexpr (!Epi::AFTER_DRAIN) { E(acc, cur, wr, wc, fr, fq); S.done(cur); }
        if (!has_next) break;
#pragma unroll
        for (int a = 0; a < 2; ++a)
#pragma unroll
            for (int b = 0; b < 2; ++b)
#pragma unroll
                for (int m = 0; m < 4; ++m)
#pragma unroll
                    for (int n = 0; n < 2; ++n) acc[a][b][m][n] = (f32x4){0.f, 0.f, 0.f, 0.f};
        cur = nxt; cA = nA; cB = nB; ++ui;
        if constexpr (ALIGN_EPI) { if (wr == 1) PG8_BAR; }
    }
    PG8_WAIT_V(0);
    if constexpr (!ALIGN_EPI) { if (wr == 0) PG8_BAR; }
    PG8_BAR;
    if constexpr (Epi::AFTER_DRAIN) { E.fused(acc, cur, wr, wc, fr, fq, lds, wid, lane); S.done(cur); }
#undef PG8_SA
#undef PG8_SB
#undef PG8_STAGE
#undef PG8_LDA
#undef PG8_LDB
#undef PG8_MMA
#undef PG8_WAIT_V
#undef PG8_WAIT_L
#undef PG8_BAR
#undef PG8_SCHED
}
}
#define GAS __attribute__((address_space(1)))
#define LAS __attribute__((address_space(3)))
typedef unsigned short bf16;
typedef unsigned v4u __attribute__((ext_vector_type(4)));
typedef float f32x4 __attribute__((ext_vector_type(4)));
typedef short bf16x8 __attribute__((ext_vector_type(8)));
typedef GAS unsigned gu32;
typedef GAS unsigned long long gu64;
#define RLX_AGENT __ATOMIC_RELAXED, __HIP_MEMORY_SCOPE_AGENT
#define LDS_WAIT() asm volatile("s_waitcnt lgkmcnt(0)" ::: "memory")
#define VM_WAIT() asm volatile("s_waitcnt vmcnt(0)" ::: "memory")
__device__ __forceinline__ unsigned long long rt() { return __builtin_amdgcn_s_memrealtime(); }
typedef __bf16 bf16x2h __attribute__((ext_vector_type(2)));
__device__ __forceinline__ unsigned f2bf(float f) { return (unsigned)__builtin_bit_cast(unsigned short, (__bf16)f); }
__device__ __forceinline__ unsigned pk2(float lo, float hi) { const bf16x2h v = {(__bf16)lo, (__bf16)hi}; return __builtin_bit_cast(unsigned, v); }

#define XB_TMO      128
#define XB_XCNT(j)  (256  + 64 * (j))
#define XB_XSUB(j)  (1280 + 64 * (j))
#define XB_XGEN(j)  (2304 + 64 * (j))
#define XB_TOP      3328
#define XB_TOPGEN   3392
#define XCD_BAR_WORDS 3456
#define XB_SPIN_CAP (1u << 18)

__device__ __forceinline__ unsigned xb_ld(unsigned* p)              { return __hip_atomic_load(p, __ATOMIC_RELAXED, __HIP_MEMORY_SCOPE_AGENT); }
__device__ __forceinline__ unsigned xb_add(unsigned* p, unsigned v) { return __hip_atomic_fetch_add(p, v, __ATOMIC_RELAXED, __HIP_MEMORY_SCOPE_AGENT); }
__device__ __forceinline__ unsigned xb_xcc_id() { return (unsigned)__builtin_amdgcn_s_getreg((3 << 11) | 20) & 0xFu; }
#define XB_SPIN(cond, bar) do { unsigned _sp = 0; while (cond) { __builtin_amdgcn_s_sleep(1); \
    if ((++_sp & 255u) == 0u) { if (xb_ld(&(bar)[XB_TMO])) break; if (_sp > XB_SPIN_CAP) { atomicAdd(&(bar)[XB_TMO], 1u); break; } } } } while (0)

struct XcdBarrier {
    unsigned* bar; unsigned x;
    volatile LAS unsigned* st;
};

__device__ __forceinline__ XcdBarrier xcd_barrier_post(unsigned* bar, volatile LAS unsigned* st) {
    XcdBarrier b; b.bar = bar; b.x = xb_xcc_id(); b.st = st;
    if (threadIdx.x == 0) (void)xb_add(&bar[XB_XCNT(b.x)], 1u);
    return b;
}
__device__ __forceinline__ void xcd_barrier_complete(unsigned* bar, unsigned x, unsigned& nloc, unsigned& nx) {
    const unsigned G = gridDim.x * gridDim.y * gridDim.z;
    unsigned sum, cnt, mine, sp = 0u;
    for (;;) {
        sum = 0u; cnt = 0u; mine = 0u;
#pragma unroll
        for (unsigned j = 0; j < 16; ++j) { const unsigned c = xb_ld(&bar[XB_XCNT(j)]); sum += c; cnt += (c > 0u) ? 1u : 0u; mine = (j == x) ? c : mine; }
        if (sum == G) break;
        __builtin_amdgcn_s_sleep(1);
        if ((++sp & 255u) == 0u) { if (xb_ld(&bar[XB_TMO])) break; if (sp > XB_SPIN_CAP) { atomicAdd(&bar[XB_TMO], 1u); break; } }
    }
    nloc = mine > 0u ? mine : 1u; nx = cnt > 0u ? cnt : 1u;
}

__device__ __forceinline__ void xcd_barrier(const XcdBarrier& b) {
    asm volatile("s_waitcnt vmcnt(0)" ::: "memory");
    __syncthreads();
    if (threadIdx.x == 0) {
        unsigned* bar = b.bar;
        __builtin_amdgcn_s_waitcnt(0);
        unsigned nloc = b.st[0], nx = b.st[1];
        if (nloc == 0u) { xcd_barrier_complete(bar, b.x, nloc, nx); b.st[0] = nloc; b.st[1] = nx; }
        const unsigned old = xb_add(&bar[XB_XSUB(b.x)], 1u);
        const unsigned gen = old / nloc;
        if (old + 1u == (gen + 1u) * nloc) {
            __builtin_amdgcn_fence(__ATOMIC_RELEASE, "agent");
            asm volatile("s_waitcnt vmcnt(0)" ::: "memory");
            const unsigned og = xb_add(&bar[XB_TOP], 1u);
            const unsigned tg = og / nx;
            if (og + 1u == (tg + 1u) * nx) xb_add(&bar[XB_TOPGEN], 1u);
            else XB_SPIN(xb_ld(&bar[XB_TOPGEN]) == tg, bar);
            __builtin_amdgcn_fence(__ATOMIC_ACQUIRE, "agent");
            xb_add(&bar[XB_XGEN(b.x)], 1u);
            asm volatile("s_waitcnt vmcnt(0)" ::: "memory");
        } else {
            XB_SPIN(xb_ld(&bar[XB_XGEN(b.x)]) == gen, bar);
            __builtin_amdgcn_fence(__ATOMIC_ACQUIRE, "agent");
            asm volatile("s_waitcnt vmcnt(0)" ::: "memory");
        }
    }
    __syncthreads();
}

#define DI __device__ __forceinline__
constexpr int NWAVES = 8, NTHR = 512;
constexpr int BATCH = 4, SEQ = 4096, DM = 2048, TR = BATCH * SEQ, NMETA = 16, MIN_ROWS = 16640;
constexpr int INC = 4640, NP = 4864;
constexpr int CQ = 0, CK = 1024, CV = 1152, CR = 1280, CPK = 2304, CPV = 3328, CW = 4352, CA = 4416, CG = 4480;
constexpr int NEXP = 16384, NSEL = 128;
constexpr float RMS_EPS = 1e-6f, GN_EPS = 64e-5f;
constexpr int NPHASE = 9;
#ifndef MK_SPLIT
#define MK_SPLIT 0
#endif

constexpr size_t MiB = 1u << 20;
constexpr size_t WS_CTL = 0, CTL_ZERO_BYTES = 1 * MiB;
constexpr size_t WS_WIN = 1 * MiB, WS_WOUT = 20 * MiB, WS_WQS = 28 * MiB, WS_SUMSQ = 36 * MiB;
constexpr size_t WS_U = 40 * MiB;
constexpr size_t WS_P = 106 * MiB;
constexpr size_t WS_TD = 262 * MiB, WS_TU = 294 * MiB;
constexpr size_t WS_SCL = 37 * MiB;
constexpr size_t WS_LW = 38 * MiB;
constexpr size_t WS_IDX = 390 * MiB, WS_GATE = 398 * MiB;
#ifndef TBL_FP6
#define TBL_FP6 1
#endif
#ifndef TBL_FP4
#define TBL_FP4 1
#endif
#ifndef DOWN_ROWSCALE
#define DOWN_ROWSCALE 1
#endif
constexpr int ROWB = TBL_FP4 ? (DOWN_ROWSCALE ? 1024 : 1088) : 1536;
#define BSCALE(s8_) __uint_as_float(((unsigned)(s8_) << 20) + 0x33800000u)
#ifndef UP_TR
#define UP_TR 1
#endif
constexpr int ROWU = 1024, UR_PITCH = 1056, UR_BUF = 8 * UR_PITCH, UR_BASE = 8192, UR_WAVE = 2 * UR_BUF;
#ifndef GATHER_SLICED
#define GATHER_SLICED 0
#endif
constexpr size_t WS_PART = 40 * MiB;
constexpr size_t WS_RW = 330 * MiB;
constexpr size_t WS_RWS = 460 * MiB;
constexpr size_t WS_END = 470 * MiB;
constexpr size_t WS_SC = 40 * MiB;
constexpr size_t WS_H1B = 170 * MiB;
static_assert(WS_U + (size_t)MIN_ROWS * DM * 2 <= WS_P && WS_P + (size_t)MIN_ROWS * NP * 2 <= WS_TD && WS_SC + (size_t)TR * DM * 4 <= WS_H1B && WS_H1B + (size_t)TR * DM * 2 <= WS_TD, "ws map");
constexpr int CW_BAR = 4096;
constexpr int RING_BYTES = 131072, LDSCTL_OFF = 159744, MISC_OFF = LDSCTL_OFF + 320, LDS_BYTES = 160256;

DI float bflo(unsigned w) { return __uint_as_float(w << 16); }
DI float bfhi(unsigned w) { return __uint_as_float(w & 0xffff0000u); }
DI float wave_sum(float v) {
#pragma unroll
    for (int o = 1; o < 64; o <<= 1) v += __shfl_xor(v, o);
    return v;
}
template <int CTRL> DI float dppf(float v) { return __int_as_float(__builtin_amdgcn_update_dpp(0, __float_as_int(v), CTRL, 0xf, 0xf, true)); }
DI float red8(float v) { v += dppf<0xB1>(v); v += dppf<0x4E>(v); v += dppf<0x141>(v); return v; }
DI float red16(float v) { v = red8(v); v += dppf<0x140>(v); return v; }
DI float max16(float v) { v = fmaxf(v, dppf<0xB1>(v)); v = fmaxf(v, dppf<0x4E>(v)); v = fmaxf(v, dppf<0x141>(v)); v = fmaxf(v, dppf<0x140>(v)); return v; }
DI float rdlane(float v, int l) { return __int_as_float(__builtin_amdgcn_readlane(__float_as_int(v), l)); }
DI float wave_max(float v) {
    v = max16(v);
    const float a = rdlane(v, 0), b = rdlane(v, 16), c = rdlane(v, 32), d = rdlane(v, 48);
    return fmaxf(fmaxf(a, b), fmaxf(c, d));
}
DI float frcp(float x) { return __builtin_amdgcn_rcpf(x); }
DI float frsq(float x) { return __builtin_amdgcn_rsqf(x); }
DI float sigmoidf_(float x) { return frcp(1.0f + __expf(-x)); }
DI float tanhf_(float x) { return 1.0f - 2.0f * frcp(1.0f + __expf(2.0f * x)); }
DI float softplusf_(float x) { return fmaxf(x, 0.f) + __logf(1.0f + __expf(-fabsf(x))); }
DI void rw_piece(int pi, int& tt, int& pc) {
    if (pi < 768) { tt = pi / 24; pc = pi - tt * 24; }
    else if (pi < 1024) { const int q = pi - 768; tt = q >> 3; pc = 24 + (q & 7); }
    else if (pi < 1280) { const int q = pi - 1024; tt = q >> 3; pc = 32 + (q & 7); }
    else { const int q = pi - 1280; tt = q / 20; pc = 40 + (q - tt * 20); }
}
typedef unsigned u32x2 __attribute__((ext_vector_type(2)));
typedef float f32x16 __attribute__((ext_vector_type(16)));
DI int kslot(int t) { return 8 * ((t & 15) >> 2) + (t & 3) + ((t & 16) >> 2); }
DI int crow(int reg, int h) { return (reg & 3) + 8 * (reg >> 2) + 4 * h; }
#define MFMA32(a, b, c) __builtin_amdgcn_mfma_f32_32x32x16_bf16((a), (b), (c), 0, 0, 0)
#define MFMA16(a, b, c) __builtin_amdgcn_mfma_f32_16x16x32_bf16((a), (b), (c), 0, 0, 0)
#define LBAR() do { asm volatile("s_waitcnt lgkmcnt(0)" ::: "memory"); __builtin_amdgcn_s_barrier(); asm volatile("" ::: "memory"); } while (0)

struct Frame {
    LAS unsigned char* lds;
    volatile LAS unsigned* MISC;
    gu32* ctl;
    int tid, lane, wave;
    int vcu, G;
    const float* in[24];
    float* out; unsigned char* ws;
};
#define IN_X 0
#define IN_META 1
#define IN_N1G 2
#define IN_WIN 3
#define IN_MU 4
#define IN_W0 5
#define IN_WUP 6
#define IN_A0 7
#define IN_AUP 8
#define IN_GUP 9
#define IN_KK 10
#define IN_KA 11
#define IN_RK 12
#define IN_GNW 13
#define IN_GNB 14
#define IN_QG 15
#define IN_KG 16
#define IN_SINK 17
#define IN_WOUT 18
#define IN_N2G 19
#define IN_PQ 20
#define IN_PSK 21
#define IN_PD 22
#define IN_PU 23

DI void p0_transpose_item(const float* W, int K, int N, bf16* WT, int row_off, LAS float* scr, int item, int lane) {
    const int nblk = N / 32, kb = item / nblk, nb = item % nblk, k0 = 64 * kb, n0 = 32 * nb;
#pragma unroll 8
    for (int i = 0; i < 32; ++i) { const int kk = 2 * i + (lane >> 5); scr[kk * 33 + (lane & 31)] = W[(size_t)(k0 + kk) * N + n0 + (lane & 31)]; }
    LDS_WAIT(); asm volatile("" ::: "memory");
    const int c = lane & 7;
#pragma unroll
    for (int j = 0; j < 4; ++j) { const int n = (lane >> 3) + 8 * j; const LAS float* s = scr + (8 * c) * 33 + n;
        v4u o; o.x = pk2(s[0 * 33], s[1 * 33]); o.y = pk2(s[2 * 33], s[3 * 33]); o.z = pk2(s[4 * 33], s[5 * 33]); o.w = pk2(s[6 * 33], s[7 * 33]);
        *(GAS v4u*)(WT + (size_t)(row_off + n0 + n) * K + k0 + 8 * c) = o; }
    LDS_WAIT(); asm volatile("" ::: "memory");
}
DI void rms_row_to_bf16(const float* xrow, const float* g, bf16* orow, int lane) {
    const GAS f32x4* xr = (const GAS f32x4*)xrow + lane; const GAS f32x4* gr = (const GAS f32x4*)g + lane;
    f32x4 v[8]; float s = 0.f;
#pragma unroll
    for (int j = 0; j < 8; ++j) { v[j] = xr[64 * j]; s += (v[j].x * v[j].x + v[j].y * v[j].y) + (v[j].z * v[j].z + v[j].w * v[j].w); }
    const float rs = 1.0f / sqrtf(wave_sum(s) * (1.0f / DM) + RMS_EPS);
    GAS unsigned long long* o8 = (GAS unsigned long long*)orow + lane;
#pragma unroll
    for (int j = 0; j < 8; ++j) { const f32x4 gg = gr[64 * j];
        o8[64 * j] = (unsigned long long)pk2(v[j].x * rs * gg.x, v[j].y * rs * gg.y) | ((unsigned long long)pk2(v[j].z * rs * gg.z, v[j].w * rs * gg.w) << 32); }
}
#ifndef P0_REP
#define P0_REP 0
#endif
DI void p0_prologue(Frame& F) {
    const int tid = F.tid, lane = F.lane, wave = F.wave;
    const int gw = F.vcu * NWAVES + wave, NGW = F.G * NWAVES;
    const size_t gt = (size_t)blockIdx.x * NTHR + tid, NT = (size_t)F.G * NTHR;
    bf16* Win_t = (bf16*)(F.ws + WS_WIN); bf16* Wout_t = (bf16*)(F.ws + WS_WOUT); bf16* Wqs_t = (bf16*)(F.ws + WS_WQS);
    bf16* U = (bf16*)(F.ws + WS_U);
    float* sumsq = (float*)(F.ws + WS_SUMSQ);
    for (int rp_ = 0; rp_ < ((P0_REP & 1) ? 2 : 1); ++rp_)
    {
        LAS float* scr = (LAS float*)(F.lds + wave * 16384);
        constexpr int I_IN = (DM / 64) * (INC / 32), I_OUT = (DM / 64) * (DM / 32);
        for (int it = gw; it < I_IN + I_OUT; it += NGW) {
            if (it < I_IN) p0_transpose_item(F.in[IN_WIN], DM, INC, Win_t, 0, scr, it, lane);
            else p0_transpose_item(F.in[IN_WOUT], DM, DM, Wout_t, 0, scr, it - I_IN, lane);
        }
        const size_t nz = (size_t)(NP - INC) * DM * 2 / 16;
        GAS v4u* z = (GAS v4u*)(Win_t + (size_t)INC * DM);
        for (size_t i = gt; i < nz; i += NT) z[i] = (v4u){0u, 0u, 0u, 0u};
    }
    for (int rp_ = 0; rp_ < ((P0_REP & 2) ? 2 : 1); ++rp_)
    for (int m = gw; m < MIN_ROWS; m += NGW) {
        if (m < TR) rms_row_to_bf16(F.in[IN_X] + (size_t)m * DM, F.in[IN_N1G], U + (size_t)m * DM, lane);
        else if (m < TR + NMETA) rms_row_to_bf16(F.in[IN_META] + (size_t)(m - TR) * DM, F.in[IN_N1G], U + (size_t)m * DM, lane);
        else { GAS v4u* o = (GAS v4u*)(U + (size_t)m * DM) + lane;
#pragma unroll
            for (int j = 0; j < 4; ++j) o[64 * j] = (v4u){0u, 0u, 0u, 0u}; }
    }
#if TBL_FP6 && !GATHER_SLICED
    for (int rp_ = 0; rp_ < ((P0_REP & 4) ? 2 : 1); ++rp_)
    {
        unsigned char* T8D = F.ws + WS_TD; unsigned char* T8U = F.ws + WS_TU; float* SCL = (float*)(F.ws + WS_SCL);
        const float* g2 = F.in[IN_N2G];
        typedef float f32x16v __attribute__((ext_vector_type(16)));
        f32x4 nv[8];
        if (gw < 2 * NEXP) { const float* src = (gw >= NEXP ? F.in[IN_PU] + (size_t)(gw - NEXP) * DM : F.in[IN_PD] + (size_t)gw * DM) + lane * 4;
#pragma unroll
            for (int j = 0; j < 8; ++j) nv[j] = *(const GAS f32x4*)(src + 256 * j); }
#pragma unroll 1
        for (int row = gw; row < 2 * NEXP; row += NGW) {
            const bool up = row >= NEXP; const int e = up ? row - NEXP : row;
            f32x4 v[8]; float m = 0.f;
#pragma unroll
            for (int j = 0; j < 8; ++j) v[j] = nv[j];
            { const int nr = row + NGW < 2 * NEXP ? row + NGW : row; const float* src = (nr >= NEXP ? F.in[IN_PU] + (size_t)(nr - NEXP) * DM : F.in[IN_PD] + (size_t)nr * DM) + lane * 4;
#pragma unroll
              for (int j = 0; j < 8; ++j) nv[j] = *(const GAS f32x4*)(src + 256 * j); }
#pragma unroll
            for (int j = 0; j < 8; ++j) {
                f32x4 a = v[j];
                if (!up) a = a * *(const GAS f32x4*)(g2 + 256 * j + lane * 4);
                v[j] = a; m = fmaxf(m, fmaxf(fmaxf(fabsf(a.x), fabsf(a.y)), fmaxf(fabsf(a.z), fabsf(a.w))));
            }
#if TBL_FP4 && UP_TR
            if (up) {
                const float mr = wave_max(m); const float su = mr > 0.f ? mr * (1.0f / 7.0f) : 1.0f, inv = mr > 0.f ? 7.0f / mr : 0.f;
                v4u d;
#pragma unroll
                for (int w = 0; w < 4; ++w) { unsigned o = 0u;
#pragma unroll
                    for (int i = 7; i >= 0; --i) { const f32x4 vv = v[2 * w + (i >> 2)]; const float x_ = (i & 3) == 0 ? vv.x : (i & 3) == 1 ? vv.y : (i & 3) == 2 ? vv.z : vv.w;
                        o = (o << 4) | (__float_as_uint(x_ * inv + 12582912.0f) & 15u); }
                    d[w] = o; }
                *(GAS v4u*)(T8U + (size_t)e * ROWU + 16 * lane) = d;
                if (lane == 0) SCL[row] = su;
                continue;
            }
#endif
#if TBL_FP4
            {
#if DOWN_ROWSCALE
                const float mr_ = wave_max(m); float bsf = mr_ > 0.f ? mr_ * (1.0f / 6.0f) : 1.0f; const unsigned bsb = 0u;
                if (lane == 0) SCL[row] = bsf;
#else
                float bsf = m > 0.f ? m * (1.0f / 6.0f) : 1.0f;
                unsigned bsb = (__float_as_uint(bsf) + 0xfffffu) >> 20;
                bsb = bsb < 824u ? 0u : (bsb - 824u > 255u ? 255u : bsb - 824u); bsf = BSCALE(bsb);
#endif
                const float inv = 1.0f / bsf;
                v4u d;
#pragma unroll
                for (int w = 0; w < 4; ++w) { unsigned o = 0u;
                    o = __builtin_amdgcn_cvt_scalef32_pk_fp4_f32(o, v[2 * w].x * inv, v[2 * w].y * inv, 1.0f, 0);
                    o = __builtin_amdgcn_cvt_scalef32_pk_fp4_f32(o, v[2 * w].z * inv, v[2 * w].w * inv, 1.0f, 1);
                    o = __builtin_amdgcn_cvt_scalef32_pk_fp4_f32(o, v[2 * w + 1].x * inv, v[2 * w + 1].y * inv, 1.0f, 2);
                    o = __builtin_amdgcn_cvt_scalef32_pk_fp4_f32(o, v[2 * w + 1].z * inv, v[2 * w + 1].w * inv, 1.0f, 3);
                    d[w] = o; }
                unsigned char* dst = (up ? T8U : T8D) + (size_t)e * ROWB;
                *(GAS v4u*)(dst + 16 * lane) = d; if (!DOWN_ROWSCALE) *(GAS unsigned char*)(dst + 1024 + lane) = (unsigned char)bsb;
                continue;
            }
#endif
            m = wave_max(m);
            const float sc = m > 0.f ? 7.0f / m : 1.0f;
            f32x16v x0, x1;
#pragma unroll
            for (int j = 0; j < 8; ++j) { x0[2 * j] = v[j].x * sc; x1[2 * j] = v[j].y * sc; x0[2 * j + 1] = v[j].z * sc; x1[2 * j + 1] = v[j].w * sc; }
            const auto pk = __builtin_amdgcn_cvt_scalef32_2xpk16_fp6_f32(x0, x1, 1.0f);
            unsigned char* dst = (up ? T8U : T8D) + (size_t)e * 1536 + lane * 24;
            *(GAS u32x2*)(dst) = (u32x2){pk[0], pk[1]}; *(GAS u32x2*)(dst + 8) = (u32x2){pk[2], pk[3]}; *(GAS u32x2*)(dst + 16) = (u32x2){pk[4], pk[5]};
            if (lane == 0) SCL[row] = m > 0.f ? m * (1.0f / 7.0f) : 1.0f;
        }
    }
#else
    {
        unsigned char* T8D = F.ws + WS_TD; unsigned char* T8U = F.ws + WS_TU; float* SCL = (float*)(F.ws + WS_SCL);
        const float* g2 = F.in[IN_N2G];
        for (int row = gw; row < 2 * NEXP; row += NGW) {
            const bool up = row >= NEXP; const int e = up ? row - NEXP : row;
            const float* src = (up ? F.in[IN_PU] : F.in[IN_PD]) + (size_t)e * DM;
            f32x4 v[2][4]; float m = 0.f;
#pragma unroll
            for (int c = 0; c < 2; ++c)
#pragma unroll
                for (int j = 0; j < 4; ++j) {
                    const int col = c * 1024 + lane * 16 + j * 4;
                    f32x4 a = *(const GAS f32x4*)(src + col);
                    if (!up) a = a * *(const GAS f32x4*)(g2 + col);
                    v[c][j] = a; m = fmaxf(m, fmaxf(fmaxf(fabsf(a.x), fabsf(a.y)), fmaxf(fabsf(a.z), fabsf(a.w))));
                }
            m = wave_max(m);
            const float sc = m > 0.f ? 440.0f / m : 1.0f;
#pragma unroll
            for (int c = 0; c < 2; ++c) {
                v4u o; unsigned w;
                w = (unsigned)__builtin_amdgcn_cvt_pk_fp8_f32(v[c][0].x * sc, v[c][0].y * sc, 0, false); w = (unsigned)__builtin_amdgcn_cvt_pk_fp8_f32(v[c][0].z * sc, v[c][0].w * sc, (int)w, true); o.x = w;
                w = (unsigned)__builtin_amdgcn_cvt_pk_fp8_f32(v[c][1].x * sc, v[c][1].y * sc, 0, false); w = (unsigned)__builtin_amdgcn_cvt_pk_fp8_f32(v[c][1].z * sc, v[c][1].w * sc, (int)w, true); o.y = w;
                w = (unsigned)__builtin_amdgcn_cvt_pk_fp8_f32(v[c][2].x * sc, v[c][2].y * sc, 0, false); w = (unsigned)__builtin_amdgcn_cvt_pk_fp8_f32(v[c][2].z * sc, v[c][2].w * sc, (int)w, true); o.z = w;
                w = (unsigned)__builtin_amdgcn_cvt_pk_fp8_f32(v[c][3].x * sc, v[c][3].y * sc, 0, false); w = (unsigned)__builtin_amdgcn_cvt_pk_fp8_f32(v[c][3].z * sc, v[c][3].w * sc, (int)w, true); o.w = w;
#if GATHER_SLICED
                *(GAS v4u*)((up ? T8U : T8D) + (size_t)(4 * c + (lane >> 4)) * ((size_t)NEXP * 256) + (size_t)e * 256 + (lane & 15) * 16) = o;
#else
                *(GAS v4u*)((up ? T8U : T8D) + (size_t)e * DM + c * 1024 + lane * 16) = o;
#endif
            }
            if (lane == 0) SCL[row] = m > 0.f ? m * (1.0f / 440.0f) : 1.0f;
        }
    }
#endif
    {
        bf16* LWU = (bf16*)(F.ws + WS_LW); bf16* LWA = LWU + 1024 * 64; bf16* LWG = LWA + 1024 * 64;
        for (size_t i = gt; i < (size_t)1024 * 64; i += NT) { const int n = (int)(i >> 6), k = (int)(i & 63); LWU[i] = (bf16)f2bf(F.in[IN_WUP][k * 1024 + n]); LWA[i] = (bf16)f2bf(F.in[IN_AUP][k * 1024 + n]); }
        for (size_t i = gt; i < (size_t)1024 * 160; i += NT) { const int n = (int)(i / 160), k = (int)(i % 160); LWG[i] = (bf16)f2bf(F.in[IN_GUP][k * 1024 + n]); }
    }
    for (size_t i = gt; i < (size_t)TR; i += NT) sumsq[i] = 0.f;
    __syncthreads();
    for (int rp_ = 0; rp_ < ((P0_REP & 8) ? 2 : 1); ++rp_)
    {
        LAS float* sk = (LAS float*)F.lds;
        LAS float* wq = (LAS float*)(F.lds + 128 * 132 * 4);
        const float* PQ = F.in[IN_PQ]; const float* PSK = F.in[IN_PSK]; const float* g2 = F.in[IN_N2G];
        for (int unit = F.vcu; unit < 256; unit += F.G) {
            const int hc = unit >> 4, k0 = (unit & 15) * 128;
            for (int i = tid; i < 128 * 32; i += NTHR) { const int n = i >> 5, d4 = (i & 31) * 4; *(LAS f32x4*)(sk + n * 132 + d4) = *(const GAS f32x4*)(PSK + (size_t)hc * 16384 + n * 128 + d4); }
            for (int i = tid; i < 128 * 32; i += NTHR) { const int k = i >> 5, d4 = (i & 31) * 4; *(LAS f32x4*)(wq + k * 132 + d4) = *(const GAS f32x4*)(PQ + (size_t)(k0 + k) * DM + hc * 128 + d4); }
            __syncthreads();
#pragma unroll 1
            for (int kh = 0; kh < 2; ++kh) {
                const int kb = 2 * kh + (wave & 1), nb = wave >> 1, r_ = lane & 31, h_ = lane >> 5;
                f32x16 acc;
#pragma unroll
                for (int g = 0; g < 16; ++g) acc[g] = 0.f;
                const LAS float* ar = wq + (32 * kb + r_) * 132 + 8 * h_; const LAS float* br = sk + (32 * nb + r_) * 132 + 8 * h_;
#pragma unroll 2
                for (int st = 0; st < 8; ++st) {
                    const f32x4 a0 = *(const LAS f32x4*)(ar + 16 * st), a1 = *(const LAS f32x4*)(ar + 16 * st + 4), b0 = *(const LAS f32x4*)(br + 16 * st), b1 = *(const LAS f32x4*)(br + 16 * st + 4);
                    unsigned ah[4], al[4], bh[4], bl[4];
#define HL_SPLIT(v0, v1, oh, ol) do { oh = pg8::cvt_pk_bf16(v0, v1); ol = pg8::cvt_pk_bf16((v0) - bflo(oh), (v1) - bfhi(oh)); } while (0)
                    HL_SPLIT(a0.x, a0.y, ah[0], al[0]); HL_SPLIT(a0.z, a0.w, ah[1], al[1]); HL_SPLIT(a1.x, a1.y, ah[2], al[2]); HL_SPLIT(a1.z, a1.w, ah[3], al[3]);
                    HL_SPLIT(b0.x, b0.y, bh[0], bl[0]); HL_SPLIT(b0.z, b0.w, bh[1], bl[1]); HL_SPLIT(b1.x, b1.y, bh[2], bl[2]); HL_SPLIT(b1.z, b1.w, bh[3], bl[3]);
                    const bf16x8 Ah = __builtin_bit_cast(bf16x8, (v4u){ah[0], ah[1], ah[2], ah[3]}), Al = __builtin_bit_cast(bf16x8, (v4u){al[0], al[1], al[2], al[3]});
                    const bf16x8 Bh = __builtin_bit_cast(bf16x8, (v4u){bh[0], bh[1], bh[2], bh[3]}), Bl = __builtin_bit_cast(bf16x8, (v4u){bl[0], bl[1], bl[2], bl[3]});
                    acc = MFMA32(Ah, Bh, acc); acc = MFMA32(Ah, Bl, acc); acc = MFMA32(Al, Bh, acc);
                }
                const int n = 32 * nb + r_;
#pragma unroll
                for (int g4 = 0; g4 < 4; ++g4) { const int k = k0 + 32 * kb + 8 * g4 + 4 * h_;
                    const f32x4 gg = *(const GAS f32x4*)(g2 + k);
                    u32x2 o; o.x = pg8::cvt_pk_bf16(acc[4 * g4] * gg.x, acc[4 * g4 + 1] * gg.y); o.y = pg8::cvt_pk_bf16(acc[4 * g4 + 2] * gg.z, acc[4 * g4 + 3] * gg.w);
                    *(GAS u32x2*)(Wqs_t + (size_t)(hc * 128 + n) * DM + k) = o; }
            }
            __syncthreads();
        }
    }
}

DI int attn_keyrow(int b, int n, int kk) {
    if (kk >= 128) return b * SEQ + 128 * n + (kk - 128);
    if (n > 0) return b * SEQ + 128 * (n - 1) + kk;
    return kk >= 112 ? TR + (kk - 112) : -1;
}
DI void attn_unit(Frame& F, int u) {
    const int tid = F.tid, lane = F.lane, wave = F.wave;
    const int b = u >> 6, kvh = (u >> 5) & 1, n = u & 31;
    const bf16* P = (const bf16*)(F.ws + WS_P); bf16* Y = (bf16*)(F.ws + WS_U);
    LAS bf16* Ks = (LAS bf16*)F.lds;
    LAS bf16* VT = (LAS bf16*)(F.lds + 256 * 144);
    const float* kg = F.in[IN_KG]; const float* qg = F.in[IN_QG];
    for (int c = tid; c < 2048; c += NTHR) {
        const int key = c >> 3, ch = c & 7; const int row = attn_keyrow(b, n, key);
        v4u rk = (v4u){0u, 0u, 0u, 0u}, rv = (v4u){0u, 0u, 0u, 0u};
        if (row >= 0) { rk = *(const GAS v4u*)(P + (size_t)row * NP + CK + kvh * 64 + ch * 8); rv = *(const GAS v4u*)(P + (size_t)row * NP + CV + kvh * 64 + ch * 8); }
        float kv[8] = {bflo(rk.x), bfhi(rk.x), bflo(rk.y), bfhi(rk.y), bflo(rk.z), bfhi(rk.z), bflo(rk.w), bfhi(rk.w)};
        float ss = 0.f;
#pragma unroll
        for (int e = 0; e < 8; ++e) ss += kv[e] * kv[e];
        ss = red8(ss);
        const float rs = frsq(ss * (1.0f / 64.0f) + RMS_EPS);
#pragma unroll
        for (int e = 0; e < 8; ++e) kv[e] = kv[e] * rs * kg[ch * 8 + e];
        v4u o; o.x = pk2(kv[0], kv[1]); o.y = pk2(kv[2], kv[3]); o.z = pk2(kv[4], kv[5]); o.w = pk2(kv[6], kv[7]);
        *(LAS v4u*)(Ks + key * 72 + ch * 8) = o;
        LAS bf16* vt = VT + (ch * 8) * 260 + key;
        vt[0 * 260] = (bf16)(rv.x & 0xffffu); vt[1 * 260] = (bf16)(rv.x >> 16); vt[2 * 260] = (bf16)(rv.y & 0xffffu); vt[3 * 260] = (bf16)(rv.y >> 16);
        vt[4 * 260] = (bf16)(rv.z & 0xffffu); vt[5 * 260] = (bf16)(rv.z >> 16); vt[6 * 260] = (bf16)(rv.w & 0xffffu); vt[7 * 260] = (bf16)(rv.w >> 16);
    }
    __syncthreads();
    const int r = lane & 31, hh = lane >> 5, hq = kvh * 8 + wave;
    const float sink = F.in[IN_SINK][hq];
    v4u rawn[4];
#pragma unroll
    for (int s4 = 0; s4 < 4; ++s4) rawn[s4] = *(const GAS v4u*)(P + (size_t)(b * SEQ + 128 * n + r) * NP + CQ + hq * 64 + 16 * s4 + 8 * hh);
#pragma unroll 1
    for (int qb = 0; qb < 4; ++qb) {
        const int qi = 32 * qb + r;
        const size_t qrow = (size_t)(b * SEQ + 128 * n + qi);
        bf16x8 qf[4];
        {
            v4u raw[4]; float ss = 0.f;
#pragma unroll
            for (int s4 = 0; s4 < 4; ++s4) raw[s4] = rawn[s4];
            { const size_t qrn = (size_t)(b * SEQ + 128 * n + 32 * (qb < 3 ? qb + 1 : 3) + r);
#pragma unroll
              for (int s4 = 0; s4 < 4; ++s4) rawn[s4] = *(const GAS v4u*)(P + qrn * NP + CQ + hq * 64 + 16 * s4 + 8 * hh); }
#pragma unroll
            for (int s4 = 0; s4 < 4; ++s4) {
                const float q0 = bflo(raw[s4].x), q1 = bfhi(raw[s4].x), q2 = bflo(raw[s4].y), q3 = bfhi(raw[s4].y), q4 = bflo(raw[s4].z), q5 = bfhi(raw[s4].z), q6 = bflo(raw[s4].w), q7 = bfhi(raw[s4].w);
                ss += (q0 * q0 + q1 * q1) + (q2 * q2 + q3 * q3) + (q4 * q4 + q5 * q5) + (q6 * q6 + q7 * q7);
            }
            ss += __shfl_xor(ss, 32);
            const float rs = 0.125f * frsq(ss * (1.0f / 64.0f) + RMS_EPS);
#pragma unroll
            for (int s4 = 0; s4 < 4; ++s4) {
                const float* gq = qg + 16 * s4 + 8 * hh;
                v4u w;
                w.x = pk2(bflo(raw[s4].x) * rs * gq[0], bfhi(raw[s4].x) * rs * gq[1]);
                w.y = pk2(bflo(raw[s4].y) * rs * gq[2], bfhi(raw[s4].y) * rs * gq[3]);
                w.z = pk2(bflo(raw[s4].z) * rs * gq[4], bfhi(raw[s4].z) * rs * gq[5]);
                w.w = pk2(bflo(raw[s4].w) * rs * gq[6], bfhi(raw[s4].w) * rs * gq[7]);
                qf[s4] = __builtin_bit_cast(bf16x8, w);
            }
        }
        f32x16 acc[5];
        float mx = sink;
#pragma unroll
        for (int j = 0; j < 5; ++j) {
            const int kt = qb + j;
#pragma unroll
            for (int g = 0; g < 16; ++g) acc[j][g] = 0.f;
#pragma unroll
            for (int s4 = 0; s4 < 4; ++s4) { const bf16x8 a = *(const LAS bf16x8*)(Ks + (32 * kt + r) * 72 + 16 * s4 + 8 * hh); acc[j] = MFMA32(a, qf[s4], acc[j]); }
#pragma unroll
            for (int g = 0; g < 16; ++g) {
                const int kk = 32 * kt + crow(g, hh);
                const bool valid = (kk < 128) ? (kk > qi && (n > 0 || kk >= 112)) : (kk - 128 <= qi);
                const float sv = valid ? acc[j][g] : -INFINITY;
                acc[j][g] = sv; mx = fmaxf(mx, sv);
            }
        }
        mx = fmaxf(mx, __shfl_xor(mx, 32));
        float l = 0.f;
#pragma unroll
        for (int j = 0; j < 5; ++j)
#pragma unroll
            for (int g = 0; g < 16; ++g) { const float p = __expf(acc[j][g] - mx); acc[j][g] = p; l += p; }
        l += __shfl_xor(l, 32);
        l += __expf(sink - mx);
        const float inv = frcp(l);
        f32x16 o[2];
#pragma unroll
        for (int g = 0; g < 16; ++g) { o[0][g] = 0.f; o[1][g] = 0.f; }
#pragma unroll
        for (int j = 0; j < 5; ++j) {
            const int kt = qb + j;
#pragma unroll
            for (int s2 = 0; s2 < 2; ++s2) {
                v4u w;
                w.x = pk2(acc[j][8 * s2 + 0], acc[j][8 * s2 + 1]); w.y = pk2(acc[j][8 * s2 + 2], acc[j][8 * s2 + 3]);
                w.z = pk2(acc[j][8 * s2 + 4], acc[j][8 * s2 + 5]); w.w = pk2(acc[j][8 * s2 + 6], acc[j][8 * s2 + 7]);
                const bf16x8 pb = __builtin_bit_cast(bf16x8, w);
#pragma unroll
                for (int dt = 0; dt < 2; ++dt) {
                    const LAS bf16* vp = VT + (32 * dt + r) * 260 + 32 * kt + 16 * s2 + 4 * hh;
                    const u32x2 lo = *(const LAS u32x2*)vp, hi = *(const LAS u32x2*)(vp + 8);
                    v4u av; av.x = lo.x; av.y = lo.y; av.z = hi.x; av.w = hi.y;
                    o[dt] = MFMA32(__builtin_bit_cast(bf16x8, av), pb, o[dt]);
                }
            }
        }
#pragma unroll
        for (int dt = 0; dt < 2; ++dt)
#pragma unroll
            for (int gg = 0; gg < 4; ++gg) {
                u32x2 w; w.x = pk2(o[dt][4 * gg + 0] * inv, o[dt][4 * gg + 1] * inv); w.y = pk2(o[dt][4 * gg + 2] * inv, o[dt][4 * gg + 3] * inv);
                *(GAS u32x2*)(Y + qrow * DM + 1024 + hq * 64 + 32 * dt + 8 * gg + 4 * hh) = w;
            }
    }
    __syncthreads();
}

constexpr int RC = 32;
DI int rwkv_row(int b, int sg) { return sg >= 32 ? b * SEQ + (sg - 32) : (sg >= 16 ? TR + (sg - 16) : -1); }
constexpr int RW_NCH = (32 + SEQ) / 32, RW_SEG0 = 33, RW_SEGN = 32;
DI void rwkv_pass1(Frame& F, int unit) {
    const int tid = F.tid, lane = F.lane, wave = F.wave;
    const int bh = unit & 63, seg = unit >> 6;
    const int b = bh >> 4, h = bh & 15;
    const int c_lo = seg == 0 ? 0 : RW_SEG0 + RW_SEGN * (seg - 1), c_hi = RW_SEG0 + RW_SEGN * seg;
    unsigned char* const blob0 = F.ws + WS_RW + (size_t)bh * RW_NCH * 16384;
    float* const HS = (float*)(F.ws + WS_RWS) + (size_t)(bh * 4 + seg) * 8192;
    const bf16* P = (const bf16*)(F.ws + WS_P); bf16* Y = (bf16*)(F.ws + WS_U);
    const bf16* LWU = (const bf16*)(F.ws + WS_LW); const bf16* LWA = LWU + 1024 * 64; const bf16* LWG = LWA + 1024 * 64;
    LAS float* XR = (LAS float*)(F.lds + 0);
    LAS float* XK = (LAS float*)(F.lds + 8192);
    LAS float* XV = (LAS float*)(F.lds + 16384);
    LAS float* LD = (LAS float*)(F.lds + 24576);
    LAS float* AA = (LAS float*)(F.lds + 32768);
    LAS float* GG = (LAS float*)(F.lds + 40960);
    LAS bf16* TW = (LAS bf16*)(F.lds + 57344);
    LAS bf16* XA = (LAS bf16*)(F.lds + 57344 + 4608);
    LAS bf16* SG = (LAS bf16*)(F.lds + 57344 + 9216);
    LAS bf16* At = (LAS bf16*)(F.lds + 57344);
    LAS bf16* Rt = At + 32 * 72; LAS bf16* Bt = Rt + 32 * 72; LAS bf16* Kt = Bt + 32 * 72;
    LAS bf16* BTt = (LAS bf16*)(F.lds + 77312);
    LAS bf16* KTt = BTt + 64 * 40; LAS bf16* VT = KTt + 64 * 40;
    LAS bf16* LAK = (LAS bf16*)(F.lds + 92672);
    LAS bf16* MRB = LAK + 32 * 40; LAS bf16* MRK = MRB + 32 * 40; LAS bf16* LAB = MRK + 32 * 40;
    LAS float* LAB32 = (LAS float*)(F.lds + 102912);
    LAS bf16* TJ = (LAS bf16*)(F.lds + 107520);
    LAS float* GAM = (LAS float*)(F.lds + 110080);
    LAS bf16* SwAll = (LAS bf16*)(F.lds + 118528);
    LAS bf16* USCAll = (LAS bf16*)(F.lds + 0);
    LAS bf16* UTAll = (LAS bf16*)(F.lds + 10240);
    LAS float* MUL = (LAS float*)(F.lds + 49152);
    LAS float* HC = (LAS float*)(F.lds + 49152 + 1920);
    LAS bf16* GUt = (LAS bf16*)(F.lds + 137984);
    __syncthreads();
    for (int i = tid; i < (110336 - 107520) / 4; i += NTHR) ((LAS unsigned*)(F.lds + 107520))[i] = 0u;
    for (int i = tid; i < 32 * 40 / 2; i += NTHR) ((LAS unsigned*)LAB)[i] = 0u;
    if (tid < 480) { const int pc = tid >> 3, e = tid & 7; const int mui = pc < 8 ? h * 64 + pc * 8 : (pc < 16 ? 1024 + h * 64 + (pc - 8) * 8 : (pc < 24 ? 2048 + h * 64 + (pc - 16) * 8 : 3072 + (pc - 24) * 8)); MUL[tid] = F.in[IN_MU][mui + e]; }
    if (tid < 448) { const int q = tid >> 6, j = tid & 63; const float* src = q == 0 ? F.in[IN_W0] : (q == 1 ? F.in[IN_A0] : (q == 2 ? F.in[IN_KK] : (q == 3 ? F.in[IN_KA] : (q == 4 ? F.in[IN_RK] : (q == 5 ? F.in[IN_GNW] : F.in[IN_GNB]))))); HC[tid] = src[h * 64 + j]; }
    const int cw = wave & 3; const bool idw = wave >= 4;
    LAS bf16* Sw = SwAll + wave * 16 * 72; LAS bf16* USC = USCAll + wave * 16 * 40; LAS bf16* UT = UTAll + wave * 16 * 40;
    f32x4 accZ[4];
    {
        const int r16i = lane & 15, kqi = lane >> 4;
#pragma unroll
        for (int q = 0; q < 4; ++q) {
#pragma unroll
            for (int e = 0; e < 4; ++e) accZ[q][e] = (idw && (16 * q + 4 * kqi + e == 16 * cw + r16i)) ? 1.f : 0.f;
            *(LAS u32x2*)(Sw + r16i * 72 + 16 * q + 4 * kqi) = (u32x2){pk2(accZ[q][0], accZ[q][1]), pk2(accZ[q][2], accZ[q][3])};
        }
    }
    const int lmat = wave >= 6 ? 0 : wave >> 1, lnt = wave & 1;
    const bool dhalf = wave >= 6;
    bf16x8 bw[4];
    {
        const int r = lane & 31, hh = lane >> 5;
        const bf16* Bg = (lmat == 1 ? LWA : LWU) + (size_t)(h * 64 + 32 * lnt + r) * 64 + 8 * hh;
#pragma unroll
        for (int sx = 0; sx < 4; ++sx) bw[sx] = __builtin_bit_cast(bf16x8, *(const GAS v4u*)(Bg + 16 * sx));
    }
    for (int i = tid; i < 64 * 20; i += NTHR) { const int nn = i / 20, k8 = (i % 20) * 8; *(LAS v4u*)(GUt + nn * 168 + k8) = *(const GAS v4u*)(LWG + (size_t)(h * 64 + nn) * 160 + k8); }
    v4u pfc[4], pfp[4];
    int pdA, pdB;
    { int t0, p0, t1, p1, t2, p2, t3 = 0, p3 = 40; rw_piece(tid, t0, p0); rw_piece(tid + NTHR, t1, p1); rw_piece(tid + 2 * NTHR, t2, p2); if (tid + 3 * NTHR < RC * 60) rw_piece(tid + 3 * NTHR, t3, p3);
      pdA = t0 | (p0 << 8) | (t1 << 16) | (p1 << 24); pdB = t2 | (p2 << 8) | (t3 << 16) | (p3 << 24); }
#define RW_TT(it, pa, pb) ((int)(((unsigned)((it) < 2 ? (pa) : (pb)) >> (16 * ((it) & 1))) & 0xffu))
#define RW_PC(it, pa, pb) ((int)(((unsigned)((it) < 2 ? (pa) : (pb)) >> (16 * ((it) & 1) + 8)) & 0xffu))
#define RW_LOADK(it, cc, pa, pb) do { const int tt = RW_TT(it, pa, pb), pc = RW_PC(it, pa, pb); const bool rk_ = (it) == 0 || ((it) == 1 && wave < 4); \
        const int col = rk_ ? CR + h * 64 + (pc >> 3) * 1024 + (pc & 7) * 8 : CW + (pc - 24) * 8; \
        const int sg = RC * (cc) + tt; const int row = rwkv_row(b, sg), rowp = rwkv_row(b, sg - 1); pfc[it] = (v4u){0u, 0u, 0u, 0u}; pfp[it] = (v4u){0u, 0u, 0u, 0u}; \
        if (row >= 0) pfc[it] = *(const GAS v4u*)(P + (size_t)row * NP + col); if (rowp >= 0) pfp[it] = *(const GAS v4u*)(P + (size_t)rowp * NP + col); } while (0)
#define RW_PREFETCH(cc, pa, pb) do { RW_LOADK(0, cc, pa, pb); RW_LOADK(1, cc, pa, pb); RW_LOADK(2, cc, pa, pb); if (wave < 6) RW_LOADK(3, cc, pa, pb); } while (0)
#define RW_PIECEK(it, K, pa, pb) do { const int tt = RW_TT(it, pa, pb), pc = RW_PC(it, pa, pb); \
        const v4u rc_ = pfc[it], rp_ = pfp[it]; \
        const float cu[8] = {bflo(rc_.x), bfhi(rc_.x), bflo(rc_.y), bfhi(rc_.y), bflo(rc_.z), bfhi(rc_.z), bflo(rc_.w), bfhi(rc_.w)}; \
        const float pr[8] = {bflo(rp_.x), bfhi(rp_.x), bflo(rp_.y), bfhi(rp_.y), bflo(rp_.z), bfhi(rp_.z), bflo(rp_.w), bfhi(rp_.w)}; \
        const f32x4 m0 = *(LAS f32x4*)(MUL + pc * 8), m1 = *(LAS f32x4*)(MUL + pc * 8 + 4); \
        const float mv[8] = {m0.x, m0.y, m0.z, m0.w, m1.x, m1.y, m1.z, m1.w}; \
        float xs[8]; \
        _Pragma("unroll") for (int e = 0; e < 8; ++e) xs[e] = cu[e] + mv[e] * (pr[e] - cu[e]); \
        if ((K) == 0) { \
            LAS float* dst = XR + (pc >> 3) * 2048 + tt * 64 + (pc & 7) * 8;        \
            *(LAS f32x4*)dst = (f32x4){xs[0], xs[1], xs[2], xs[3]}; *(LAS f32x4*)(dst + 4) = (f32x4){xs[4], xs[5], xs[6], xs[7]}; \
        } else if ((K) == 1) { \
            v4u o; o.x = pk2(tanhf_(xs[0]), tanhf_(xs[1])); o.y = pk2(tanhf_(xs[2]), tanhf_(xs[3])); o.z = pk2(tanhf_(xs[4]), tanhf_(xs[5])); o.w = pk2(tanhf_(xs[6]), tanhf_(xs[7])); \
            *(LAS v4u*)(TW + tt * 72 + (pc - 24) * 8) = o; \
        } else if ((K) == 2) { \
            v4u o; o.x = pk2(xs[0], xs[1]); o.y = pk2(xs[2], xs[3]); o.z = pk2(xs[4], xs[5]); o.w = pk2(xs[6], xs[7]); \
            *(LAS v4u*)(XA + tt * 72 + (pc - 32) * 8) = o; \
        } else { \
            v4u o; o.x = pk2(sigmoidf_(xs[0]), sigmoidf_(xs[1])); o.y = pk2(sigmoidf_(xs[2]), sigmoidf_(xs[3])); o.z = pk2(sigmoidf_(xs[4]), sigmoidf_(xs[5])); o.w = pk2(sigmoidf_(xs[6]), sigmoidf_(xs[7])); \
            *(LAS v4u*)(SG + tt * 168 + (pc - 40) * 8) = o; \
        } } while (0)
    RW_PREFETCH(c_lo, pdA, pdB);
    __syncthreads();
    asm volatile("" :: "v"(pfc[0]), "v"(pfc[1]), "v"(pfc[2]), "v"(pfc[3]), "v"(pfp[0]), "v"(pfp[1]), "v"(pfp[2]), "v"(pfp[3]));
    for (int c = c_lo; c < c_hi; ++c) {
        int tidv = tid; asm volatile("" : "+v"(tidv));
        int pa = pdA, pb = pdB; asm volatile("" : "+v"(pa), "+v"(pb));
        const int lanev = tidv & 63; const int r16 = lanev & 15, kq = lanev >> 4;
        RW_PIECEK(0, 0, pa, pb);
        if (wave < 4) { RW_PIECEK(1, 0, pa, pb); RW_PIECEK(2, 2, pa, pb); } else { RW_PIECEK(1, 1, pa, pb); RW_PIECEK(2, 3, pa, pb); }
        if (wave < 6) RW_PIECEK(3, 3, pa, pb);
        asm volatile("" ::: "memory");
        if (c + 1 < c_hi) RW_PREFETCH(c + 1, pa, pb);
        LBAR();
        {
            const int r = lanev & 31, hh = lanev >> 5;
            const LAS bf16* Ab = lmat == 0 ? TW : (lmat == 1 ? XA : SG);
            const int sa = lmat == 2 ? 168 : 72;
            f32x16 acc;
#pragma unroll
            for (int g = 0; g < 16; ++g) acc[g] = 0.f;
            if (lmat == 2) {
#pragma unroll
                for (int sx = 0; sx < 10; ++sx) acc = MFMA32(*(const LAS bf16x8*)(Ab + r * sa + 16 * sx + 8 * hh), *(const LAS bf16x8*)(GUt + (32 * lnt + r) * 168 + 16 * sx + 8 * hh), acc);
            } else {
#pragma unroll
                for (int sx = 0; sx < 4; ++sx) acc = MFMA32(*(const LAS bf16x8*)(Ab + r * sa + 16 * sx + 8 * hh), bw[sx], acc);
            }
            const int nn = 32 * lnt + r;
            if (lmat == 0) {
                const float w0 = HC[nn];
                float ldv[8], rsum[2], osum[2];
#pragma unroll
                for (int g = 0; g < 8; ++g) { const float wl = w0 + (dhalf ? acc[8 + g] : acc[g]); const float wlog = -softplusf_(-wl) - 0.5f; ldv[g] = -__expf(wlog); }
#pragma unroll
                for (int gg = 0; gg < 2; ++gg) { rsum[gg] = (ldv[4 * gg] + ldv[4 * gg + 1]) + (ldv[4 * gg + 2] + ldv[4 * gg + 3]); osum[gg] = __shfl_xor(rsum[gg], 32); }
                float off = 0.f;
                const int tb = dhalf ? 16 : 0;
#pragma unroll
                for (int gg = 0; gg < 2; ++gg) {
                    float cs = off + (hh ? osum[gg] : 0.f);
#pragma unroll
                    for (int e = 0; e < 4; ++e) { cs += ldv[4 * gg + e]; LD[(tb + 8 * gg + 4 * hh + e) * 64 + nn] = cs; }
                    off += rsum[gg] + osum[gg];
                }
            } else if (lmat == 1) { const float a0 = HC[64 + nn];
#pragma unroll
                for (int g = 0; g < 16; ++g) AA[crow(g, hh) * 64 + nn] = sigmoidf_(a0 + acc[g]); }
            else {
#pragma unroll
                for (int g = 0; g < 16; ++g) GG[crow(g, hh) * 64 + nn] = acc[g]; }
        }
        LBAR();
        {
            const int tt = tid >> 4, j0 = (tid & 15) * 4;
            const f32x4 xk = *(LAS f32x4*)(XK + tt * 64 + j0), av = *(LAS f32x4*)(AA + tt * 64 + j0);
            const f32x4 kkw = *(LAS f32x4*)(HC + 128 + j0), kaw = *(LAS f32x4*)(HC + 192 + j0);
            f32x4 kr = xk * kkw;
            float ss = (kr.x * kr.x + kr.y * kr.y) + (kr.z * kr.z + kr.w * kr.w);
            ss = red16(ss);
            const float inv = frsq(fmaxf(ss, 1e-24f));
            const f32x4 kkv = kr * inv, bb = kkv * av, km = xk * (1.0f + (av - 1.0f) * kaw);
            *(LAS f32x4*)(XK + tt * 64 + j0) = km;
            f32x4 cum = *(LAS f32x4*)(LD + tt * 64 + j0);
            f32x4 cx = (f32x4){0.f, 0.f, 0.f, 0.f}; if (tt > 0) cx = *(LAS f32x4*)(LD + (tt - 1) * 64 + j0);
            if (tt >= 16) { const f32x4 h0 = *(LAS f32x4*)(LD + 15 * 64 + j0); cum = cum + h0; if (tt > 16) cx = cx + h0; }
            const f32x4 rr = *(LAS f32x4*)(XR + tt * 64 + j0), vv = *(LAS f32x4*)(XV + tt * 64 + j0);
            float ep[4], en[4], ex[4];
#pragma unroll
            for (int e = 0; e < 4; ++e) { ep[e] = __expf(cum[e]); en[e] = __expf(-cum[e]); ex[e] = __expf(cx[e]); }
            unsigned short a_[4], b_[4], k_[4], r_[4], v_[4];
#pragma unroll
            for (int e = 0; e < 4; ++e) { a_[e] = (unsigned short)f2bf(-kkv[e] * ex[e]); b_[e] = (unsigned short)f2bf(bb[e] * en[e]); k_[e] = (unsigned short)f2bf(km[e] * en[e]); r_[e] = (unsigned short)f2bf(rr[e] * ep[e]); v_[e] = (unsigned short)f2bf(vv[e]); }
            *(LAS u32x2*)(At + tt * 72 + j0) = (u32x2){(unsigned)a_[0] | ((unsigned)a_[1] << 16), (unsigned)a_[2] | ((unsigned)a_[3] << 16)};
            *(LAS u32x2*)(Bt + tt * 72 + j0) = (u32x2){(unsigned)b_[0] | ((unsigned)b_[1] << 16), (unsigned)b_[2] | ((unsigned)b_[3] << 16)};
            *(LAS u32x2*)(Kt + tt * 72 + j0) = (u32x2){(unsigned)k_[0] | ((unsigned)k_[1] << 16), (unsigned)k_[2] | ((unsigned)k_[3] << 16)};
            *(LAS u32x2*)(Rt + tt * 72 + j0) = (u32x2){(unsigned)r_[0] | ((unsigned)r_[1] << 16), (unsigned)r_[2] | ((unsigned)r_[3] << 16)};
#pragma unroll
            for (int e = 0; e < 4; ++e) { const int sw = ((j0 >> 4) & 3) << 3;
                BTt[(j0 + e) * 40 + (kslot(tt) ^ sw)] = b_[e]; KTt[(j0 + e) * 40 + (tt ^ sw)] = k_[e]; VT[(j0 + e) * 40 + (tt ^ sw)] = v_[e]; }
            if (tt == RC - 1) *(LAS f32x4*)(GAM + j0) = (f32x4){ep[0], ep[1], ep[2], ep[3]};
            const f32x4 gg = *(LAS f32x4*)(GG + tt * 64 + j0);
            const f32x4 rk = *(LAS f32x4*)(HC + 256 + j0), gw = *(LAS f32x4*)(HC + 320 + j0), gb = *(LAS f32x4*)(HC + 384 + j0);
            const f32x4 t3 = rr * km * rk;
            const float bonus = red16((t3.x + t3.y) + (t3.z + t3.w));
            {
                unsigned char* blob = blob0 + (size_t)c * 16384;
                const f32x4 g1 = gw * gg, e1 = (gb + vv * bonus) * gg;
                *(GAS u32x2*)(blob + 8192 + (tt * 64 + j0) * 2) = (u32x2){pk2(g1.x, g1.y), pk2(g1.z, g1.w)};
                *(GAS u32x2*)(blob + 12288 + (tt * 64 + j0) * 2) = (u32x2){pk2(e1.x, e1.y), pk2(e1.z, e1.w)};
            }
        }
        LBAR();
        if (wave < 4) {
            const int r = lanev & 31, hh = lanev >> 5;
            const LAS bf16* Aimg = (wave == 0 || wave == 2) ? Kt : Bt;
            const LAS bf16* Bimg = (wave == 0 || wave == 3) ? At : Rt;
            LAS bf16* Oimg = wave == 0 ? LAK : (wave == 1 ? MRB : (wave == 2 ? MRK : LAB));
            const bool incl = (wave == 1 || wave == 2);
            f32x16 acc;
#pragma unroll
            for (int g = 0; g < 16; ++g) acc[g] = 0.f;
#pragma unroll
            for (int s = 0; s < 4; ++s) {
                const bf16x8 a = *(const LAS bf16x8*)(Aimg + r * 72 + 16 * s + 8 * hh);
                const bf16x8 bq = *(const LAS bf16x8*)(Bimg + r * 72 + 16 * s + 8 * hh);
                acc = MFMA32(a, bq, acc);
            }
            const int t = r;
#pragma unroll
            for (int gg = 0; gg < 4; ++gg) {
                float x[4];
#pragma unroll
                for (int e = 0; e < 4; ++e) { const int tau = 8 * gg + 4 * hh + e; const bool keep = incl ? (tau <= t) : (tau < t); x[e] = keep ? acc[4 * gg + e] : 0.f; }
                const int ocol = (wave == 1 || wave == 3) ? kslot(8 * gg + 4 * hh) : 8 * gg + 4 * hh;
                if (wave != 3 || gg < 2) *(LAS u32x2*)(Oimg + t * 40 + ocol) = (u32x2){pk2(x[0], x[1]), pk2(x[2], x[3])};
                if (wave == 3) *(LAS f32x4*)(LAB32 + t * 36 + 8 * gg + 4 * hh) = (f32x4){x[0], x[1], x[2], x[3]};
            }
        }
        LBAR();
        f32x4 accN[2], accY[2];
        if (wave == 4) {
            const int blk = (lanev >> 4) & 1, cc = lanev & 15;
            const LAS float* Lb = LAB32 + (16 * blk) * 36 + 16 * blk;
            float Tc[16];
            f32x4 ln[4], ln2[4];
            ln[0] = *(const LAS f32x4*)(Lb + 1 * 36); ln2[0] = *(const LAS f32x4*)(Lb + 2 * 36);
#pragma unroll
            for (int q = 1; q < 4; ++q) { ln[q] = ln[0]; ln2[q] = ln[0]; }
            Tc[0] = (cc == 0) ? 1.f : 0.f;
#pragma unroll
            for (int t = 1; t < 16; ++t) {
                f32x4 lc[4];
#pragma unroll
                for (int q = 0; q < 4; ++q) { lc[q] = ln[q]; ln[q] = ln2[q]; }
                if (t + 2 < 16) {
#pragma unroll
                    for (int q = 0; q < 4; ++q) if (4 * q < t + 2) ln2[q] = *(const LAS f32x4*)(Lb + (t + 2) * 36 + 4 * q);
                }
                float s0 = (t == cc) ? 1.f : 0.f, s1 = 0.f, s2 = 0.f, s3 = 0.f;
#pragma unroll
                for (int tau = 0; tau < t; ++tau) { const float pr_ = lc[tau >> 2][tau & 3] * Tc[tau]; if ((tau & 3) == 0) s0 += pr_; else if ((tau & 3) == 1) s1 += pr_; else if ((tau & 3) == 2) s2 += pr_; else s3 += pr_; }
                Tc[t] = (s0 + s1) + (s2 + s3);
            }
            if (lanev < 32) {
#pragma unroll
                for (int t = 0; t < 16; ++t) TJ[blk * 640 + t * 40 + kslot(cc)] = (unsigned short)f2bf(Tc[t]);
            }
        }
        const bf16x8 bzero = (bf16x8){0, 0, 0, 0, 0, 0, 0, 0};
        {
#pragma unroll
            for (int m = 0; m < 2; ++m) {
                f32x4 an = (f32x4){0.f, 0.f, 0.f, 0.f}, ay = (f32x4){0.f, 0.f, 0.f, 0.f};
#pragma unroll
                for (int ks = 0; ks < 2; ++ks) {
                    const bf16x8 sb_ = *(const LAS bf16x8*)(Sw + r16 * 72 + 32 * ks + 8 * kq);
                    an = MFMA16(*(const LAS bf16x8*)(At + (16 * m + r16) * 72 + 32 * ks + 8 * kq), sb_, an);
                    ay = MFMA16(*(const LAS bf16x8*)(Rt + (16 * m + r16) * 72 + 32 * ks + 8 * kq), sb_, ay);
                }
                const bf16x8 vb = idw ? bzero : *(const LAS bf16x8*)(VT + (16 * cw + r16) * 40 + 8 * (kq ^ cw));
                an = MFMA16(*(const LAS bf16x8*)(LAK + (16 * m + r16) * 40 + 8 * kq), vb, an);
                ay = MFMA16(*(const LAS bf16x8*)(MRK + (16 * m + r16) * 40 + 8 * kq), vb, ay);
                accN[m] = an; accY[m] = ay;
            }
        }
        LBAR();
        asm volatile("" :: "v"(pfc[0]), "v"(pfc[1]), "v"(pfc[2]), "v"(pfc[3]), "v"(pfp[0]), "v"(pfp[1]), "v"(pfp[2]), "v"(pfp[3]));
        {
            const f32x4 z4 = (f32x4){0.f, 0.f, 0.f, 0.f};
            const v4u nb0 = (v4u){pk2(accN[0][0], accN[0][1]), pk2(accN[0][2], accN[0][3]), 0u, 0u};
            const f32x4 u0 = MFMA16(*(const LAS bf16x8*)(TJ + r16 * 40 + 8 * kq), __builtin_bit_cast(bf16x8, nb0), z4);
            const v4u ub0 = (v4u){pk2(u0[0], u0[1]), pk2(u0[2], u0[3]), 0u, 0u};
            const f32x4 n1 = MFMA16(*(const LAS bf16x8*)(LAB + (16 + r16) * 40 + 8 * kq), __builtin_bit_cast(bf16x8, ub0), accN[1]);
            const v4u nb1 = (v4u){pk2(n1[0], n1[1]), pk2(n1[2], n1[3]), 0u, 0u};
            const f32x4 u1 = MFMA16(*(const LAS bf16x8*)(TJ + 640 + r16 * 40 + 8 * kq), __builtin_bit_cast(bf16x8, nb1), z4);
            const v4u ubw = (v4u){ub0.x, ub0.y, pk2(u1[0], u1[1]), pk2(u1[2], u1[3])};
            const bf16x8 ub = __builtin_bit_cast(bf16x8, ubw);
            const bf16x8 vb = idw ? bzero : *(const LAS bf16x8*)(VT + (16 * cw + r16) * 40 + 8 * (kq ^ cw));
            unsigned char* blob = blob0 + (size_t)c * 16384;
#pragma unroll
            for (int m = 0; m < 2; ++m) {
                const f32x4 yv = MFMA16(*(const LAS bf16x8*)(MRB + (16 * m + r16) * 40 + 8 * kq), ub, accY[m]);
                if (!idw) *(GAS u32x2*)(blob + ((cw * 2 + m) * 64 + lanev) * 8) = (u32x2){pk2(yv[0], yv[1]), pk2(yv[2], yv[3])};
                else {
#pragma unroll
                    for (int e = 0; e < 4; ++e) *(GAS unsigned short*)(blob + 4096 + ((16 * m + 4 * kq + e) * 64 + 16 * cw + r16) * 2) = (unsigned short)f2bf(yv[e]);
                }
            }
#pragma unroll
            for (int jt = 0; jt < 4; ++jt) {
                f32x4 zz = MFMA16(*(const LAS bf16x8*)(BTt + (16 * jt + r16) * 40 + 8 * (kq ^ jt)), ub, accZ[jt]);
                zz = MFMA16(*(const LAS bf16x8*)(KTt + (16 * jt + r16) * 40 + 8 * (kq ^ jt)), vb, zz);
                const f32x4 gm = *(const LAS f32x4*)(GAM + 16 * jt + 4 * kq);
                zz = zz * gm; accZ[jt] = zz;
                *(LAS u32x2*)(Sw + r16 * 72 + 16 * jt + 4 * kq) = (u32x2){pk2(zz[0], zz[1]), pk2(zz[2], zz[3])};
            }
        }
        LBAR();
    }
    {
        const int r16 = lane & 15, kq = lane >> 4;
#pragma unroll
        for (int jt = 0; jt < 4; ++jt) {
            if (!idw) *(GAS f32x4*)(HS + (16 * cw + r16) * 64 + 16 * jt + 4 * kq) = accZ[jt];
            else {
#pragma unroll
                for (int e = 0; e < 4; ++e) HS[4096 + (16 * jt + 4 * kq + e) * 64 + 16 * cw + r16] = accZ[jt][e];
            }
        }
    }
    __syncthreads();
}


DI void rwkv_pass2(Frame& F, int unit) {
    const int tid = F.tid, lane = F.lane, wave = F.wave;
    const int bh = unit & 63, seg = unit >> 6;
    const int b = bh >> 4, h = bh & 15;
    const int c_lo = seg == 0 ? 0 : RW_SEG0 + RW_SEGN * (seg - 1), c_hi = RW_SEG0 + RW_SEGN * seg;
    const unsigned char* const blob0 = F.ws + WS_RW + (size_t)bh * RW_NCH * 16384;
    const float* const HS0 = (const float*)(F.ws + WS_RWS) + (size_t)(bh * 4) * 8192;
    bf16* Y = (bf16*)(F.ws + WS_U);
    LAS float* ZA = (LAS float*)(F.lds + 0);
    LAS float* ZB = (LAS float*)(F.lds + 17408);
    LAS float* GL = (LAS float*)(F.lds + 34816);
    LAS bf16* SIN = (LAS bf16*)(F.lds + 52224);
    LAS float* YY = (LAS float*)(F.lds + 61440);
    __syncthreads();
    if (seg > 0) {
        for (int i = tid; i < 64 * 16; i += NTHR) { const int r = i >> 4, c4 = (i & 15) * 4; *(LAS f32x4*)(ZA + r * 68 + c4) = *(const GAS f32x4*)(HS0 + r * 64 + c4); }
        LAS float* zc = ZA; LAS float* zn = ZB;
        for (int sx = 1; sx < seg; ++sx) {
            for (int i = tid; i < 64 * 16; i += NTHR) { const int r = i >> 4, c4 = (i & 15) * 4; *(LAS f32x4*)(GL + r * 68 + c4) = *(const GAS f32x4*)(HS0 + (size_t)sx * 8192 + 4096 + r * 64 + c4); }
            __syncthreads();
            const int i = tid >> 3, j0 = (tid & 7) * 8;
            float acc[8];
#pragma unroll
            for (int e = 0; e < 8; ++e) acc[e] = HS0[(size_t)sx * 8192 + i * 64 + j0 + e];
            for (int m = 0; m < 64; m += 4) {
                const f32x4 z = *(LAS f32x4*)(zc + i * 68 + m);
#pragma unroll
                for (int e = 0; e < 8; ++e) { const f32x4 gv = *(LAS f32x4*)(GL + (j0 + e) * 68 + m); acc[e] += (z.x * gv.x + z.y * gv.y) + (z.z * gv.z + z.w * gv.w); }
            }
#pragma unroll
            for (int e = 0; e < 8; ++e) zn[i * 68 + j0 + e] = acc[e];
            __syncthreads();
            LAS float* t_ = zc; zc = zn; zn = t_;
        }
        __syncthreads();
        for (int i = tid; i < 64 * 16; i += NTHR) { const int r = i >> 4, c4 = (i & 15) * 4; const f32x4 z = *(LAS f32x4*)(zc + r * 68 + c4); *(LAS u32x2*)(SIN + r * 72 + c4) = (u32x2){pk2(z.x, z.y), pk2(z.z, z.w)}; }
        __syncthreads();
    }
    const int r16 = lane & 15, kq = lane >> 4, ct = wave & 3, m2 = wave >> 2;
    const int tt = tid >> 4, i0 = (tid & 15) * 4;
    u32x2 pylA, pg1A, pe1A, pylB, pg1B, pe1B; v4u pyhA0, pyhA1, pyhB0, pyhB1;
#define RW2_LOAD(S, cc) do { const unsigned char* bl_ = blob0 + (size_t)(cc) * 16384; pyl##S = *(const GAS u32x2*)(bl_ + ((ct * 2 + m2) * 64 + lane) * 8); \
        pyh##S##0 = *(const GAS v4u*)(bl_ + 4096 + ((16 * m2 + r16) * 64 + 8 * kq) * 2); pyh##S##1 = *(const GAS v4u*)(bl_ + 4096 + ((16 * m2 + r16) * 64 + 32 + 8 * kq) * 2); \
        pg1##S = *(const GAS u32x2*)(bl_ + 8192 + (tt * 64 + i0) * 2); pe1##S = *(const GAS u32x2*)(bl_ + 12288 + (tt * 64 + i0) * 2); } while (0)
#define RW2_BODY(S, cc) do { \
        f32x4 acc = (f32x4){bflo(pyl##S.x), bfhi(pyl##S.x), bflo(pyl##S.y), bfhi(pyl##S.y)}; \
        const v4u yh0 = pyh##S##0, yh1 = pyh##S##1; const u32x2 g1w = pg1##S, e1w = pe1##S; \
        { const int cn = (cc) + 2 < c_hi ? (cc) + 2 : c_hi - 1; RW2_LOAD(S, cn); } \
        if (seg > 0) { \
            acc = MFMA16(__builtin_bit_cast(bf16x8, yh0), *(const LAS bf16x8*)(SIN + (16 * ct + r16) * 72 + 8 * kq), acc); \
            acc = MFMA16(__builtin_bit_cast(bf16x8, yh1), *(const LAS bf16x8*)(SIN + (16 * ct + r16) * 72 + 32 + 8 * kq), acc); \
        } \
        LAS float* yb = YY + ((cc) & 1) * 2048; \
        _Pragma("unroll") for (int e = 0; e < 4; ++e) yb[(16 * m2 + 4 * kq + e) * 64 + 16 * ct + r16] = acc[e]; \
        LBAR(); \
        { \
            const f32x4 y4 = *(LAS f32x4*)(yb + tt * 64 + i0); \
            const float mean = red16((y4.x + y4.y) + (y4.z + y4.w)) * (1.0f / 64.0f); \
            const f32x4 d = y4 - mean; \
            const float var = red16((d.x * d.x + d.y * d.y) + (d.z * d.z + d.w * d.w)) * (1.0f / 64.0f); \
            const float rstd = frsq(var + GN_EPS); \
            const f32x4 g1 = (f32x4){bflo(g1w.x), bfhi(g1w.x), bflo(g1w.y), bfhi(g1w.y)}, e1 = (f32x4){bflo(e1w.x), bfhi(e1w.x), bflo(e1w.y), bfhi(e1w.y)}; \
            const f32x4 ov = (d * rstd) * g1 + e1; \
            const int sg = RC * (cc) + tt; \
            const int orow = sg >= 32 ? b * SEQ + sg - 32 : TR + (sg & 15); u32x2 w; w.x = pk2(ov.x, ov.y); w.y = pk2(ov.z, ov.w); *(GAS u32x2*)(Y + (size_t)orow * DM + h * 64 + i0) = w; \
        } } while (0)
    int c0 = c_lo;
    RW2_LOAD(A, c0); RW2_LOAD(B, c0 + 1);
    if ((c_hi - c_lo) & 1) {
        RW2_BODY(A, c0); ++c0;
        pylA = pylB; pyhA0 = pyhB0; pyhA1 = pyhB1; pg1A = pg1B; pe1A = pe1B;
        RW2_LOAD(B, c0 + 1);
    }
    asm volatile("" :: "v"(pylA), "v"(pg1A), "v"(pe1A), "v"(pyhA0), "v"(pyhA1), "v"(pylB), "v"(pg1B), "v"(pe1B), "v"(pyhB0), "v"(pyhB1));
#pragma unroll 4
    for (int t = 0; t < RW_SEGN / 2; ++t) { const int c = c0 + 2 * t; RW2_BODY(A, c); RW2_BODY(B, c + 1); }
    __syncthreads();
}

DI int f2key(float f) { const int b = __float_as_int(f); return b ^ ((b >> 31) & 0x7fffffff); }
DI float key2f(int k) { return __int_as_float(k ^ ((k >> 31) & 0x7fffffff)); }
template <int CTRL> DI int dppi(int v) { return __builtin_amdgcn_update_dpp(0, v, CTRL, 0xf, 0xf, true); }
DI int imax2(int a, int b) { return a > b ? a : b; }
DI int imin2(int a, int b) { return a < b ? a : b; }
DI int imax16(int v) { v = imax2(v, dppi<0xB1>(v)); v = imax2(v, dppi<0x4E>(v)); v = imax2(v, dppi<0x141>(v)); v = imax2(v, dppi<0x140>(v)); return v; }
constexpr int KMIN = -2147483647 - 1;
#define CEX(a, b) do { const int lo_ = imin2(a, b), hi_ = imax2(a, b); a = hi_; b = lo_; } while (0)
DI int top16_of8(int (&x)[8], int l16) {
    CEX(x[0], x[1]); CEX(x[2], x[3]); CEX(x[4], x[5]); CEX(x[6], x[7]);
    CEX(x[0], x[2]); CEX(x[1], x[3]); CEX(x[4], x[6]); CEX(x[5], x[7]);
    CEX(x[1], x[2]); CEX(x[5], x[6]); CEX(x[0], x[4]); CEX(x[3], x[7]);
    CEX(x[1], x[5]); CEX(x[2], x[6]);
    CEX(x[1], x[4]); CEX(x[3], x[6]);
    CEX(x[2], x[4]); CEX(x[3], x[5]);
    CEX(x[3], x[4]);
    int res = KMIN;
#pragma unroll
    for (int k = 0; k < 16; ++k) {
        const int m = imax16(x[0]);
        const bool hit = x[0] == m;
#pragma unroll
        for (int q = 0; q < 7; ++q) x[q] = hit ? x[q + 1] : x[q];
        x[7] = hit ? KMIN : x[7];
        res = (l16 == k) ? m : res;
    }
    return res;
}
DI int top16_of4(int (&x)[4], int l16) {
    CEX(x[0], x[1]); CEX(x[2], x[3]); CEX(x[0], x[2]); CEX(x[1], x[3]); CEX(x[1], x[2]);
    int res = KMIN;
#pragma unroll
    for (int k = 0; k < 16; ++k) {
        const int m = imax16(x[0]);
        const bool hit = x[0] == m;
        x[0] = hit ? x[1] : x[0]; x[1] = hit ? x[2] : x[1]; x[2] = hit ? x[3] : x[2]; x[3] = hit ? KMIN : x[3];
        res = (l16 == k) ? m : res;
    }
    return res;
}
DI void topk_setup(LAS unsigned char* TAB, int lane) {
    {
        unsigned char v = 0xFF; int q = lane, i = 0;
#pragma unroll
        for (int ii = 0; ii < 16; ++ii) { const int cnt = 16 / (ii + 1); if (i == ii) { if (q < cnt) { v = (unsigned char)((ii << 4) | q); i = 99; } else { q -= cnt; i = ii + 1; } } }
        TAB[lane] = v;
    }
    asm volatile("s_waitcnt lgkmcnt(0)" ::: "memory");
}
DI void topk_pass(const float* SC, int t, int pass, int lane, LAS int* KA, LAS int* KB, int& eidx, float& gate) {
    const int g = lane >> 4, l16 = lane & 15;
    const LAS unsigned char* TAB = (const LAS unsigned char*)(KA + 128);
    const int hd = 4 * pass + g;
    const bf16* srow = (const bf16*)SC + (size_t)t * DM + hd * 256 + 8 * l16;
    const v4u ra_ = *(const GAS v4u*)(srow), rb_ = *(const GAS v4u*)(srow + 128);
    const f32x4 a0 = {bflo(ra_.x), bfhi(ra_.x), bflo(ra_.y), bfhi(ra_.y)}, a1 = {bflo(ra_.z), bfhi(ra_.z), bflo(ra_.w), bfhi(ra_.w)};
    const f32x4 b0 = {bflo(rb_.x), bfhi(rb_.x), bflo(rb_.y), bfhi(rb_.y)}, b1 = {bflo(rb_.z), bfhi(rb_.z), bflo(rb_.w), bfhi(rb_.w)};
    int xa[8], xb[8];
#pragma unroll
    for (int q = 0; q < 4; ++q) { xa[q] = (f2key(a0[q]) & ~0x7F) | (8 * l16 + q); xa[4 + q] = (f2key(a1[q]) & ~0x7F) | (8 * l16 + 4 + q);
                                  xb[q] = (f2key(b0[q]) & ~0x7F) | (8 * l16 + q); xb[4 + q] = (f2key(b1[q]) & ~0x7F) | (8 * l16 + 4 + q); }
    const int ra = top16_of8(xa, l16), rb = top16_of8(xb, l16);
    KA[g * 16 + l16] = ra; KB[g * 16 + l16] = rb;
    asm volatile("s_waitcnt lgkmcnt(0)" ::: "memory");
    int cs[4];
#pragma unroll
    for (int e = 0; e < 4; ++e) {
        const int ij = TAB[4 * l16 + e]; const int ka = KA[g * 16 + ((ij >> 4) & 15)], kb = KB[g * 16 + (ij & 15)];
        const float sv = key2f(ka & ~0x7F) + key2f(kb & ~0x7F);
        cs[e] = (ij == 0xFF) ? KMIN : ((f2key(sv) & ~0xFF) | ij);
    }
    const int rc = top16_of4(cs, l16);
    const int ij = rc & 0xFF;
    const int ia = KA[g * 16 + (ij >> 4)] & 0x7F, ib = KB[g * 16 + (ij & 15)] & 0x7F;
    const float sv = key2f(rc & ~0xFF);
    const float smax = key2f(imax16(rc) & ~0xFF);
    const float ex = __expf(sv - smax);
    const float sum = red16(ex);
    eidx = ia * 128 + ib; gate = ex * frcp(sum);
    asm volatile("s_waitcnt lgkmcnt(0)" ::: "memory");
}
#ifndef FUSE_TOPK
#define FUSE_TOPK 1
#endif
DI void topk_phase(Frame& F) {
    const int lane = F.lane, wave = F.wave;
    const int gw = F.vcu * NWAVES + wave, NGW = F.G * NWAVES;
    const float* SC = (const float*)(F.ws + WS_SC); int* IDX = (int*)(F.ws + WS_IDX); float* GATE = (float*)(F.ws + WS_GATE);
    LAS int* KA = (LAS int*)(F.lds + wave * 1024); LAS int* KB = KA + 64;
    topk_setup((LAS unsigned char*)(F.lds + wave * 1024 + 512), lane);
    for (int t = gw; t < TR; t += NGW) {
#pragma unroll 1
        for (int pass = 0; pass < 2; ++pass) {
            int e; float gt; topk_pass(SC, t, pass, lane, KA, KB, e, gt);
            IDX[(size_t)t * NSEL + 64 * pass + lane] = e; GATE[(size_t)t * NSEL + 64 * pass + lane] = gt;
        }
    }
}

typedef float f32x2v __attribute__((ext_vector_type(2)));
typedef int v2i_t __attribute__((ext_vector_type(2)));
#ifndef GATHER_NT
#define GATHER_NT 0
#endif
#if GATHER_NT
#define G_LD(p) __builtin_nontemporal_load(p)
#else
#define G_LD(p) (*(p))
#endif
#if TBL_FP4
typedef unsigned v4u8 __attribute__((ext_vector_type(4), aligned(8)));
typedef unsigned u32x6v __attribute__((ext_vector_type(6)));
struct Row6 { v4u a; unsigned s; };
#define G_ISSUE_O(buf, o, gb) do { const int tb_ = (gb) < 32 ? 0 : (int)(WS_TU - WS_TD); const int kb_ = ((gb) & 31) * 4; \
    _Pragma("unroll") for (int q = 0; q < 4; ++q) { const int k_ = kb_ + q; const int e_ = __builtin_amdgcn_readlane(k_ < 64 ? id0 : id1, k_ & 63); \
        const int so_ = tb_ + e_ * ROWB; buf[(o) + q].a = __builtin_amdgcn_raw_buffer_load_b128(trs, (int)lo16, so_, 0); buf[(o) + q].s = DOWN_ROWSCALE ? 0u : (unsigned)__builtin_amdgcn_raw_buffer_load_b8(trs, (int)lo2, so_, 0); } } while (0)
#define G_ISSUE(buf, gb) G_ISSUE_O(buf, 0, gb)
#define G_ISSUE8(buf, gb) do { G_ISSUE_O(buf, 0, gb); G_ISSUE_O(buf, 4, (gb) + 1); } while (0)
#define G_DEC4(r, y_) do { _Pragma("unroll") for (int w_ = 0; w_ < 4; ++w_) { \
    { const auto f_ = __builtin_amdgcn_cvt_scalef32_pk_f32_fp4((r).a[w_], 1.0f, 0); y_[8 * w_ + 0] = f_[0]; y_[8 * w_ + 1] = f_[1]; } \
    { const auto f_ = __builtin_amdgcn_cvt_scalef32_pk_f32_fp4((r).a[w_], 1.0f, 1); y_[8 * w_ + 2] = f_[0]; y_[8 * w_ + 3] = f_[1]; } \
    { const auto f_ = __builtin_amdgcn_cvt_scalef32_pk_f32_fp4((r).a[w_], 1.0f, 2); y_[8 * w_ + 4] = f_[0]; y_[8 * w_ + 5] = f_[1]; } \
    { const auto f_ = __builtin_amdgcn_cvt_scalef32_pk_f32_fp4((r).a[w_], 1.0f, 3); y_[8 * w_ + 6] = f_[0]; y_[8 * w_ + 7] = f_[1]; } } } while (0)
typedef __bf16 bf16x2p __attribute__((ext_vector_type(2)));
#define G_D2(w_, bs_, acc_) acc_ = __builtin_amdgcn_fdot2_f32_bf16(__builtin_amdgcn_cvt_scalef32_pk_bf16_fp4(rr_.a[w_], 1.0f, bs_), __builtin_bit_cast(bf16x2p, xr[4 * (w_) + (bs_)]), acc_, false)
#define G_PART(buf, j0) G_PART_O(buf, 0, j0)
#define G_PART_O(buf, o, j0) do { _Pragma("unroll") for (int q = 0; q < 4; ++q) { const Row6 rr_ = buf[(o) + q]; float s_ = 0.f; \
        _Pragma("unroll") for (int w = 0; w < 4; ++w) { G_D2(w, 0, s_); G_D2(w, 1, s_); G_D2(w, 2, s_); G_D2(w, 3, s_); } \
        pp[(j0) + q] = DOWN_ROWSCALE ? s_ : s_ * BSCALE(rr_.s); } } while (0)
#define G_RED16(G) do { \
    _Pragma("unroll") for (int i = 0; i < 8; ++i) { const auto r_ = __builtin_amdgcn_permlane32_swap(__float_as_uint(pp[i]), __float_as_uint(pp[i + 8]), false, false); pp[i] = __uint_as_float(r_[0]) + __uint_as_float(r_[1]); } \
    _Pragma("unroll") for (int i = 0; i < 4; ++i) { const auto r_ = __builtin_amdgcn_permlane16_swap(__float_as_uint(pp[i]), __float_as_uint(pp[i + 4]), false, false); pp[i] = __uint_as_float(r_[0]) + __uint_as_float(r_[1]); } \
    { const bool b3_ = (lane & 8) != 0; _Pragma("unroll") for (int i = 0; i < 2; ++i) { const float keep_ = b3_ ? pp[i + 2] : pp[i], send_ = b3_ ? pp[i] : pp[i + 2]; pp[i] = keep_ + dppf<0x128>(send_); } } \
    { const bool b2_ = (lane & 4) != 0; const float keep_ = b2_ ? pp[1] : pp[0], send_ = b2_ ? pp[0] : pp[1]; pp[0] = keep_ + dppf<0x141>(send_); } \
    float tot_ = pp[0]; tot_ += dppf<0xB1>(tot_); tot_ += dppf<0x4E>(tot_); \
    if ((lane & 3) == ((G) & 3)) { if ((G) < 4) hv0 = tot_; else hv1 = tot_; } } while (0)
#define G_DOWN(buf, b) do { float p_[4]; \
    _Pragma("unroll") for (int q = 0; q < 4; ++q) { const Row6 rr_ = buf[q]; float s0_ = 0.f, s1_ = 0.f, s2_ = 0.f, s3_ = 0.f; \
        _Pragma("unroll") for (int w = 0; w < 4; ++w) { G_D2(w, 0, s0_); G_D2(w, 1, s1_); G_D2(w, 2, s2_); G_D2(w, 3, s3_); } \
        p_[q] = ((s0_ + s1_) + (s2_ + s3_)) * BSCALE(rr_.s); } \
    { const bool h5_ = (lane & 32) != 0; _Pragma("unroll") for (int i = 0; i < 2; ++i) { const float keep_ = h5_ ? p_[i + 2] : p_[i], send_ = h5_ ? p_[i] : p_[i + 2]; p_[i] = keep_ + __shfl_xor(send_, 32); } } \
    { const bool h4_ = (lane & 16) != 0; const float keep_ = h4_ ? p_[1] : p_[0], send_ = h4_ ? p_[0] : p_[1]; p_[0] = keep_ + __shfl_xor(send_, 16); } \
    const float tot_ = red16(p_[0]); \
    if ((lane & 15) == ((b) & 15)) { if ((b) < 16) hv0 = tot_; else hv1 = tot_; } } while (0)
#define G_UP(buf, b) do { _Pragma("unroll") for (int q = 0; q < 4; ++q) { Row6 rr_ = buf[q]; asm volatile("" : "+v"(rr_.a) : "v"(acc[0]), "v"(acc[31]));        \
        const float ck_ = rdlane((b) < 16 ? c0 : c1, 16 * ((b) & 3) + 4 * q + (((b) >> 2) & 3)) * BSCALE(rr_.s); float y_[32]; G_DEC4(rr_, y_); \
        _Pragma("unroll") for (int i = 0; i < 32; ++i) acc[i] += ck_ * y_[i]; } } while (0)
DI void fp8x4_f32(unsigned w, float& a, float& b, float& c, float& d) { const auto lo = __builtin_amdgcn_cvt_pk_f32_fp8((int)w, false); const auto hi = __builtin_amdgcn_cvt_pk_f32_fp8((int)w, true); a = lo[0]; b = lo[1]; c = hi[0]; d = hi[1]; }
#elif TBL_FP6
typedef unsigned v4u8 __attribute__((ext_vector_type(4), aligned(8)));
typedef unsigned u32x6v __attribute__((ext_vector_type(6)));
struct Row6 { v4u a; u32x2 b; };
#define G_ISSUE(buf, gb) do { const unsigned char* tb_ = (gb) < 32 ? T8D : T8U; const int kb_ = ((gb) & 31) * 4; \
    _Pragma("unroll") for (int q = 0; q < 4; ++q) { const int k_ = kb_ + q; const int e_ = __builtin_amdgcn_readlane(k_ < 64 ? id0 : id1, k_ & 63); \
        const unsigned char* p_ = tb_ + (size_t)e_ * 1536 + lane * 24; buf[q].a = *(const GAS v4u8*)p_; buf[q].b = *(const GAS u32x2*)(p_ + 16); } } while (0)
#define G_DEC(r) __builtin_amdgcn_cvt_scalef32_pk32_f32_fp6((u32x6v){(r).a.x, (r).a.y, (r).a.z, (r).a.w, (r).b.x, (r).b.y}, 1.0f)
#define G_DOWN(buf, b) do { float p_[4]; \
    _Pragma("unroll") for (int q = 0; q < 4; ++q) { const auto y_ = G_DEC(buf[q]); float s0_ = 0.f, s1_ = 0.f, s2_ = 0.f, s3_ = 0.f; \
        _Pragma("unroll") for (int i = 0; i < 32; i += 4) { s0_ += y_[i] * xv[i]; s1_ += y_[i + 1] * xv[i + 1]; s2_ += y_[i + 2] * xv[i + 2]; s3_ += y_[i + 3] * xv[i + 3]; } p_[q] = (s0_ + s1_) + (s2_ + s3_); } \
    { const bool h5_ = (lane & 32) != 0; _Pragma("unroll") for (int i = 0; i < 2; ++i) { const float keep_ = h5_ ? p_[i + 2] : p_[i], send_ = h5_ ? p_[i] : p_[i + 2]; p_[i] = keep_ + __shfl_xor(send_, 32); } } \
    { const bool h4_ = (lane & 16) != 0; const float keep_ = h4_ ? p_[1] : p_[0], send_ = h4_ ? p_[0] : p_[1]; p_[0] = keep_ + __shfl_xor(send_, 16); } \
    const float tot_ = red16(p_[0]); \
    if ((lane & 15) == ((b) & 15)) { if ((b) < 16) hv0 = tot_; else hv1 = tot_; } } while (0)
#define G_UP(buf, b) do { _Pragma("unroll") for (int q = 0; q < 4; ++q) { const float ck_ = rdlane((b) < 16 ? c0 : c1, 16 * q + ((b) & 15)); const auto y_ = G_DEC(buf[q]); \
        _Pragma("unroll") for (int i = 0; i < 32; ++i) acc[i] += ck_ * y_[i]; } } while (0)
DI void fp8x4_f32(unsigned w, float& a, float& b, float& c, float& d) { const auto lo = __builtin_amdgcn_cvt_pk_f32_fp8((int)w, false); const auto hi = __builtin_amdgcn_cvt_pk_f32_fp8((int)w, true); a = lo[0]; b = lo[1]; c = hi[0]; d = hi[1]; }
#else
#define G_ISSUE(buf, gb) do { const unsigned char* tb_ = (gb) < 32 ? T8D : T8U; const int kb_ = ((gb) & 31) * 4; \
    _Pragma("unroll") for (int q = 0; q < 4; ++q) { const int k_ = kb_ + q; const int e_ = __builtin_amdgcn_readlane(k_ < 64 ? id0 : id1, k_ & 63); \
        const unsigned char* p_ = tb_ + (size_t)e_ * DM + lane * 16; buf[q][0] = G_LD((const GAS v4u*)p_); buf[q][1] = G_LD((const GAS v4u*)(p_ + 1024)); } } while (0)
DI void fp8x4_f32(unsigned w, float& a, float& b, float& c, float& d) { const auto lo = __builtin_amdgcn_cvt_pk_f32_fp8((int)w, false); const auto hi = __builtin_amdgcn_cvt_pk_f32_fp8((int)w, true); a = lo[0]; b = lo[1]; c = hi[0]; d = hi[1]; }
DI float fp8_dot4(unsigned w, float x0, float x1, float x2, float x3) { float a, b, c, d; fp8x4_f32(w, a, b, c, d); return (a * x0 + b * x1) + (c * x2 + d * x3); }
#define G_DOT4(w, xo) fp8_dot4((w), xv[(xo) + 0], xv[(xo) + 1], xv[(xo) + 2], xv[(xo) + 3])
#define G_DOWN(buf, b) do { float p_[4]; \
    _Pragma("unroll") for (int q = 0; q < 4; ++q) { float s0_ = 0.f, s1_ = 0.f; \
        s0_ += G_DOT4(buf[q][0].x, 0); s1_ += G_DOT4(buf[q][0].y, 4); s0_ += G_DOT4(buf[q][0].z, 8); s1_ += G_DOT4(buf[q][0].w, 12); \
        s0_ += G_DOT4(buf[q][1].x, 16); s1_ += G_DOT4(buf[q][1].y, 20); s0_ += G_DOT4(buf[q][1].z, 24); s1_ += G_DOT4(buf[q][1].w, 28); p_[q] = s0_ + s1_; } \
    { const bool h5_ = (lane & 32) != 0; _Pragma("unroll") for (int i = 0; i < 2; ++i) { const float keep_ = h5_ ? p_[i + 2] : p_[i], send_ = h5_ ? p_[i] : p_[i + 2]; p_[i] = keep_ + __shfl_xor(send_, 32); } } \
    { const bool h4_ = (lane & 16) != 0; const float keep_ = h4_ ? p_[1] : p_[0], send_ = h4_ ? p_[0] : p_[1]; p_[0] = keep_ + __shfl_xor(send_, 16); } \
    const float tot_ = red16(p_[0]); \
    if ((lane & 15) == ((b) & 15)) { if ((b) < 16) hv0 = tot_; else hv1 = tot_; } } while (0)
#define G_FMA4(w, ao, ck) do { float a_, b_, c_, d_; fp8x4_f32((w), a_, b_, c_, d_); \
    acc[(ao) + 0] += (ck) * a_; acc[(ao) + 1] += (ck) * b_; acc[(ao) + 2] += (ck) * c_; acc[(ao) + 3] += (ck) * d_; } while (0)
#define G_UP(buf, b) do { _Pragma("unroll") for (int q = 0; q < 4; ++q) { const float ck_ = rdlane((b) < 16 ? c0 : c1, 16 * q + ((b) & 15)); \
        G_FMA4(buf[q][0].x, 0, ck_); G_FMA4(buf[q][0].y, 4, ck_); G_FMA4(buf[q][0].z, 8, ck_); G_FMA4(buf[q][0].w, 12, ck_); \
        G_FMA4(buf[q][1].x, 16, ck_); G_FMA4(buf[q][1].y, 20, ck_); G_FMA4(buf[q][1].z, 24, ck_); G_FMA4(buf[q][1].w, 28, ck_); } } while (0)
#endif
template <int J> DI int xorlane(int v, int lane) {
    if (J == 1) return __builtin_amdgcn_update_dpp(0, v, 0xB1, 0xf, 0xf, true);
    if (J == 2) return __builtin_amdgcn_update_dpp(0, v, 0x4E, 0xf, 0xf, true);
    if (J == 4) return __builtin_amdgcn_update_dpp(0, __builtin_amdgcn_update_dpp(0, v, 0x141, 0xf, 0xf, true), 0x1B, 0xf, 0xf, true);
    if (J == 8) return __builtin_amdgcn_update_dpp(0, v, 0x128, 0xf, 0xf, true);
    if (J == 16) { const auto r_ = __builtin_amdgcn_permlane16_swap((unsigned)v, (unsigned)v, false, false); return (lane & 16) ? (int)r_[0] : (int)r_[1]; }
    { const auto r_ = __builtin_amdgcn_permlane32_swap((unsigned)v, (unsigned)v, false, false); return (lane & 32) ? (int)r_[0] : (int)r_[1]; }
}
DI void bitonic128(int& a, int& b, int lane) {
#pragma unroll
    for (int k = 2; k <= 128; k <<= 1) {
#pragma unroll
        for (int j = k >> 1; j >= 1; j >>= 1) {
            if (j == 64) { const int lo = imin2(a, b), hi = imax2(a, b); a = lo; b = hi; }
            else {
                const int oa = j == 1 ? xorlane<1>(a, lane) : j == 2 ? xorlane<2>(a, lane) : j == 4 ? xorlane<4>(a, lane) : j == 8 ? xorlane<8>(a, lane) : j == 16 ? xorlane<16>(a, lane) : xorlane<32>(a, lane);
                const int ob = j == 1 ? xorlane<1>(b, lane) : j == 2 ? xorlane<2>(b, lane) : j == 4 ? xorlane<4>(b, lane) : j == 8 ? xorlane<8>(b, lane) : j == 16 ? xorlane<16>(b, lane) : xorlane<32>(b, lane);
                const bool lower = (lane & j) == 0;
                const bool up_a = k == 128 ? true : (k == 64 ? true : ((lane & k) == 0));
                const bool up_b = k == 128 ? true : (k == 64 ? false : ((lane & k) == 0));
                a = (lower == up_a) ? imin2(a, oa) : imax2(a, oa);
                b = (lower == up_b) ? imin2(b, ob) : imax2(b, ob);
            }
        }
    }
}
#ifndef GATHER_ALIGN
#define GATHER_ALIGN 2
#endif
DI void xcd_align(Frame& F, const XcdBarrier& bar, unsigned& epoch, unsigned nwg_x) {
    __syncthreads();
    if (F.tid == 0) {
        gu32* cnt = F.ctl + 2048 + 64 * bar.x;
        ++epoch; (void)__hip_atomic_fetch_add(cnt, 1u, __ATOMIC_RELAXED, __HIP_MEMORY_SCOPE_AGENT);
        const unsigned want = epoch * nwg_x;
        for (unsigned sp = 0; __hip_atomic_load(cnt, __ATOMIC_RELAXED, __HIP_MEMORY_SCOPE_AGENT) < want; ) { __builtin_amdgcn_s_sleep(1); if (++sp > (1u << 20)) break; }
    }
    __syncthreads();
}
#ifndef GATHER_SORT
#define GATHER_SORT 1
#endif
#ifndef GATHER_TRIPLE
#define GATHER_TRIPLE 0
#endif
#ifndef GATHER_SYNC
#define GATHER_SYNC 0
#endif
DI void gather_phase(Frame& F, const XcdBarrier& bar) {
    const int lane = F.lane, wave = F.wave;
    const int gw = F.vcu * NWAVES + wave, NGW = F.G * NWAVES;
    const int* IDX = (const int*)(F.ws + WS_IDX); const float* GATE = (const float*)(F.ws + WS_GATE);
    const unsigned char* T8D = F.ws + WS_TD; const unsigned char* T8U = F.ws + WS_TU; const float* SCL = (const float*)(F.ws + WS_SCL);
    const bf16* H1B = (const bf16*)(F.ws + WS_H1B);
    const float* sumsq = (const float*)(F.ws + WS_SUMSQ);
    unsigned align_epoch = 0u; const unsigned nwg_x = MK_SPLIT ? 0u : xb_ld(&bar.bar[XB_XCNT(bar.x)]);
    const bool align_ok = !MK_SPLIT && nwg_x > 0u && (TR % NGW) == 0;
#if TBL_FP4
    const __amdgpu_buffer_rsrc_t trs = __builtin_amdgcn_make_buffer_rsrc((void*)T8D, 0, 0x7fffffff, 0x00020000);
#endif
#if FUSE_TOPK
    const float* SC = (const float*)(F.ws + WS_SC);
    LAS int* KA = (LAS int*)(F.lds + wave * 1024); LAS int* KB = KA + 64;
    topk_setup((LAS unsigned char*)(F.lds + wave * 1024 + 512), lane);
#endif
    for (int t = gw; t < TR; t += NGW) {
#if FUSE_TOPK
        int id0, id1; float gr0, gr1;
        topk_pass(SC, t, 0, lane, KA, KB, id0, gr0); topk_pass(SC, t, 1, lane, KA, KB, id1, gr1);
#else
        int id0 = IDX[(size_t)t * NSEL + lane], id1 = IDX[(size_t)t * NSEL + 64 + lane];
#endif
#if TBL_FP4
        const int kA = 16 * (lane & 3) + (lane >> 2);
#else
        const int kA = 4 * (lane & 15) + (lane >> 4);
#endif
#if GATHER_SORT
        int key0 = (id0 << 7) | lane, key1 = (id1 << 7) | (lane + 64);
        bitonic128(key0, key1, lane);
        id0 = key0 >> 7; id1 = key1 >> 7;
        const int keyA = __shfl(key0, kA), keyB = __shfl(key1, kA);
        const int ea = keyA >> 7, eb = keyB >> 7;
#if FUSE_TOPK
        const int oA = keyA & 127, oB = keyB & 127;
        const float gA0 = __shfl(gr0, oA & 63), gA1 = __shfl(gr1, oA & 63), gB0 = __shfl(gr0, oB & 63), gB1 = __shfl(gr1, oB & 63);
        const float g0 = oA < 64 ? gA0 : gA1, g1 = oB < 64 ? gB0 : gB1;
#else
        const float g0 = GATE[(size_t)t * NSEL + (keyA & 127)], g1 = GATE[(size_t)t * NSEL + (keyB & 127)];
#endif
#else
        const int ea = IDX[(size_t)t * NSEL + kA], eb = IDX[(size_t)t * NSEL + 64 + kA];
        const float g0 = GATE[(size_t)t * NSEL + kA], g1 = GATE[(size_t)t * NSEL + 64 + kA];
#endif
        const float sd0 = SCL[ea], sd1 = SCL[eb], su0 = SCL[NEXP + ea], su1 = SCL[NEXP + eb];
        const float rs = frsq(sumsq[t] * (1.0f / DM) + RMS_EPS);
#if TBL_FP4
        const unsigned lo16 = (unsigned)lane * 16u, lo2 = 1024u + (unsigned)lane;
        unsigned xr[16];
#pragma unroll
        for (int j = 0; j < 8; ++j) { const u32x2 raw = *(const GAS u32x2*)(H1B + (size_t)t * DM + 256 * j + lane * 4); xr[2 * j] = raw.x; xr[2 * j + 1] = raw.y; }
        float hv0 = 0.f, hv1 = 0.f;
        Row6 bufA[8], bufB[8];
#elif TBL_FP6
        float xv[32];
#pragma unroll
        for (int j = 0; j < 8; ++j) { const u32x2 raw = *(const GAS u32x2*)(H1B + (size_t)t * DM + 256 * j + lane * 4); const int o = j * 4;
            xv[o + 0] = bflo(raw.x); xv[o + 1] = bfhi(raw.x); xv[o + 2] = bflo(raw.y); xv[o + 3] = bfhi(raw.y); }
        float hv0 = 0.f, hv1 = 0.f;
        Row6 bufA[4], bufB[4];
#else
#pragma unroll
        for (int c = 0; c < 2; ++c)
#pragma unroll
            for (int j = 0; j < 2; ++j) { const v4u raw = *(const GAS v4u*)(H1B + (size_t)t * DM + c * 1024 + lane * 16 + j * 8); const int o = c * 16 + j * 8;
                xv[o + 0] = bflo(raw.x); xv[o + 1] = bfhi(raw.x); xv[o + 2] = bflo(raw.y); xv[o + 3] = bfhi(raw.y); xv[o + 4] = bflo(raw.z); xv[o + 5] = bfhi(raw.z); xv[o + 6] = bflo(raw.w); xv[o + 7] = bfhi(raw.w); }
        float hv0 = 0.f, hv1 = 0.f;
        v4u bufA[4][2], bufB[4][2];
#endif
        if (GATHER_SYNC & 1) xcd_barrier(bar);
        if ((GATHER_ALIGN & 1) && align_ok) xcd_align(F, bar, align_epoch, nwg_x);
#if GATHER_TRIPLE
        Row6 bufC[4];
        G_ISSUE(bufA, 0); G_ISSUE(bufB, 1);
#pragma unroll 1
        for (int b = 0; b < 30; b += 3) { G_ISSUE(bufC, b + 2); G_DOWN(bufA, b); G_ISSUE(bufA, b + 3); G_DOWN(bufB, b + 1); G_ISSUE(bufB, b + 4); G_DOWN(bufC, b + 2); }
        G_ISSUE(bufC, 32); G_DOWN(bufA, 30); G_ISSUE(bufA, 33); G_DOWN(bufB, 31);
#else
#if TBL_FP4
        G_ISSUE8(bufA, 0);
#pragma unroll 1
        for (int G = 0; G < 8; ++G) { float pp[16];
            G_ISSUE8(bufB, 4 * G + 2); G_PART_O(bufA, 0, 0); G_PART_O(bufA, 4, 4); G_ISSUE8(bufA, 4 * G + 4 > 30 ? 30 : 4 * G + 4); G_PART_O(bufB, 0, 8); G_PART_O(bufB, 4, 12);
            G_RED16(G); }
#else
        G_ISSUE(bufA, 0);
#pragma unroll 1
        for (int b = 0; b < 32; b += 2) { G_ISSUE(bufB, b + 1); G_DOWN(bufA, b); G_ISSUE(bufA, b + 2); G_DOWN(bufB, b + 1); }
#endif
#endif
#if TBL_FP4
        const float z0 = hv0 * rs * (DOWN_ROWSCALE ? sd0 : 1.0f), z1 = hv1 * rs * (DOWN_ROWSCALE ? sd1 : 1.0f);
        const float c0 = (UP_TR ? su0 : 1.0f) * g0 * 0.5f * z0 * (1.0f + erff(z0 * 0.70710678118654752f)), c1 = (UP_TR ? su1 : 1.0f) * g1 * 0.5f * z1 * (1.0f + erff(z1 * 0.70710678118654752f));
#else
        const float z0 = hv0 * rs * sd0, z1 = hv1 * rs * sd1;
        const float c0 = g0 * su0 * 0.5f * z0 * (1.0f + erff(z0 * 0.70710678118654752f)), c1 = g1 * su1 * 0.5f * z1 * (1.0f + erff(z1 * 0.70710678118654752f));
#endif
        float acc[32];
#if TBL_FP4 && UP_TR
        {
            LAS unsigned char* cq = F.lds + wave * 1024;
            const float cmax = wave_max(fmaxf(fabsf(c0), fabsf(c1)));
            const float qs = cmax > 0.f ? 119.0f * frcp(cmax) : 0.f;
            { const int v0 = (int)rintf(fminf(fmaxf(c0 * qs, -119.0f), 119.0f)), v1 = (int)rintf(fminf(fmaxf(c1 * qs, -119.0f), 119.0f));
              const int h0 = (v0 + 8) >> 4, h1 = (v1 + 8) >> 4;
              cq[kA] = (unsigned char)h0; cq[kA + 64] = (unsigned char)h1; cq[128 + kA] = (unsigned char)(v0 - 16 * h0); cq[128 + kA + 64] = (unsigned char)(v1 - 16 * h1); }
            asm volatile("s_waitcnt lgkmcnt(0)" ::: "memory");
            if (lane < 32) { const unsigned x_ = *(const LAS unsigned*)(cq + 8 * lane) & 0x0f0f0f0fu, y_ = *(const LAS unsigned*)(cq + 8 * lane + 4) & 0x0f0f0f0fu;
                const unsigned tx_ = (x_ | (x_ >> 4)) & 0x00ff00ffu, ty_ = (y_ | (y_ >> 4)) & 0x00ff00ffu;
                *(LAS unsigned*)(cq + 256 + 4 * lane) = ((tx_ | (tx_ >> 8)) & 0xffffu) | (((ty_ | (ty_ >> 8)) & 0xffffu) << 16); }
            asm volatile("s_waitcnt lgkmcnt(0)" ::: "memory");
            LAS unsigned char* const ring = F.lds + UR_BASE + wave * UR_WAVE;
            const unsigned trb = (unsigned)(size_t)(ring + (lane & 7) * UR_PITCH + 8 * (lane >> 4));
            int ah[32], al[32];
#pragma unroll
            for (int i = 0; i < 32; ++i) { ah[i] = 0; al[i] = 0; }
#define UR_ISSUE(ch) do { _Pragma("unroll") for (int q = 0; q < 8; ++q) { const int k_ = 8 * (ch) + q; const int e_ = __builtin_amdgcn_readlane(k_ < 64 ? id0 : id1, k_ & 63); \
        __builtin_amdgcn_global_load_lds((const GAS unsigned*)(T8U + (size_t)e_ * ROWU + lane * 16), (LAS unsigned*)(ring + ((ch) & 1) * UR_BUF + q * UR_PITCH), 16, 0, 0); } } while (0)
            if ((GATHER_ALIGN & 2) && align_ok) xcd_align(F, bar, align_epoch, nwg_x);
            asm volatile("s_waitcnt vmcnt(0)" ::: "memory");
            UR_ISSUE(0); UR_ISSUE(1);
#pragma unroll 1
            for (int ch = 0; ch < 16; ++ch) {
                if (ch + 1 < 16) asm volatile("s_waitcnt vmcnt(8)" ::: "memory"); else asm volatile("s_waitcnt vmcnt(0)" ::: "memory");
                const int kh = *(const LAS int*)(cq + 256 + 4 * ch), kl = *(const LAS int*)(cq + 256 + 64 + 4 * ch);
                const unsigned tb_ = trb + (unsigned)((ch & 1) * UR_BUF);
                int rr[32];
#pragma unroll
                for (int T = 0; T < 32; ++T) {
                    const v2i_t r_ = __builtin_amdgcn_ds_read_tr4_b64_v2i32((LAS v2i_t*)(size_t)(tb_ + 32 * T)); rr[T] = r_.x; }
                asm volatile("s_waitcnt lgkmcnt(0)" ::: "memory");
                if (ch + 2 < 16) UR_ISSUE(ch + 2);
#pragma unroll
                for (int T = 0; T < 32; ++T) { ah[T] = __builtin_amdgcn_sdot8(rr[T], kh, ah[T], false); al[T] = __builtin_amdgcn_sdot8(rr[T], kl, al[T], false); }
            }
            const float os = cmax * (1.0f / 119.0f);
            { const int j_ = lane & 15, g_ = lane >> 4; const unsigned cb_ = 4u * (unsigned)(264 * ((16 * (g_ & 1) + j_) >> 2) + 4 * (g_ >> 1) + (j_ & 3));
#pragma unroll
              for (int T = 0; T < 32; ++T) *(LAS float*)(ring + cb_ + 32 * T) = os * (float)(16 * ah[T] + al[T]); }
            asm volatile("s_waitcnt lgkmcnt(0)" ::: "memory");
#pragma unroll
            for (int j = 0; j < 8; ++j) { const f32x4 o_ = *(const LAS f32x4*)(ring + 4 * (264 * j + 4 * lane)); acc[4 * j] = o_.x; acc[4 * j + 1] = o_.y; acc[4 * j + 2] = o_.z; acc[4 * j + 3] = o_.w; }
            asm volatile("s_waitcnt lgkmcnt(0)" ::: "memory");
        }
#else
#pragma unroll
        for (int i = 0; i < 32; ++i) acc[i] = 0.f;
        if (GATHER_SYNC & 2) xcd_barrier(bar);
#endif
#if TBL_FP4 && UP_TR
#elif GATHER_TRIPLE
        G_ISSUE(bufB, 34); G_UP(bufC, 0);
#pragma unroll 1
        for (int u = 1; u < 31; u += 3) { G_ISSUE(bufC, 32 + u + 2); G_UP(bufA, u); G_ISSUE(bufA, 32 + u + 3); G_UP(bufB, u + 1); G_ISSUE(bufB, (32 + u + 4) & 63); G_UP(bufC, u + 2); }
        G_UP(bufA, 31);
#else
#pragma unroll 1
        for (int b = 0; b < 32; b += 2) { G_ISSUE(bufB, 32 + b + 1); G_UP(bufA, b); if (b + 2 < 32) G_ISSUE(bufA, 32 + b + 2); G_UP(bufB, b + 1); }
#endif
#if TBL_FP6
        {
#pragma unroll
            for (int j = 0; j < 8; ++j) {
#if TBL_FP4 && UP_TR
                const u32x2 raw = (u32x2){xr[2 * j], xr[2 * j + 1]};
#else
                const u32x2 raw = *(const GAS u32x2*)(H1B + (size_t)t * DM + 256 * j + lane * 4);
#endif
                *(GAS f32x4*)(F.out + (size_t)t * DM + 256 * j + lane * 4) = (f32x4){bflo(raw.x) + acc[j * 4 + 0], bfhi(raw.x) + acc[j * 4 + 1], bflo(raw.y) + acc[j * 4 + 2], bfhi(raw.y) + acc[j * 4 + 3]}; }
        }
#else
#pragma unroll
        for (int c = 0; c < 2; ++c) {
            GAS f32x4* op = (GAS f32x4*)(F.out + (size_t)t * DM + c * 1024 + lane * 16);
#pragma unroll
            for (int j = 0; j < 4; ++j) { f32x4 a = op[j]; a.x += acc[c * 16 + j * 4 + 0]; a.y += acc[c * 16 + j * 4 + 1]; a.z += acc[c * 16 + j * 4 + 2]; a.w += acc[c * 16 + j * 4 + 3]; op[j] = a; }
        }
#endif
    }
}

DI float dot4_fp8(unsigned w, const f32x4& x) { float a, b, c, d; fp8x4_f32(w, a, b, c, d); return (a * x.x + b * x.y) + (c * x.z + d * x.w); }
struct SliceMap { int slice, rank, nblk; };
DI SliceMap slice_map(Frame& F, const XcdBarrier& bar) {
    SliceMap m; m.slice = (int)(blockIdx.x & 7); m.rank = (int)(blockIdx.x >> 3); m.nblk = (F.G + 7 - m.slice) / 8;
    if (!MK_SPLIT && (F.G & 7) == 0) {
        bool ok = true;
#pragma unroll
        for (int j = 0; j < 16; ++j) { const unsigned cnt = xb_ld(&bar.bar[XB_XCNT(j)]); ok = ok && (j < 8 ? cnt == (unsigned)(F.G / 8) : cnt == 0u); }
        if (ok) { m.slice = (int)bar.x; m.rank = (int)F.MISC[10]; m.nblk = F.G / 8; }
    }
    return m;
}
#define GS_ISSUE(buf, i0_, i1_, q) do { const int ids_ = ((q) & 2) ? (i1_) : (i0_); const int lb_ = ((q) & 1) * 32; \
    _Pragma("unroll") for (int k = 0; k < 32; ++k) buf[k] = *(const GAS unsigned*)(T8 + (size_t)__builtin_amdgcn_readlane(ids_, lb_ + k) * 256); } while (0)
#define GS_DOWN(buf, q) do { float p[32]; \
    _Pragma("unroll") for (int k = 0; k < 32; ++k) p[k] = dot4_fp8(buf[k], xc); \
    _Pragma("unroll") for (int d = 16; d >= 1; d >>= 1) { const bool hi_ = (lane & d) != 0; \
        _Pragma("unroll") for (int i = 0; i < d; ++i) { const float keep_ = hi_ ? p[i + d] : p[i], send_ = hi_ ? p[i] : p[i + d]; p[i] = keep_ + __shfl_xor(send_, d); } } \
    const float tot_ = p[0] + __shfl_xor(p[0], 32); \
    if (lane < 32 && vc) PART[(size_t)tc * NSEL + 32 * (q) + lane] = tot_; } while (0)
#define GSD_TOK(Ba, Bb, Bc) do { \
    const int in_ = it + 1; const bool vn = in_ < ntok; const int tn = vn ? wv + in_ * NWV : wv; \
    const int n0 = IDX[(size_t)tn * NSEL + lane], n1 = IDX[(size_t)tn * NSEL + 64 + lane]; \
    const u32x2 xr_ = *(const GAS u32x2*)(H1B + (size_t)tn * DM + 256 * sm.slice + 4 * lane); \
    GS_ISSUE(Bc, c0i, c1i, 2); \
    GS_DOWN(Ba, 0); GS_ISSUE(Ba, c0i, c1i, 3); \
    GS_DOWN(Bb, 1); GS_ISSUE(Bb, n0, n1, 0); \
    GS_DOWN(Bc, 2); GS_ISSUE(Bc, n0, n1, 1); \
    GS_DOWN(Ba, 3); \
    c0i = n0; c1i = n1; xc = (f32x4){bflo(xr_.x), bfhi(xr_.x), bflo(xr_.y), bfhi(xr_.y)}; tc = tn; vc = vn; ++it; } while (0)
DI void gather_down_sliced(Frame& F, const XcdBarrier& bar) {
    const int lane = F.lane, wave = F.wave;
    const SliceMap sm = slice_map(F, bar);
    const int* IDX = (const int*)(F.ws + WS_IDX);
    const unsigned char* T8 = F.ws + WS_TD + (size_t)sm.slice * ((size_t)NEXP * 256) + lane * 4;
    const bf16* H1B = (const bf16*)(F.ws + WS_H1B);
    float* PART = (float*)(F.ws + WS_PART) + (size_t)sm.slice * TR * NSEL;
    const int wv = sm.rank * NWAVES + wave, NWV = sm.nblk * NWAVES;
    const int ntok = wv < TR ? (TR - wv + NWV - 1) / NWV : 0;
    int it = 0; int tc = wv < TR ? wv : 0; bool vc = ntok > 0;
    int c0i = IDX[(size_t)tc * NSEL + lane], c1i = IDX[(size_t)tc * NSEL + 64 + lane];
    f32x4 xc; { const u32x2 xr = *(const GAS u32x2*)(H1B + (size_t)tc * DM + 256 * sm.slice + 4 * lane); xc = (f32x4){bflo(xr.x), bfhi(xr.x), bflo(xr.y), bfhi(xr.y)}; }
    unsigned b0[32], b1[32], b2[32];
    GS_ISSUE(b0, c0i, c1i, 0); GS_ISSUE(b1, c0i, c1i, 1);
    while (it < ntok) { GSD_TOK(b0, b1, b2); GSD_TOK(b1, b2, b0); GSD_TOK(b2, b0, b1); }
}
#define GS_UP(buf, q) do { const float cs_ = ((q) & 2) ? cc1 : cc0; const int lb_ = ((q) & 1) * 32; \
    _Pragma("unroll") for (int k = 0; k < 32; ++k) { float a_, b_, c_, d_; fp8x4_f32(buf[k], a_, b_, c_, d_); const float ck_ = rdlane(cs_, lb_ + k); \
        if (k & 1) { acc1.x += ck_ * a_; acc1.y += ck_ * b_; acc1.z += ck_ * c_; acc1.w += ck_ * d_; } else { acc0.x += ck_ * a_; acc0.y += ck_ * b_; acc0.z += ck_ * c_; acc0.w += ck_ * d_; } } } while (0)
#define GSU_COEF(tq, i0_, i1_, o0, o1) do { float h0_ = 0.f, h1_ = 0.f; \
    _Pragma("unroll") for (int xs = 0; xs < 8; ++xs) { h0_ += PART[((size_t)xs * TR + (tq)) * NSEL + lane]; h1_ += PART[((size_t)xs * TR + (tq)) * NSEL + 64 + lane]; } \
    const float rs_ = frsq(sumsq[tq] * (1.0f / DM) + RMS_EPS); const float z0_ = h0_ * rs_ * SCL[i0_], z1_ = h1_ * rs_ * SCL[i1_]; \
    o0 = GATE[(size_t)(tq) * NSEL + lane] * SCL[NEXP + (i0_)] * 0.5f * z0_ * (1.0f + erff(z0_ * 0.70710678118654752f)); \
    o1 = GATE[(size_t)(tq) * NSEL + 64 + lane] * SCL[NEXP + (i1_)] * 0.5f * z1_ * (1.0f + erff(z1_ * 0.70710678118654752f)); } while (0)
#define GSU_TOK(Ba, Bb, Bc) do { \
    const int in_ = it + 1; const bool vn = in_ < ntok; const int tn = vn ? wv + in_ * NWV : wv; \
    const int n0 = IDX[(size_t)tn * NSEL + lane], n1 = IDX[(size_t)tn * NSEL + 64 + lane]; \
    f32x4 acc0 = (f32x4){0.f, 0.f, 0.f, 0.f}, acc1 = (f32x4){0.f, 0.f, 0.f, 0.f}; \
    GS_ISSUE(Bc, c0i, c1i, 2); \
    GS_UP(Ba, 0); GS_ISSUE(Ba, c0i, c1i, 3); \
    float nc0, nc1; GSU_COEF(tn, n0, n1, nc0, nc1); \
    GS_UP(Bb, 1); GS_ISSUE(Bb, n0, n1, 0); \
    GS_UP(Bc, 2); GS_ISSUE(Bc, n0, n1, 1); \
    GS_UP(Ba, 3); \
    if (vc) { GAS f32x4* op = (GAS f32x4*)(F.out + (size_t)tc * DM + 256 * sm.slice + 4 * lane); f32x4 o = *op; o = o + acc0 + acc1; *op = o; } \
    c0i = n0; c1i = n1; cc0 = nc0; cc1 = nc1; tc = tn; vc = vn; ++it; } while (0)
DI void gather_up_sliced(Frame& F, const XcdBarrier& bar) {
    const int lane = F.lane, wave = F.wave;
    const SliceMap sm = slice_map(F, bar);
    const int* IDX = (const int*)(F.ws + WS_IDX); const float* GATE = (const float*)(F.ws + WS_GATE);
    const unsigned char* T8 = F.ws + WS_TU + (size_t)sm.slice * ((size_t)NEXP * 256) + lane * 4;
    const float* PART = (const float*)(F.ws + WS_PART); const float* SCL = (const float*)(F.ws + WS_SCL);
    const float* sumsq = (const float*)(F.ws + WS_SUMSQ);
    const int wv = sm.rank * NWAVES + wave, NWV = sm.nblk * NWAVES;
    const int ntok = wv < TR ? (TR - wv + NWV - 1) / NWV : 0;
    int it = 0; int tc = wv < TR ? wv : 0; bool vc = ntok > 0;
    int c0i = IDX[(size_t)tc * NSEL + lane], c1i = IDX[(size_t)tc * NSEL + 64 + lane];
    float cc0, cc1; GSU_COEF(tc, c0i, c1i, cc0, cc1);
    unsigned b0[32], b1[32], b2[32];
    GS_ISSUE(b0, c0i, c1i, 0); GS_ISSUE(b1, c0i, c1i, 1);
    while (it < ntok) { GSU_TOK(b0, b1, b2); GSU_TOK(b1, b2, b0); GSU_TOK(b2, b0, b1); }
}

#ifndef REP_ATT
#define REP_ATT 1
#endif
#ifndef REP_RWKV
#define REP_RWKV 1
#endif
struct Args { const float* in[24]; float* out; unsigned char* ws; int ph_lo, ph_hi, li, pad; };
__global__ void __launch_bounds__(NTHR, 2) hybrid_fwd(Args args) {
    extern __shared__ __attribute__((aligned(16))) unsigned char lds[];
    Frame F;
    F.lds = (LAS unsigned char*)lds;
    F.MISC = (volatile LAS unsigned*)(F.lds + MISC_OFF);
    F.tid = threadIdx.x; F.lane = F.tid & 63; F.wave = __builtin_amdgcn_readfirstlane(F.tid >> 6);
    F.G = gridDim.x; { const int bx = blockIdx.x; F.vcu = (F.G % 8 == 0) ? (bx % 8) * (F.G / 8) + bx / 8 : bx; }
    F.ws = args.ws; F.out = args.out; F.ctl = (gu32*)(args.ws + WS_CTL);
#pragma unroll
    for (int i = 0; i < 24; ++i) F.in[i] = args.in[i];
    for (int u = F.tid; u < (LDS_BYTES - LDSCTL_OFF) / 4; u += NTHR) ((LAS unsigned*)(F.lds + LDSCTL_OFF))[u] = 0u;
    __syncthreads();
    XcdBarrier bar; bar.bar = (unsigned*)(F.ctl + CW_BAR); bar.x = 0; bar.st = nullptr;
    if (!MK_SPLIT) {
        bar.x = xb_xcc_id(); bar.st = F.MISC + 8;
        if (F.tid == 0) F.MISC[10] = xb_add(&bar.bar[XB_XCNT(bar.x)], 1u);
        __syncthreads();
    }
    const int lo = args.ph_lo, hi = args.ph_hi;
#ifndef PH_MASK
#define PH_MASK 0x1ff
#endif
#define IN(k) (((PH_MASK >> (k)) & 1) && lo <= (k) && (k) < hi)
#define SEAM(k) do { if (IN(k) && IN((k) + 1)) xcd_barrier(bar); } while (0)
    bf16* Win_t = (bf16*)(F.ws + WS_WIN); bf16* Wout_t = (bf16*)(F.ws + WS_WOUT); bf16* Wqs_t = (bf16*)(F.ws + WS_WQS);
    bf16* U = (bf16*)(F.ws + WS_U); bf16* P = (bf16*)(F.ws + WS_P); bf16* H1B = (bf16*)(F.ws + WS_H1B);
    float* sumsq = (float*)(F.ws + WS_SUMSQ); float* SC = (float*)(F.ws + WS_SC);

#ifndef PH_DUP
#define PH_DUP 0
#endif
#define DUP(k) for (int rep_ = 0; rep_ < (((PH_DUP >> (k)) & 1) ? 2 : 1); ++rep_)
    if (IN(0)) { DUP(0) { p0_prologue(F); __syncthreads(); } } SEAM(0);
    if (IN(1)) {
        pg8::Gemm g{U, Win_t, MIN_ROWS, NP, DM}; pg8::StaticOrder S; S.init(MIN_ROWS, NP, F.G, (int)blockIdx.x);
        pg8::EpiBf16<0> E{P, NP, nullptr, 0, 0, 1.f};
        pg8::gemm_phase<pg8::EpiBf16<0>, pg8::StaticOrder, true, true>(F.lds, g, S, E);
#if (PH_DUP >> 1) & 1
        __syncthreads(); pg8::gemm_phase<pg8::EpiBf16<0>, pg8::StaticOrder, true, true>(F.lds, g, S, E);
#endif
    } SEAM(1);
    if (IN(2)) {
        for (int rep = 0; rep < REP_ATT; ++rep) for (int u = blockIdx.x; u < 256; u += F.G) attn_unit(F, u);
        for (int rep = 0; rep < REP_RWKV; ++rep) for (int u = blockIdx.x; u < 256; u += F.G) rwkv_pass1(F, u);
    } SEAM(2);
    if (IN(3)) {
        for (int u = blockIdx.x; u < 256; u += F.G) rwkv_pass2(F, u);
    } SEAM(3);
    if (IN(4)) {
        pg8::Gemm g{U, Wout_t, TR, DM, DM}; pg8::StaticOrder S; S.init(TR, DM, F.G, (int)blockIdx.x);
        pg8::EpiOut E{F.in[IN_X], F.out, H1B, sumsq, DM};
        pg8::gemm_phase<pg8::EpiOut, pg8::StaticOrder, true, true>(F.lds, g, S, E);
    } SEAM(4);
    if (IN(5)) {
        pg8::Gemm g{H1B, Wqs_t, TR, DM, DM}; pg8::StaticOrder S; S.init(TR, DM, F.G, (int)blockIdx.x);
        pg8::EpiScores E{sumsq, SC, DM, RMS_EPS};
        pg8::gemm_phase<pg8::EpiScores, pg8::StaticOrder, true, true>(F.lds, g, S, E);
#if (PH_DUP >> 5) & 1
        __syncthreads(); pg8::gemm_phase<pg8::EpiScores, pg8::StaticOrder, true, true>(F.lds, g, S, E);
#endif
    } SEAM(5);
#if !FUSE_TOPK || GATHER_SLICED
    if (IN(6)) { DUP(6) topk_phase(F); } SEAM(6);
#endif
#if GATHER_SLICED
    if (IN(7)) { gather_down_sliced(F, bar); } SEAM(7);
    if (IN(8)) { gather_up_sliced(F, bar); }
#else
    if (IN(7)) { gather_phase(F, bar); }
#endif
#undef IN
#undef SEAM
}

extern "C" void kernel_launch(void* const* d_in, const int* in_sizes, int n_in, void* d_out, int out_size, void* d_ws, size_t ws_size, hipStream_t stream) {
    static int grid = 0;
    if (grid == 0) {
        if (n_in != 24 || in_sizes[0] != TR * DM || out_size != TR * DM || ws_size < WS_END) { fprintf(stderr, "kernel_launch: unexpected shapes: n_in %d in0 %d out %d ws %zu\n", n_in, n_in > 0 ? in_sizes[0] : -1, out_size, ws_size); grid = -1; return; }
        int dev = 0, cus = 0, per_cu = 0;
        if (hipGetDevice(&dev) != hipSuccess || hipDeviceGetAttribute(&cus, hipDeviceAttributeMultiprocessorCount, dev) != hipSuccess) { grid = -1; return; }
        if (hipFuncSetAttribute((const void*)hybrid_fwd, hipFuncAttributeMaxDynamicSharedMemorySize, LDS_BYTES) != hipSuccess) { fprintf(stderr, "kernel_launch: hipFuncSetAttribute failed\n"); grid = -1; return; }
        if (hipOccupancyMaxActiveBlocksPerMultiprocessor(&per_cu, (const void*)hybrid_fwd, NTHR, LDS_BYTES) != hipSuccess || per_cu < 1) fprintf(stderr, "kernel_launch: occupancy query says %d\n", per_cu);
        (void)hipGetLastError();
        grid = cus;
    }
    if (grid < 0) return;
    if (hipMemsetAsync((char*)d_ws + WS_CTL, 0, CTL_ZERO_BYTES, stream) != hipSuccess) return;
    Args a{};
    for (int i = 0; i < 24; ++i) a.in[i] = (const float*)d_in[i];
    a.out = (float*)d_out; a.ws = (unsigned char*)d_ws;
#if MK_SPLIT
    for (int li = 0; li < NPHASE; ++li) { a.ph_lo = li; a.ph_hi = li + 1; a.li = li; hipLaunchKernelGGL(hybrid_fwd, dim3(grid), dim3(NTHR), LDS_BYTES, stream, a); }
#else
    a.ph_lo = 0; a.ph_hi = NPHASE; a.li = 0;
    hipLaunchKernelGGL(hybrid_fwd, dim3(grid), dim3(NTHR), LDS_BYTES, stream, a);
#endif
}
```
